# Optimizing an MI355X kernel written in HIP

```python
import math
import jax
import jax.numpy as jnp
from jax import lax
import numpy as np

D_MODEL = 1024
BATCH = 8
SEQ = 2048
DEPTH = 1

N_HEADS = 16
HEAD_DIM = 64
ATTN_WIDTH = N_HEADS * HEAD_DIM
MOBA_BLOCK = 256
MOBA_TOPK = 3
Q_CHUNK = 16
SSD_EXPAND = 2
D_INNER = SSD_EXPAND * D_MODEL
SSD_HEAD_DIM = 64
SSD_HEADS = D_INNER // SSD_HEAD_DIM
N_GROUPS = 4
HEADS_PER_GROUP = SSD_HEADS // N_GROUPS
D_STATE = 128
CONV_K = 4
SSD_CHUNK = 128
D_XBC = D_INNER + 2 * N_GROUPS * D_STATE
N_BRANCHES = 2
COL_Q = ATTN_WIDTH
COL_K = 2 * ATTN_WIDTH
COL_V = 3 * ATTN_WIDTH
COL_Z = COL_V + D_INNER
COL_XBC = COL_Z + D_XBC
COL_DT = COL_XBC + SSD_HEADS
N_IN = COL_DT + N_BRANCHES * D_MODEL
N_EXPERTS = 32
TOP_K = 4
D_FF = D_MODEL
SWIGLU_LIMIT = 7.0
SWIGLU_ALPHA = 1.702
MOE_BLOCK = 256
NORM_EPS = 1e-6
NEG_INF = -1e30

kernel_name = 'hybrid_moba_ssd_gated_moe'


def rms_norm(x, w):
    xf = x.astype(jnp.float32)
    y = xf * lax.rsqrt(jnp.mean(xf * xf, axis=-1, keepdims=True) + NORM_EPS)
    return (y * w.astype(jnp.float32)).astype(x.dtype)


def moba_attention(q, k, v):
    b, l, h, d = q.shape
    lp = -(-l // MOBA_BLOCK) * MOBA_BLOCK
    pad = ((0, 0), (0, lp - l), (0, 0), (0, 0))
    nb = lp // MOBA_BLOCK
    q = jnp.pad(q, pad).transpose(0, 2, 1, 3)
    kb = jnp.pad(k, pad).transpose(0, 2, 1, 3).reshape(b, h, nb, MOBA_BLOCK, d)
    vb = jnp.pad(v, pad).transpose(0, 2, 1, 3).reshape(b, h, nb, MOBA_BLOCK, d)
    k_mean = jnp.mean(kb.astype(jnp.float32), axis=3)
    blk_scores = jnp.einsum('bhtd,bhnd->bhtn', q.astype(jnp.float32), k_mean)
    q_blk = jnp.arange(lp) // MOBA_BLOCK
    past = jnp.arange(nb)[None, :] < q_blk[:, None]
    blk_scores = jnp.where(past, blk_scores, NEG_INF)
    n_sel = min(MOBA_TOPK, nb)
    _, sel = lax.top_k(blk_scores, n_sel)
    sel_valid = sel < q_blk[:, None]
    nqc = lp // Q_CHUNK

    def to_chunks(t):
        return jnp.moveaxis(t.reshape(b, h, nqc, Q_CHUNK, t.shape[-1]), 2, 0)

    gather_blocks = jax.vmap(jax.vmap(lambda blocks, idx: blocks[idx]))
    scale = HEAD_DIM ** -0.5

    def attend_chunk(args):
        c, q_c, sel_c, valid_c = args
        blk = (c * Q_CHUNK) // MOBA_BLOCK
        k_own = lax.dynamic_index_in_dim(kb, blk, axis=2, keepdims=False)
        v_own = lax.dynamic_index_in_dim(vb, blk, axis=2, keepdims=False)
        q_pos = c * Q_CHUNK + jnp.arange(Q_CHUNK)
        k_pos = blk * MOBA_BLOCK + jnp.arange(MOBA_BLOCK)
        s_own = jnp.einsum('bhqd,bhkd->bhqk', q_c, k_own).astype(jnp.float32) * scale
        s_own = jnp.where(k_pos[None, :] <= q_pos[:, None], s_own, NEG_INF)
        k_sel = gather_blocks(kb, sel_c)
        v_sel = gather_blocks(vb, sel_c)
        s_sel = jnp.einsum('bhqd,bhqnkd->bhqnk', q_c, k_sel).astype(jnp.float32) * scale
        s_sel = jnp.where(valid_c[..., None], s_sel, NEG_INF)
        logits = jnp.concatenate([s_own, s_sel.reshape(b, h, Q_CHUNK, n_sel * MOBA_BLOCK)], axis=-1)
        p = jax.nn.softmax(logits, axis=-1).astype(v_own.dtype)
        p_own = p[..., :MOBA_BLOCK]
        p_sel = p[..., MOBA_BLOCK:].reshape(b, h, Q_CHUNK, n_sel, MOBA_BLOCK)
        return (jnp.einsum('bhqk,bhkd->bhqd', p_own, v_own)
                + jnp.einsum('bhqnk,bhqnkd->bhqd', p_sel, v_sel))

    out = lax.map(attend_chunk, (jnp.arange(nqc), to_chunks(q), to_chunks(sel), to_chunks(sel_valid)))
    out = out.transpose(1, 0, 3, 2, 4).reshape(b, lp, h, d)[:, :l]
    return out.reshape(b, l, h * d)


def segsum(x):
    t = x.shape[-1]
    cs = jnp.cumsum(x, axis=-1)
    diff = cs[..., :, None] - cs[..., None, :]
    return jnp.where(jnp.tril(jnp.ones((t, t), dtype=bool)), diff, -jnp.inf)


def ssd_chunked(xdt, adt, bm, cm):
    b, l, g, r, p = xdt.shape
    n = bm.shape[-1]
    nc = l // SSD_CHUNK
    xc = xdt.reshape(b, nc, SSD_CHUNK, g, r, p)
    ac = adt.reshape(b, nc, SSD_CHUNK, g, r).transpose(0, 3, 4, 1, 2)
    bc = bm.reshape(b, nc, SSD_CHUNK, g, n)
    cc = cm.reshape(b, nc, SSD_CHUNK, g, n)
    a_cum = jnp.cumsum(ac, axis=-1)
    lmat = jnp.exp(segsum(ac))
    cb = jnp.einsum('bclgn,bcsgn->bgcls', cc, bc)
    y_diag = jnp.einsum('bgrcls,bcsgrp->bclgrp', cb[:, :, None] * lmat, xc)
    decay_states = jnp.exp(a_cum[..., -1:] - a_cum).transpose(0, 3, 4, 1, 2)
    states = jnp.einsum('bclgn,bclgrp->bcgrpn', bc, xc * decay_states[..., None])
    states = jnp.concatenate([jnp.zeros_like(states[:, :1]), states], axis=1)
    chunk_decay = jnp.exp(segsum(jnp.pad(a_cum[..., -1], ((0, 0), (0, 0), (0, 0), (1, 0)))))
    states = jnp.einsum('bgrzc,bcgrpn->bzgrpn', chunk_decay, states)[:, :-1]
    state_decay_out = jnp.exp(a_cum).transpose(0, 3, 4, 1, 2)
    y_off = jnp.einsum('bclgn,bcgrpn->bclgrp', cc, states) * state_decay_out[..., None]
    return (y_diag + y_off).reshape(b, l, g, r, p)


def ssd_mixer(z, xbc, dt_raw, conv_w, conv_b, dt_bias, a_log, d_skip, norm_w):
    b, l, _ = xbc.shape
    xbc = lax.conv_general_dilated(
        xbc, conv_w[:, None, :].astype(xbc.dtype), window_strides=(1,),
        padding=[(CONV_K - 1, 0)], dimension_numbers=('NWC', 'WIO', 'NWC'),
        feature_group_count=D_XBC)
    xbc = jax.nn.silu(xbc + conv_b)
    xs = xbc[..., :D_INNER].reshape(b, l, N_GROUPS, HEADS_PER_GROUP, SSD_HEAD_DIM).astype(jnp.float32)
    bm = xbc[..., D_INNER:D_INNER + N_GROUPS * D_STATE].reshape(b, l, N_GROUPS, D_STATE).astype(jnp.float32)
    cm = xbc[..., D_INNER + N_GROUPS * D_STATE:].reshape(b, l, N_GROUPS, D_STATE).astype(jnp.float32)
    dt = jax.nn.softplus(dt_raw.astype(jnp.float32) + dt_bias.astype(jnp.float32))
    dt = dt.reshape(b, l, N_GROUPS, HEADS_PER_GROUP)
    a = -jnp.exp(a_log.astype(jnp.float32)).reshape(N_GROUPS, HEADS_PER_GROUP)
    y = ssd_chunked(xs * dt[..., None], dt * a, bm, cm)
    y = y + d_skip.astype(jnp.float32).reshape(N_GROUPS, HEADS_PER_GROUP, 1) * xs
    gated = y * jax.nn.silu(z.astype(jnp.float32)).reshape(b, l, N_GROUPS, HEADS_PER_GROUP, SSD_HEAD_DIM)
    gated = gated.reshape(b, l, N_GROUPS, HEADS_PER_GROUP * SSD_HEAD_DIM)
    normed = rms_norm(gated, norm_w.reshape(N_GROUPS, HEADS_PER_GROUP * SSD_HEAD_DIM))
    return normed.reshape(b, l, D_INNER).astype(z.dtype)


def moe_ffn(h, w_router, b_router, w_gate_up, b_gate_up, w_down, b_down):
    t, d = h.shape
    logits = jnp.matmul(h, w_router).astype(jnp.float32) + b_router.astype(jnp.float32)
    top_vals, top_idx = lax.top_k(logits, TOP_K)
    gates = jax.nn.softmax(top_vals, axis=-1)
    n_assign = t * TOP_K
    e_flat = top_idx.reshape(-1)
    tok_flat = jnp.repeat(jnp.arange(t, dtype=jnp.int32), TOP_K)
    w_flat = gates.reshape(-1)
    order = jnp.argsort(e_flat)
    e_sorted = e_flat[order]
    counts = jnp.bincount(e_flat, length=N_EXPERTS)
    padded = ((counts + MOE_BLOCK - 1) // MOE_BLOCK) * MOE_BLOCK
    start = jnp.cumsum(counts) - counts
    cum_padded = jnp.cumsum(padded)
    pstart = cum_padded - padded
    dest = pstart[e_sorted] + (jnp.arange(n_assign) - start[e_sorted])
    n_rows = n_assign + N_EXPERTS * MOE_BLOCK
    n_blocks = n_rows // MOE_BLOCK
    buf_tok = jnp.zeros((n_rows,), jnp.int32).at[dest].set(tok_flat[order])
    buf_w = jnp.zeros((n_rows,), jnp.float32).at[dest].set(w_flat[order])
    block_expert = jnp.minimum(
        jnp.searchsorted(cum_padded, jnp.arange(n_blocks) * MOE_BLOCK, side='right'), N_EXPERTS - 1)
    xb = h[buf_tok].reshape(n_blocks, MOE_BLOCK, d)

    def expert_block(args):
        xblk, e = args
        gu = jnp.matmul(xblk, w_gate_up[e]) + b_gate_up[e]
        g = jnp.minimum(gu[:, 0::2], SWIGLU_LIMIT)
        u = jnp.clip(gu[:, 1::2], -SWIGLU_LIMIT, SWIGLU_LIMIT)
        act = (u + 1.0) * (g * jax.nn.sigmoid(SWIGLU_ALPHA * g))
        return jnp.matmul(act, w_down[e]) + b_down[e]

    yb = lax.map(expert_block, (xb, block_expert)).reshape(n_rows, d)
    return jnp.zeros((t, d), h.dtype).at[buf_tok].add(yb * buf_w[:, None].astype(h.dtype))


def setup_inputs(seed: int = 0) -> dict:
    key = jax.random.key(seed)
    ks = jax.random.split(key, 24)

    def nrm(k, shape, scale):
        return jax.random.normal(k, shape, jnp.float32) * scale

    dt0 = jnp.exp(jax.random.uniform(ks[8], (DEPTH, SSD_HEADS), jnp.float32,
                                     minval=math.log(1e-3), maxval=math.log(1e-1)))
    return {
        'x': nrm(ks[0], (BATCH, SEQ, D_MODEL), 1.0),
        'ln1_w': 1.0 + nrm(ks[1], (DEPTH, D_MODEL), 0.01),
        'w_in': nrm(ks[2], (DEPTH, D_MODEL, N_IN), D_MODEL ** -0.5),
        'gate_b': nrm(ks[3], (DEPTH, N_BRANCHES, D_MODEL), 0.01),
        'q_norm_w': 1.0 + nrm(ks[4], (DEPTH, HEAD_DIM), 0.01),
        'k_norm_w': 1.0 + nrm(ks[5], (DEPTH, HEAD_DIM), 0.01),
        'conv_w': nrm(ks[6], (DEPTH, CONV_K, D_XBC), CONV_K ** -0.5),
        'conv_b': nrm(ks[7], (DEPTH, D_XBC), 0.01),
        'dt_bias': dt0 + jnp.log(-jnp.expm1(-dt0)),
        'a_log': jnp.log(jax.random.uniform(ks[9], (DEPTH, SSD_HEADS), jnp.float32, minval=1.0, maxval=16.0)),
        'd_skip': 1.0 + nrm(ks[10], (DEPTH, SSD_HEADS), 0.01),
        'ssd_norm_w': 1.0 + nrm(ks[11], (DEPTH, D_INNER), 0.01),
        'w_o_attn': nrm(ks[12], (DEPTH, ATTN_WIDTH, D_MODEL), ATTN_WIDTH ** -0.5),
        'w_o_ssd': nrm(ks[13], (DEPTH, D_INNER, D_MODEL), D_INNER ** -0.5),
        'w_out': nrm(ks[14], (DEPTH, D_MODEL, D_MODEL), D_MODEL ** -0.5),
        'ln2_w': 1.0 + nrm(ks[15], (DEPTH, D_MODEL), 0.01),
        'w_router': nrm(ks[16], (DEPTH, D_MODEL, N_EXPERTS), D_MODEL ** -0.5),
        'b_router': nrm(ks[17], (DEPTH, N_EXPERTS), 0.01),
        'w_gate_up': nrm(ks[18], (DEPTH, N_EXPERTS, D_MODEL, 2 * D_FF), D_MODEL ** -0.5),
        'b_gate_up': nrm(ks[19], (DEPTH, N_EXPERTS, 2 * D_FF), 0.01),
        'w_down': nrm(ks[20], (DEPTH, N_EXPERTS, D_FF, D_MODEL), D_FF ** -0.5),
        'b_down': nrm(ks[21], (DEPTH, N_EXPERTS, D_MODEL), 0.01),
    }


def reference(x, ln1_w, w_in, gate_b, q_norm_w, k_norm_w, conv_w, conv_b, dt_bias, a_log,
              d_skip, ssd_norm_w, w_o_attn, w_o_ssd, w_out, ln2_w, w_router, b_router,
              w_gate_up, b_gate_up, w_down, b_down):
    b, l, d = x.shape
    for layer in range(DEPTH):
        h = rms_norm(x, ln1_w[layer])
        proj = jnp.matmul(h, w_in[layer])
        q = proj[..., :COL_Q].reshape(b, l, N_HEADS, HEAD_DIM)
        k = proj[..., COL_Q:COL_K].reshape(b, l, N_HEADS, HEAD_DIM)
        v = proj[..., COL_K:COL_V].reshape(b, l, N_HEADS, HEAD_DIM)
        z = proj[..., COL_V:COL_Z]
        xbc = proj[..., COL_Z:COL_XBC]
        dt_raw = proj[..., COL_XBC:COL_DT]
        gate_logits = proj[..., COL_DT:].reshape(b, l, N_BRANCHES, D_MODEL)
        q = rms_norm(q, q_norm_w[layer])
        k = rms_norm(k, k_norm_w[layer])
        attn = jnp.matmul(moba_attention(q, k, v), w_o_attn[layer])
        ssd = jnp.matmul(ssd_mixer(z, xbc, dt_raw, conv_w[layer], conv_b[layer], dt_bias[layer],
                                   a_log[layer], d_skip[layer], ssd_norm_w[layer]), w_o_ssd[layer])
        gates = jax.nn.sigmoid(gate_logits + gate_b[layer])
        mixed = gates[:, :, 0] * attn + gates[:, :, 1] * ssd
        x = x + jnp.matmul(mixed, w_out[layer])
        h2 = rms_norm(x, ln2_w[layer]).reshape(b * l, d)
        x = x + moe_ffn(h2, w_router[layer], b_router[layer], w_gate_up[layer], b_gate_up[layer],
                        w_down[layer], b_down[layer]).reshape(b, l, d)
    return x
```

```cpp
#include <hip/hip_runtime.h>
#include <cstdio>
#include <cstdint>
namespace pg8 {
#define PG8_LAS __attribute__((address_space(3)))
typedef unsigned short bf16_t;
typedef short bf16x8 __attribute__((ext_vector_type(8)));
typedef float f32x4 __attribute__((ext_vector_type(4)));
typedef unsigned u32x4 __attribute__((ext_vector_type(4)));
constexpr int BM = 256, BK = 64, HALF = 128, HTB = HALF * BK * 2  , STAGE_BYTES = 8 * HTB, NXCD = 8, WGM = 8;

__host__ __device__ __forceinline__ int lds_byte(int r, int c) { const int st = (r >> 4) * 2 + (c >> 5), rr = r & 15, cc = c & 31, ob = rr * 64 + cc * 2; return st * 1024 + (ob ^ (((ob >> 9) & 1) << 5)); }
__host__ __device__ __forceinline__ void stage_rc(int b, int& R, int& C) { const int st = b / 1024, sb = b % 1024, swz = sb ^ (((sb >> 9) & 1) << 5); R = (st >> 1) * 16 + swz / 64; C = (st & 1) * 32 + (swz % 64) / 2; }
__host__ __device__ __forceinline__ int perm32(int rho) { const int n = rho >> 4, i = rho & 15; return 8 * (i >> 2) + 4 * n + (i & 3); }

struct Unit { int pm, pn; };
struct Gemm { const bf16_t* A; const bf16_t* Bt; int M, N, K; };

struct StaticOrder {
    int nM, nN, nwg, G, c;
    __host__ __device__ void init(int M, int N, int G_, int c_) { nM = M / BM; nN = N / BM; nwg = nM * nN; G = G_; c = c_; }
    __host__ __device__ bool next(int i, Unit& u) const {
        const long L = (long)i * G + c; if (L >= nwg) return false;
        int wgid = (int)L; { const int q = nwg / NXCD, r = nwg % NXCD, xcd = wgid % NXCD, off = wgid / NXCD; wgid = (xcd < r ? xcd * (q + 1) : r * (q + 1) + (xcd - r) * q) + off; }
        const int nig = WGM * nN, gid = wgid / nig, fm = gid * WGM, gsz = (nM - fm) < WGM ? (nM - fm) : WGM;
        u.pm = fm + ((wgid % nig) % gsz); u.pn = (wgid % nig) / gsz; return true;
    }
    __device__ __forceinline__ void a_ready(const Unit&) const {}
    __device__ __forceinline__ void done(const Unit&) const {}
};

struct GroupedOrder {
    int nN, NT, G, c; const PG8_LAS int* tile_e;
    __device__ __forceinline__ bool next(int i, Unit& u) const {
        const long L = (long)i * G + c; const int nwg = NT * nN; if (L >= nwg) return false;
        int wgid = (int)L; { const int q = nwg / NXCD, r = nwg % NXCD, xcd = wgid % NXCD, off = wgid / NXCD; wgid = (xcd < r ? xcd * (q + 1) : r * (q + 1) + (xcd - r) * q) + off; }
        const int rt = wgid / nN, pl = wgid % nN;
        u.pm = rt; u.pn = tile_e[rt] * nN + pl; return true;
    }
    __device__ __forceinline__ void a_ready(const Unit&) const {}
    __device__ __forceinline__ void done(const Unit&) const {}
};

__device__ __forceinline__ unsigned cvt_pk_bf16(float lo, float hi) { unsigned r; asm volatile("v_cvt_pk_bf16_f32 %0, %1, %2" : "=v"(r) : "v"(lo), "v"(hi)); return r; }
__device__ __forceinline__ float sigm(float x) { return __builtin_amdgcn_rcpf(1.f + __builtin_amdgcn_exp2f(-1.44269504f * x)); }
__device__ __forceinline__ void unpack8(const u32x4 w, float (&f)[8]) {
#pragma unroll
    for (int i = 0; i < 4; ++i) { f[2 * i] = __uint_as_float(w[i] << 16); f[2 * i + 1] = __uint_as_float(w[i] & 0xffff0000u); }
}
struct EpiPlain {
    static constexpr bool PERM = true, AFTER_DRAIN = false; bf16_t* O; int ldc;
    __device__ __forceinline__ void operator()(const f32x4 (&acc)[2][2][4][2], const Unit& u, int wr, int wc, int fr, int fq) const {
        const int row0 = u.pm * BM + wr * 64 + fr, col0 = u.pn * BM + wc * 32 + 8 * fq;
#pragma unroll
        for (int ai = 0; ai < 2; ++ai)
#pragma unroll
            for (int m = 0; m < 4; ++m) { bf16_t* rowp = O + (size_t)(row0 + ai * HALF + m * 16) * ldc + col0;
#pragma unroll
                for (int bj = 0; bj < 2; ++bj) { const f32x4 v0 = acc[ai][bj][m][0], v1 = acc[ai][bj][m][1]; u32x4 w;
                    w.x = cvt_pk_bf16(v0[0], v0[1]); w.y = cvt_pk_bf16(v0[2], v0[3]); w.z = cvt_pk_bf16(v1[0], v1[1]); w.w = cvt_pk_bf16(v1[2], v1[3]);
                    *(u32x4*)(rowp + bj * HALF) = w; } }
    }
};
struct EpiGate1 {
    static constexpr bool PERM = true, AFTER_DRAIN = false; const bf16_t* Gp; int ldg; const float* gb; float* MIXF;
    __device__ __forceinline__ void operator()(const f32x4 (&acc)[2][2][4][2], const Unit& u, int wr, int wc, int fr, int fq) const {
        const int row0 = u.pm * BM + wr * 64 + fr, col0 = u.pn * BM + wc * 32 + 8 * fq;
#pragma unroll
        for (int ai = 0; ai < 2; ++ai)
#pragma unroll
            for (int m = 0; m < 4; ++m) { const size_t row = (size_t)(row0 + ai * HALF + m * 16);
#pragma unroll
                for (int bj = 0; bj < 2; ++bj) { const int c = col0 + bj * HALF; float g[8]; unpack8(*(const u32x4*)(Gp + row * ldg + c), g);
                    const f32x4 b0 = *(const f32x4*)(gb + c), b1 = *(const f32x4*)(gb + c + 4); const f32x4 v0 = acc[ai][bj][m][0], v1 = acc[ai][bj][m][1]; f32x4 o0, o1;
#pragma unroll
                    for (int i = 0; i < 4; ++i) { o0[i] = sigm(g[i] + b0[i]) * v0[i]; o1[i] = sigm(g[4 + i] + b1[i]) * v1[i]; }
                    *(f32x4*)(MIXF + row * 1024 + c) = o0; *(f32x4*)(MIXF + row * 1024 + c + 4) = o1; } }
    }
};
struct EpiGate2 {
    static constexpr bool PERM = true, AFTER_DRAIN = false; const bf16_t* Gp; int ldg; const float* gb; const float* MIXF; bf16_t* MIX;
    __device__ __forceinline__ void operator()(const f32x4 (&acc)[2][2][4][2], const Unit& u, int wr, int wc, int fr, int fq) const {
        const int row0 = u.pm * BM + wr * 64 + fr, col0 = u.pn * BM + wc * 32 + 8 * fq;
#pragma unroll
        for (int ai = 0; ai < 2; ++ai)
#pragma unroll
            for (int m = 0; m < 4; ++m) { const size_t row = (size_t)(row0 + ai * HALF + m * 16);
#pragma unroll
                for (int bj = 0; bj < 2; ++bj) { const int c = col0 + bj * HALF; float g[8]; unpack8(*(const u32x4*)(Gp + row * ldg + c), g);
                    const f32x4 b0 = *(const f32x4*)(gb + c), b1 = *(const f32x4*)(gb + c + 4); const f32x4 v0 = acc[ai][bj][m][0], v1 = acc[ai][bj][m][1];
                    const f32x4 p0 = *(const f32x4*)(MIXF + row * 1024 + c), p1 = *(const f32x4*)(MIXF + row * 1024 + c + 4); f32x4 o0, o1;
#pragma unroll
                    for (int i = 0; i < 4; ++i) { o0[i] = p0[i] + sigm(g[i] + b0[i]) * v0[i]; o1[i] = p1[i] + sigm(g[4 + i] + b1[i]) * v1[i]; }
                    u32x4 w; w.x = cvt_pk_bf16(o0[0], o0[1]); w.y = cvt_pk_bf16(o0[2], o0[3]); w.z = cvt_pk_bf16(o1[0], o1[1]); w.w = cvt_pk_bf16(o1[2], o1[3]);
                    *(u32x4*)(MIX + row * 1024 + c) = w; } }
    }
};
struct EpiResid {
    static constexpr bool PERM = true, AFTER_DRAIN = false; const float* base; float* out;
    __device__ __forceinline__ void operator()(const f32x4 (&acc)[2][2][4][2], const Unit& u, int wr, int wc, int fr, int fq) const {
        const int row0 = u.pm * BM + wr * 64 + fr, col0 = u.pn * BM + wc * 32 + 8 * fq;
#pragma unroll
        for (int ai = 0; ai < 2; ++ai)
#pragma unroll
            for (int m = 0; m < 4; ++m) { const size_t row = (size_t)(row0 + ai * HALF + m * 16);
#pragma unroll
                for (int bj = 0; bj < 2; ++bj) { const size_t o = row * 1024 + col0 + bj * HALF;
                    const f32x4 p0 = *(const f32x4*)(base + o), p1 = *(const f32x4*)(base + o + 4);
                    *(f32x4*)(out + o) = p0 + acc[ai][bj][m][0]; *(f32x4*)(out + o + 4) = p1 + acc[ai][bj][m][1]; } }
    }
};
struct EpiSwiglu {
    static constexpr bool PERM = true, AFTER_DRAIN = false; bf16_t* ACT; const float* bgu;
    __device__ __forceinline__ void operator()(const f32x4 (&acc)[2][2][4][2], const Unit& u, int wr, int wc, int fr, int fq) const {
        const int e = u.pn >> 3, pl = u.pn & 7, j0 = 128 * pl + wc * 32 + 8 * fq; const int row0 = u.pm * BM + wr * 64 + fr;
        float bg[8], bu[8];
        { const float* bs = bgu + (size_t)e * 2048 + 2 * j0;
#pragma unroll
          for (int q = 0; q < 4; ++q) { const f32x4 t = *(const f32x4*)(bs + 4 * q); bg[2 * q] = t[0]; bu[2 * q] = t[1]; bg[2 * q + 1] = t[2]; bu[2 * q + 1] = t[3]; } }
#pragma unroll
        for (int ai = 0; ai < 2; ++ai)
#pragma unroll
            for (int m = 0; m < 4; ++m) { const size_t row = (size_t)(row0 + ai * HALF + m * 16); float a[8];
#pragma unroll
                for (int i = 0; i < 8; ++i) { const float gr = (i < 4 ? acc[ai][0][m][0][i & 3] : acc[ai][0][m][1][i & 3]) + bg[i], ur = (i < 4 ? acc[ai][1][m][0][i & 3] : acc[ai][1][m][1][i & 3]) + bu[i];
                    const float g = fminf(gr, 7.0f), uu = fminf(fmaxf(ur, -7.0f), 7.0f); a[i] = (uu + 1.0f) * (g * sigm(1.702f * g)); }
                u32x4 w; w.x = cvt_pk_bf16(a[0], a[1]); w.y = cvt_pk_bf16(a[2], a[3]); w.z = cvt_pk_bf16(a[4], a[5]); w.w = cvt_pk_bf16(a[6], a[7]);
                *(u32x4*)(ACT + row * 1024 + j0) = w; }
    }
};
struct EpiDown {
    static constexpr bool PERM = true, AFTER_DRAIN = false; bf16_t* Y; const float* bd; const float* roww;
    __device__ __forceinline__ void operator()(const f32x4 (&acc)[2][2][4][2], const Unit& u, int wr, int wc, int fr, int fq) const {
        const int e = u.pn >> 2, pl = u.pn & 3, col0 = pl * BM + wc * 32 + 8 * fq; const int row0 = u.pm * BM + wr * 64 + fr;
#pragma unroll
        for (int ai = 0; ai < 2; ++ai)
#pragma unroll
            for (int m = 0; m < 4; ++m) { const size_t row = (size_t)(row0 + ai * HALF + m * 16); const float rw = roww[row];
#pragma unroll
                for (int bj = 0; bj < 2; ++bj) { const int c = col0 + bj * HALF; const f32x4 b0 = *(const f32x4*)(bd + (size_t)e * 1024 + c), b1 = *(const f32x4*)(bd + (size_t)e * 1024 + c + 4);
                    const f32x4 v0 = (acc[ai][bj][m][0] + b0) * rw, v1 = (acc[ai][bj][m][1] + b1) * rw; u32x4 w;
                    w.x = cvt_pk_bf16(v0[0], v0[1]); w.y = cvt_pk_bf16(v0[2], v0[3]); w.z = cvt_pk_bf16(v1[0], v1[1]); w.w = cvt_pk_bf16(v1[2], v1[3]);
                    *(u32x4*)(Y + row * 1024 + c) = w; } }
    }
};
template <class Epi, class Sched, bool ALIGN_EPI = false, bool SP2 = false>
__device__ __forceinline__ void gemm_phase(PG8_LAS unsigned char* lds, const Gemm g, const Sched& S, const Epi& E) {
    const int tid = threadIdx.x, wid = __builtin_amdgcn_readfirstlane(tid >> 6), lane = tid & 63, wr = wid >> 2, wc = wid & 3, fr = lane & 15, fq = lane >> 4;
    const int K = g.K, nt = K / BK;
    unsigned voffA[2], voffB[2];
#pragma unroll
    for (int i = 0; i < 2; ++i) { int R, C; stage_rc(tid * 16 + i * 8192, R, C); const int Rb = Epi::PERM ? ((R & ~31) + perm32(R & 31)) : R;
        voffA[i] = (unsigned)(R * K + C) * 2u; voffB[i] = (unsigned)(Rb * K + C) * 2u; }
    const size_t kstep = (size_t)(BK * 2);
    const size_t hstep = (size_t)HALF * K * 2;
    const size_t tstep = 2 * hstep;
    const unsigned ldsw = (unsigned)wid * 1024u;
    const int aoff = lds_byte(wr * 64 + fr, fq * 8), boff = lds_byte(wc * 32 + fr, fq * 8);
#define PG8_SA(b, h) (((b) * 2 + (h)) * HTB)
#define PG8_SB(b, h) ((4 + (b) * 2 + (h)) * HTB)
#define PG8_STAGE(bufoff, gbase, voff) do { _Pragma("unroll") for (int _i = 0; _i < 2; ++_i) \
        __builtin_amdgcn_global_load_lds((const unsigned*)((const char*)(gbase) + (voff)[_i]), (PG8_LAS unsigned*)(lds + (bufoff) + ldsw + _i * 8192), 16, 0, 0); } while (0)
#define PG8_LDA(dst, b, h) do { _Pragma("unroll") for (int m = 0; m < 4; ++m) _Pragma("unroll") for (int k = 0; k < 2; ++k) dst[m][k] = *(const PG8_LAS bf16x8*)(lds + PG8_SA(b, h) + aoff + m * 2048 + k * 1024); } while (0)
#define PG8_LDB(dst, b, h) do { _Pragma("unroll") for (int n = 0; n < 2; ++n) _Pragma("unroll") for (int k = 0; k < 2; ++k) dst[n][k] = *(const PG8_LAS bf16x8*)(lds + PG8_SB(b, h) + boff + n * 2048 + k * 1024); } while (0)
#define PG8_MMA(ai, bj, At, Bt) do { __builtin_amdgcn_s_setprio(1); _Pragma("unroll") for (int m = 0; m < 4; ++m) _Pragma("unroll") for (int n = 0; n < 2; ++n) _Pragma("unroll") for (int k = 0; k < 2; ++k) \
        acc[ai][bj][m][n] = __builtin_amdgcn_mfma_f32_16x16x32_bf16(Bt[n][k], At[m][k], acc[ai][bj][m][n], 0, 0, 0); __builtin_amdgcn_s_setprio(0); } while (0)
#define PG8_WAIT_V(n) asm volatile("s_waitcnt vmcnt(" #n ")" ::: "memory")
#define PG8_WAIT_L(n) asm volatile("s_waitcnt lgkmcnt(" #n ")" ::: "memory")
#define PG8_BAR __builtin_amdgcn_s_barrier()
#define PG8_SCHED __builtin_amdgcn_sched_barrier(0)
    Unit cur, nxt; int ui = 0;
    if (!S.next(0, cur)) return;
    f32x4 acc[2][2][4][2];
#pragma unroll
    for (int a = 0; a < 2; ++a)
#pragma unroll
        for (int b = 0; b < 2; ++b)
#pragma unroll
            for (int m = 0; m < 4; ++m)
#pragma unroll
                for (int n = 0; n < 2; ++n) acc[a][b][m][n] = (f32x4){0.f, 0.f, 0.f, 0.f};
    bf16x8 At[4][2], B0[2][2], B1[2][2];
    const char* cA = (const char*)g.A + (size_t)cur.pm * tstep; const char* cB = (const char*)g.Bt + (size_t)cur.pn * tstep;
    S.a_ready(cur);
    if constexpr (SP2) {
        PG8_STAGE(PG8_SB(0, 0), cB, voffB); PG8_STAGE(PG8_SB(0, 1), cB + hstep, voffB); PG8_STAGE(PG8_SA(0, 0), cA, voffA); PG8_STAGE(PG8_SA(0, 1), cA + hstep, voffA);
        if (wr == 1) PG8_BAR;
        PG8_WAIT_V(2); PG8_BAR;
        PG8_STAGE(PG8_SB(1, 0), cB + kstep, voffB); PG8_STAGE(PG8_SA(1, 0), cA + kstep, voffA); PG8_STAGE(PG8_SB(1, 1), cB + hstep + kstep, voffB);
        PG8_WAIT_V(6); PG8_BAR;
    } else {
        PG8_STAGE(PG8_SB(0, 0), cB, voffB); PG8_STAGE(PG8_SA(0, 0), cA, voffA); PG8_STAGE(PG8_SB(0, 1), cB + hstep, voffB); PG8_STAGE(PG8_SA(0, 1), cA + hstep, voffA);
        if (wr == 1) PG8_BAR;
        PG8_WAIT_V(4); PG8_BAR;
        PG8_STAGE(PG8_SB(1, 0), cB + kstep, voffB); PG8_STAGE(PG8_SA(1, 0), cA + kstep, voffA); PG8_STAGE(PG8_SB(1, 1), cB + hstep + kstep, voffB);
        PG8_WAIT_V(6); PG8_BAR;
    }
    for (;;) {
        const bool has_next = S.next(ui + 1, nxt);
        const char* nA = has_next ? (const char*)g.A + (size_t)nxt.pm * tstep : cA; const char* nB = has_next ? (const char*)g.Bt + (size_t)nxt.pn * tstep : cB;
        for (int t = 0; t < nt; t += 2) {
            const bool last = (t == nt - 2);
            const char* a1 = cA + (size_t)(t + 1) * kstep;
            const char* a2 = last ? nA : cA + (size_t)(t + 2) * kstep; const char* b2 = last ? nB : cB + (size_t)(t + 2) * kstep;
            const char* a3 = a2 + kstep; const char* b3 = b2 + kstep;
            if (last && has_next) S.a_ready(nxt);
            if constexpr (SP2) {
            PG8_LDB(B0, 0, 0); PG8_LDB(B1, 0, 1); PG8_SCHED; PG8_LDA(At, 0, 0); PG8_STAGE(PG8_SA(1, 1), a1 + hstep, voffA);
            PG8_WAIT_V(8); PG8_WAIT_L(0); PG8_BAR; PG8_MMA(0, 0, At, B0); PG8_MMA(0, 1, At, B1); PG8_BAR; PG8_SCHED;
            PG8_LDA(At, 0, 1); PG8_STAGE(PG8_SB(0, 0), b2, voffB); PG8_STAGE(PG8_SB(0, 1), b2 + hstep, voffB); PG8_STAGE(PG8_SA(0, 0), a2, voffA);
            PG8_WAIT_V(8); PG8_WAIT_L(0); PG8_BAR; PG8_MMA(1, 0, At, B0); PG8_MMA(1, 1, At, B1); PG8_BAR; PG8_SCHED;
            PG8_LDB(B0, 1, 0); PG8_LDB(B1, 1, 1); PG8_SCHED; PG8_LDA(At, 1, 0); PG8_STAGE(PG8_SA(0, 1), a2 + hstep, voffA);
            PG8_WAIT_V(8); PG8_WAIT_L(0); PG8_BAR; PG8_MMA(0, 0, At, B0); PG8_MMA(0, 1, At, B1); PG8_BAR; PG8_SCHED;
            PG8_LDA(At, 1, 1); PG8_STAGE(PG8_SB(1, 0), b3, voffB); PG8_STAGE(PG8_SB(1, 1), b3 + hstep, voffB); PG8_STAGE(PG8_SA(1, 0), a3, voffA);
            PG8_WAIT_V(8); PG8_WAIT_L(0); PG8_BAR; PG8_MMA(1, 0, At, B0); PG8_MMA(1, 1, At, B1); PG8_BAR; PG8_SCHED;
            } else {
            PG8_LDB(B0, 0, 0); PG8_SCHED; PG8_LDA(At, 0, 0); PG8_STAGE(PG8_SA(1, 1), a1 + hstep, voffA);
            PG8_WAIT_L(8); PG8_BAR; PG8_WAIT_L(0); PG8_MMA(0, 0, At, B0); PG8_BAR; PG8_SCHED;
            PG8_LDB(B1, 0, 1); PG8_STAGE(PG8_SB(0, 0), b2, voffB);
            PG8_BAR; PG8_WAIT_L(0); PG8_MMA(0, 1, At, B1); PG8_BAR;
            PG8_LDA(At, 0, 1); PG8_STAGE(PG8_SA(0, 0), a2, voffA);
            PG8_BAR; PG8_WAIT_L(0); PG8_MMA(1, 0, At, B0); PG8_BAR; PG8_SCHED;
            PG8_STAGE(PG8_SB(0, 1), b2 + hstep, voffB);
            PG8_WAIT_V(6); PG8_BAR; PG8_MMA(1, 1, At, B1); PG8_BAR;
            PG8_LDB(B0, 1, 0); PG8_SCHED; PG8_LDA(At, 1, 0); PG8_STAGE(PG8_SA(0, 1), a2 + hstep, voffA);
            PG8_WAIT_L(8); PG8_BAR; PG8_WAIT_L(0); PG8_MMA(0, 0, At, B0); PG8_BAR; PG8_SCHED;
            PG8_LDB(B1, 1, 1); PG8_STAGE(PG8_SB(1, 0), b3, voffB);
            PG8_BAR; PG8_WAIT_L(0); PG8_MMA(0, 1, At, B1); PG8_BAR;
            PG8_LDA(At, 1, 1); PG8_STAGE(PG8_SA(1, 0), a3, voffA);
            PG8_BAR; PG8_WAIT_L(0); PG8_MMA(1, 0, At, B0); PG8_BAR; PG8_SCHED;
            PG8_STAGE(PG8_SB(1, 1), b3 + hstep, voffB);
            PG8_WAIT_V(6); PG8_BAR; PG8_MMA(1, 1, At, B1); PG8_BAR;
            }
        }
        if constexpr (ALIGN_EPI) { if (wr == 0) PG8_BAR; }
        if constexpr (!Epi::AFTER_DRAIN) { E(acc, cur, wr, wc, fr, fq); S.done(cur); }
        if (!has_next) break;
#pragma unroll
        for (int a = 0; a < 2; ++a)
#pragma unroll
            for (int b = 0; b < 2; ++b)
#pragma unroll
                for (int m = 0; m < 4; ++m)
#pragma unroll
                    for (int n = 0; n < 2; ++n) acc[a][b][m][n] = (f32x4){0.f, 0.f, 0.f, 0.f};
        cur = nxt; cA = nA; cB = nB; ++ui;
        if constexpr (ALIGN_EPI) { if (wr == 1) PG8_BAR; }
    }
    PG8_WAIT_V(0);
    if constexpr (!ALIGN_EPI) { if (wr == 0) PG8_BAR; }
    PG8_BAR;
    if constexpr (Epi::AFTER_DRAIN) { E.fused(acc, cur, wr, wc, fr, fq, lds, wid, lane); S.done(cur); }
#undef PG8_SA
#undef PG8_SB
#undef PG8_STAGE
#undef PG8_LDA
#undef PG8_LDB
#undef PG8_MMA
#undef PG8_WAIT_V
#undef PG8_WAIT_L
#undef PG8_BAR
#undef PG8_SCHED
}
}
constexpr int NWAVES = 8;
#ifndef MK_PER_PHASE
#define MK_PER_PHASE 1
#endif
constexpr int BATCH = 8, SEQ = 2048, D = 1024, M = BATCH * SEQ;
constexpr int NH = 16, HD = 64, MBLK = 256, NBLK = SEQ / MBLK, MOBA_TOPK = 3;
constexpr int D_INNER = 2048, SSD_H = 32, NGRP = 4, DSTATE = 128, D_XBC = 3072, CONVK = 4;
constexpr int N_IN = 10272, NPROJ = 10240;
constexpr int PQ = 0, PK = 1024, PV = 2048, PZ = 3072, PXBC = 5120, PGATE = 8192;
constexpr int COL_DT = 8192;
constexpr int NEXP = 32, TOPK = 4, EXPCAP = 16384, MAXROWS = M * TOPK + NEXP * 256, MAXTILES = MAXROWS / 256;
constexpr float NORM_EPS = 1e-6f;
constexpr float QSCALE = 0.125f * 1.4426950408889634f;

constexpr size_t MiB = 1u << 20;
constexpr size_t WS_CTL = 0, CTL_ZERO_BYTES = 2 * MiB;
constexpr size_t WS_KM = 1 * MiB;
constexpr size_t WS_WIN = 2 * MiB, WS_WOA = 22 * MiB, WS_WOS = 24 * MiB, WS_WOUT = 28 * MiB, WS_WGU = 30 * MiB, WS_WDN = 158 * MiB;
constexpr size_t WS_WDT = 222 * MiB, WS_WRT = 222 * MiB + 512 * 1024;
constexpr size_t WS_XN = 223 * MiB, WS_DT = 255 * MiB, WS_SSQ = 257 * MiB, WS_YG = 259 * MiB, WS_AO = 323 * MiB, WS_MIXF = 355 * MiB, WS_MIX = 419 * MiB, WS_H2 = 451 * MiB;
constexpr size_t WS_TOKL = 483 * MiB, WS_GATEW = 485 * MiB, WS_POS = 486 * MiB, WS_ROWW = 487 * MiB;
constexpr size_t WS_PROJ = 488 * MiB, WS_XC = 808 * MiB, WS_END = 904 * MiB;
constexpr size_t WS_XG = WS_PROJ, WS_ACT = WS_PROJ + 144 * MiB, WS_Y = WS_XG;
static_assert(WS_ACT + (size_t)MAXROWS * 1024 * 2 <= WS_END, "MoE overlay");
constexpr int CW_TMO = 0, CW_CODE = 1, CW_BAR = 4096, CW_CNT = 16384;

constexpr int RING_OFF = 0, RING_BYTES = 131072;
constexpr int LDSCTL_OFF = RING_BYTES, MISC_OFF = LDSCTL_OFF + 320, TILEE_OFF = LDSCTL_OFF + 1024, ROWB_OFF = LDSCTL_OFF + 2560, CNTL_OFF = LDSCTL_OFF + 2816;
constexpr int LDS_BYTES = 147456;

#define GAS __attribute__((address_space(1)))
#define LAS __attribute__((address_space(3)))
typedef unsigned short bf16;
typedef unsigned v4u __attribute__((ext_vector_type(4)));
typedef unsigned v2u __attribute__((ext_vector_type(2)));
typedef float f32x4 __attribute__((ext_vector_type(4)));
typedef GAS unsigned gu32;
#define RLX_AGENT __ATOMIC_RELAXED, __HIP_MEMORY_SCOPE_AGENT
#define LDS_WAIT() asm volatile("s_waitcnt lgkmcnt(0)" ::: "memory")
#define VM_WAIT() asm volatile("s_waitcnt vmcnt(0)" ::: "memory")
__device__ __forceinline__ unsigned f2bf(float f) { unsigned u = __builtin_bit_cast(unsigned, f); return (u + 0x7fffu + ((u >> 16) & 1u)) >> 16; }
__device__ __forceinline__ unsigned pk2(float lo, float hi) { return f2bf(lo) | (f2bf(hi) << 16); }
__device__ __forceinline__ float bf2f(bf16 b) { return __uint_as_float((unsigned)b << 16); }
__device__ __forceinline__ void unpk8(const v4u w, float (&f)[8]) {
#pragma unroll
    for (int i = 0; i < 4; ++i) { f[2 * i] = __uint_as_float(w[i] << 16); f[2 * i + 1] = __uint_as_float(w[i] & 0xffff0000u); }
}
__device__ __forceinline__ v4u pack8(const float (&f)[8]) { v4u w; w.x = pk2(f[0], f[1]); w.y = pk2(f[2], f[3]); w.z = pk2(f[4], f[5]); w.w = pk2(f[6], f[7]); return w; }
__device__ __forceinline__ float wave_sum(float v) {
#pragma unroll
    for (int o = 1; o < 64; o <<= 1) v += __shfl_xor(v, o);
    return v;
}
__device__ __forceinline__ float wave_max(float v) {
#pragma unroll
    for (int o = 1; o < 64; o <<= 1) v = fmaxf(v, __shfl_xor(v, o));
    return v;
}
__device__ __forceinline__ float silu_f(float x) { return x / (1.f + __expf(-x)); }
#define XB_TMO      128
#define XB_XCNT(j)  (256  + 64 * (j))
#define XB_XSUB(j)  (1280 + 64 * (j))
#define XB_XGEN(j)  (2304 + 64 * (j))
#define XB_TOP      3328
#define XB_TOPGEN   3392
#define XCD_BAR_WORDS 3456
#define XB_SPIN_CAP (1u << 18)

__device__ __forceinline__ unsigned xb_ld(unsigned* p)              { return __hip_atomic_load(p, __ATOMIC_RELAXED, __HIP_MEMORY_SCOPE_AGENT); }
__device__ __forceinline__ unsigned xb_add(unsigned* p, unsigned v) { return __hip_atomic_fetch_add(p, v, __ATOMIC_RELAXED, __HIP_MEMORY_SCOPE_AGENT); }
__device__ __forceinline__ unsigned xb_xcc_id() { return (unsigned)__builtin_amdgcn_s_getreg((3 << 11) | 20) & 0xFu; }
#define XB_SPIN(cond, bar) do { unsigned _sp = 0; while (cond) { __builtin_amdgcn_s_sleep(1); \
    if ((++_sp & 255u) == 0u) { if (xb_ld(&(bar)[XB_TMO])) break; if (_sp > XB_SPIN_CAP) { atomicAdd(&(bar)[XB_TMO], 1u); break; } } } } while (0)

struct XcdBarrier {
    unsigned* bar; unsigned x;
    volatile LAS unsigned* st;
};

__device__ __forceinline__ XcdBarrier xcd_barrier_post(unsigned* bar, volatile LAS unsigned* st) {
    XcdBarrier b; b.bar = bar; b.x = xb_xcc_id(); b.st = st;
    if (threadIdx.x == 0) (void)xb_add(&bar[XB_XCNT(b.x)], 1u);
    return b;
}
__device__ __forceinline__ void xcd_barrier_complete(unsigned* bar, unsigned x, unsigned& nloc, unsigned& nx) {
    const unsigned G = gridDim.x * gridDim.y * gridDim.z;
    unsigned sum, cnt, mine, sp = 0u;
    for (;;) {
        sum = 0u; cnt = 0u; mine = 0u;
#pragma unroll
        for (unsigned j = 0; j < 16; ++j) { const unsigned c = xb_ld(&bar[XB_XCNT(j)]); sum += c; cnt += (c > 0u) ? 1u : 0u; mine = (j == x) ? c : mine; }
        if (sum == G) break;
        __builtin_amdgcn_s_sleep(1);
        if ((++sp & 255u) == 0u) { if (xb_ld(&bar[XB_TMO])) break; if (sp > XB_SPIN_CAP) { atomicAdd(&bar[XB_TMO], 1u); break; } }
    }
    nloc = mine > 0u ? mine : 1u; nx = cnt > 0u ? cnt : 1u;
}

__device__ __forceinline__ void xcd_barrier(const XcdBarrier& b) {
    asm volatile("s_waitcnt vmcnt(0)" ::: "memory");
    __syncthreads();
    if (threadIdx.x == 0) {
        unsigned* bar = b.bar;
        __builtin_amdgcn_s_waitcnt(0);
        unsigned nloc = b.st[0], nx = b.st[1];
        if (nloc == 0u) { xcd_barrier_complete(bar, b.x, nloc, nx); b.st[0] = nloc; b.st[1] = nx; }
        const unsigned old = xb_add(&bar[XB_XSUB(b.x)], 1u);
        const unsigned gen = old / nloc;
        if (old + 1u == (gen + 1u) * nloc) {
            __builtin_amdgcn_fence(__ATOMIC_RELEASE, "agent");
            asm volatile("s_waitcnt vmcnt(0)" ::: "memory");
            const unsigned og = xb_add(&bar[XB_TOP], 1u);
            const unsigned tg = og / nx;
            if (og + 1u == (tg + 1u) * nx) xb_add(&bar[XB_TOPGEN], 1u);
            else XB_SPIN(xb_ld(&bar[XB_TOPGEN]) == tg, bar);
            __builtin_amdgcn_fence(__ATOMIC_ACQUIRE, "agent");
            xb_add(&bar[XB_XGEN(b.x)], 1u);
            asm volatile("s_waitcnt vmcnt(0)" ::: "memory");
        } else {
            XB_SPIN(xb_ld(&bar[XB_XGEN(b.x)]) == gen, bar);
            __builtin_amdgcn_fence(__ATOMIC_ACQUIRE, "agent");
            asm volatile("s_waitcnt vmcnt(0)" ::: "memory");
        }
    }
    __syncthreads();
}
struct Args { const float* in[22]; float* out; unsigned char* ws; int ph_lo, ph_hi; };
struct Frame {
    LAS unsigned char* lds;
    volatile LAS unsigned* MISC;
    gu32* ctl;
    int tid, lane, wave, vcu, G;
};
#define IN_X(A)      ((A).in[0])
#define IN_LN1W(A)   ((A).in[1])
#define IN_WIN(A)    ((A).in[2])
#define IN_GATEB(A)  ((A).in[3])
#define IN_QNW(A)    ((A).in[4])
#define IN_KNW(A)    ((A).in[5])
#define IN_CONVW(A)  ((A).in[6])
#define IN_CONVB(A)  ((A).in[7])
#define IN_DTB(A)    ((A).in[8])
#define IN_ALOG(A)   ((A).in[9])
#define IN_DSKIP(A)  ((A).in[10])
#define IN_SSDNW(A)  ((A).in[11])
#define IN_WOA(A)    ((A).in[12])
#define IN_WOS(A)    ((A).in[13])
#define IN_WOUT(A)   ((A).in[14])
#define IN_LN2W(A)   ((A).in[15])
#define IN_WR(A)     ((A).in[16])
#define IN_BR(A)     ((A).in[17])
#define IN_WGU(A)    ((A).in[18])
#define IN_BGU(A)    ((A).in[19])
#define IN_WDN(A)    ((A).in[20])
#define IN_BDN(A)    ((A).in[21])
#define WSP(A, T, off) ((T*)((A).ws + (off)))

template <class Map>
__device__ __forceinline__ void transpose_item(const float* W, int K, int N, bf16* WT, LAS unsigned* scr, int kb, int nb, int lane, const Map& dest_row) {
    const int k0 = 64 * kb, n0 = 64 * nb, cc = lane & 15, kpl = lane >> 4;
    int col = n0 + 4 * cc; if (col > N - 4) col = N - 4;
    f32x4 a[8], b[8];
#pragma unroll
    for (int it = 0; it < 8; ++it) { const int kp = 4 * it + kpl; a[it] = *(const f32x4*)(W + (size_t)(k0 + 2 * kp) * N + col); b[it] = *(const f32x4*)(W + (size_t)(k0 + 2 * kp + 1) * N + col); }
#pragma unroll
    for (int it = 0; it < 8; ++it) { const int kp = 4 * it + kpl;
#pragma unroll
        for (int i = 0; i < 4; ++i) scr[(4 * cc + i) * 33 + kp] = pk2(a[it][i], b[it][i]); }
    LDS_WAIT(); asm volatile("" ::: "memory");
    const int rr = lane >> 3, ch = lane & 7;
#pragma unroll
    for (int j = 0; j < 8; ++j) { const int n = 8 * j + rr; const LAS unsigned* s = scr + n * 33 + 4 * ch; v4u o; o.x = s[0]; o.y = s[1]; o.z = s[2]; o.w = s[3];
        const int dr = dest_row(n0 + n); if (dr >= 0) *(v4u*)(WT + (size_t)dr * K + k0 + 8 * ch) = o; }
    LDS_WAIT(); asm volatile("" ::: "memory");
}
struct MapId { int N; __device__ __forceinline__ int operator()(int s) const { return s < N ? s : -1; } };
struct MapWin { __device__ __forceinline__ int operator()(int s) const { return s < COL_DT ? s : (s < COL_DT + SSD_H ? -1 : (s < N_IN ? s - SSD_H : -1)); } };
struct MapGu { __device__ __forceinline__ int operator()(int s) const { const int j = s >> 1, isu = s & 1; return (j >> 7) * 256 + (j & 127) + 128 * isu; } };

__device__ __forceinline__ void p0_prologue(Frame& F, const Args& A) {
    LAS unsigned* scr = (LAS unsigned*)(F.lds + RING_OFF + F.wave * 8704);
    const int gw = F.vcu * NWAVES + F.wave, NGW = F.G * NWAVES, lane = F.lane;
    constexpr int I_IN = 16 * 161, I_OA = 16 * 16, I_OS = 32 * 16, I_OUT = 16 * 16, I_GU1 = 16 * 32, I_GU = NEXP * I_GU1, I_DN1 = 16 * 16, I_DN = NEXP * I_DN1;
    constexpr int NITEMS = I_IN + I_OA + I_OS + I_OUT + I_GU + I_DN;
    for (int it = gw; it < NITEMS; it += NGW) {
        int r = it;
        if (r < I_IN) { transpose_item(IN_WIN(A), 1024, N_IN, WSP(A,bf16,WS_WIN), scr, r / 161, r % 161, lane, MapWin{}); continue; } r -= I_IN;
        if (r < I_OA) { transpose_item(IN_WOA(A), 1024, 1024, WSP(A,bf16,WS_WOA), scr, r / 16, r % 16, lane, MapId{1024}); continue; } r -= I_OA;
        if (r < I_OS) { transpose_item(IN_WOS(A), 2048, 1024, WSP(A,bf16,WS_WOS), scr, r / 16, r % 16, lane, MapId{1024}); continue; } r -= I_OS;
        if (r < I_OUT) { transpose_item(IN_WOUT(A), 1024, 1024, WSP(A,bf16,WS_WOUT), scr, r / 16, r % 16, lane, MapId{1024}); continue; } r -= I_OUT;
        if (r < I_GU) { const int e = r / I_GU1, q = r % I_GU1; transpose_item(IN_WGU(A) + (size_t)e * 1024 * 2048, 1024, 2048, WSP(A,bf16,WS_WGU) + (size_t)e * 2048 * 1024, scr, q / 32, q % 32, lane, MapGu{}); continue; } r -= I_GU;
        { const int e = r / I_DN1, q = r % I_DN1; transpose_item(IN_WDN(A) + (size_t)e * 1024 * 1024, 1024, 1024, WSP(A,bf16,WS_WDN) + (size_t)e * 1024 * 1024, scr, q / 16, q % 16, lane, MapId{1024}); }
    }
    { const int gt = F.vcu * 512 + F.tid, NGT = F.G * 512;
      for (int i = gt; i < 32 * 1024; i += NGT) { const int e = i >> 10, k = i & 1023; WSP(A,float,WS_WDT)[i] = IN_WIN(A)[(size_t)k * N_IN + COL_DT + e]; WSP(A,float,WS_WRT)[i] = IN_WR(A)[k * 32 + e]; } }
    for (int m = gw; m < M; m += NGW) {
        const f32x4* xr = (const f32x4*)(IN_X(A) + (size_t)m * D) + lane; const f32x4* wr = (const f32x4*)IN_LN1W(A) + lane;
        f32x4 v[4]; float s = 0.f;
#pragma unroll
        for (int j = 0; j < 4; ++j) { v[j] = xr[64 * j]; s += (v[j].x * v[j].x + v[j].y * v[j].y) + (v[j].z * v[j].z + v[j].w * v[j].w); }
        const float rs = 1.0f / sqrtf(wave_sum(s) * (1.f / D) + NORM_EPS);
        v2u* o8 = (v2u*)(WSP(A,bf16,WS_XN) + (size_t)m * D) + lane;
#pragma unroll
        for (int j = 0; j < 4; ++j) { const f32x4 w = wr[64 * j]; v2u o; o.x = pk2(v[j].x * rs * w.x, v[j].y * rs * w.y); o.y = pk2(v[j].z * rs * w.z, v[j].w * rs * w.w); o8[64 * j] = o; }
    }
}

__device__ __forceinline__ float rowdot32(const float (&h)[16], const LAS float* WT, int lane) {
    float mine = 0.f;
#pragma unroll 2
    for (int e = 0; e < 32; ++e) { float s = 0.f;
#pragma unroll
        for (int j = 0; j < 4; ++j) { const f32x4 w = *(const LAS f32x4*)(WT + e * 1024 + 256 * j + 4 * lane); s += (h[4 * j] * w.x + h[4 * j + 1] * w.y) + (h[4 * j + 2] * w.z + h[4 * j + 3] * w.w); }
        s = wave_sum(s); mine = (lane == e) ? s : mine; }
    return mine;
}
__device__ __forceinline__ void stage_wt(Frame& F, const float* src) {
    LAS f32x4* dst = (LAS f32x4*)(F.lds + RING_OFF); const f32x4* s4 = (const f32x4*)src;
    for (int i = F.tid; i < 8192; i += NWAVES * 64) dst[i] = s4[i];
    __syncthreads();
}

__device__ __forceinline__ void p2_prep(Frame& F, const Args& A) {
    stage_wt(F, WSP(A,float,WS_WDT));
    const LAS float* WT = (const LAS float*)(F.lds + RING_OFF);
    const int lane = F.lane, wave = F.wave;
    float qw[16], kw[16];
#pragma unroll
    for (int q = 0; q < 4; ++q) { const f32x4 a = *(const f32x4*)(IN_QNW(A) + 16 * (lane & 3) + 4 * q), b = *(const f32x4*)(IN_KNW(A) + 16 * (lane & 3) + 4 * q);
#pragma unroll
        for (int i = 0; i < 4; ++i) { qw[4 * q + i] = a[i] * QSCALE; kw[4 * q + i] = b[i]; } }
    for (int item = F.vcu; item < M / 32; item += F.G) {
        const int t0 = item * 32 + wave * 4, b = t0 / SEQ, blk = (t0 % SEQ) / MBLK;
        float km[16];
#pragma unroll
        for (int i = 0; i < 16; ++i) km[i] = 0.f;
        for (int tt = 0; tt < 4; ++tt) {
            const int t = t0 + tt, pos = t % SEQ;
            bf16* prow = WSP(A,bf16,WS_PROJ) + (size_t)t * NPROJ;
            {
                float v[16]; { float lo[8], hi[8]; unpk8(*(const v4u*)(prow + PQ + 16 * lane), lo); unpk8(*(const v4u*)(prow + PQ + 16 * lane + 8), hi);
#pragma unroll
                    for (int i = 0; i < 8; ++i) { v[i] = lo[i]; v[8 + i] = hi[i]; } }
                float ss = 0.f;
#pragma unroll
                for (int i = 0; i < 16; ++i) ss += v[i] * v[i];
                ss += __shfl_xor(ss, 1); ss += __shfl_xor(ss, 2);
                const float rs = 1.0f / sqrtf(ss * (1.f / 64.f) + NORM_EPS);
                float lo[8], hi[8];
#pragma unroll
                for (int i = 0; i < 8; ++i) { lo[i] = v[i] * rs * qw[i]; hi[i] = v[8 + i] * rs * qw[8 + i]; }
                *(v4u*)(prow + PQ + 16 * lane) = pack8(lo); *(v4u*)(prow + PQ + 16 * lane + 8) = pack8(hi);
            }
            {
                float v[16]; { float lo[8], hi[8]; unpk8(*(const v4u*)(prow + PK + 16 * lane), lo); unpk8(*(const v4u*)(prow + PK + 16 * lane + 8), hi);
#pragma unroll
                    for (int i = 0; i < 8; ++i) { v[i] = lo[i]; v[8 + i] = hi[i]; } }
                float ss = 0.f;
#pragma unroll
                for (int i = 0; i < 16; ++i) ss += v[i] * v[i];
                ss += __shfl_xor(ss, 1); ss += __shfl_xor(ss, 2);
                const float rs = 1.0f / sqrtf(ss * (1.f / 64.f) + NORM_EPS);
                float lo[8], hi[8];
#pragma unroll
                for (int i = 0; i < 8; ++i) { lo[i] = v[i] * rs * kw[i]; hi[i] = v[8 + i] * rs * kw[8 + i]; km[i] += lo[i]; km[8 + i] += hi[i]; }
                *(v4u*)(prow + PK + 16 * lane) = pack8(lo); *(v4u*)(prow + PK + 16 * lane + 8) = pack8(hi);
            }
#pragma unroll 1
            for (int g6 = 0; g6 < 6; ++g6) {
                const int c0 = g6 * 512 + 8 * lane; float acc[8];
                { const f32x4 b0 = *(const f32x4*)(IN_CONVB(A) + c0), b1 = *(const f32x4*)(IN_CONVB(A) + c0 + 4);
#pragma unroll
                  for (int i = 0; i < 4; ++i) { acc[i] = b0[i]; acc[4 + i] = b1[i]; } }
#pragma unroll
                for (int j = 0; j < CONVK; ++j) {
                    if (pos - (CONVK - 1) + j >= 0) {
                        float xv[8]; unpk8(*(const v4u*)(WSP(A,bf16,WS_PROJ) + (size_t)(t - (CONVK - 1) + j) * NPROJ + PXBC + c0), xv);
                        const f32x4 w0 = *(const f32x4*)(IN_CONVW(A) + j * D_XBC + c0), w1 = *(const f32x4*)(IN_CONVW(A) + j * D_XBC + c0 + 4);
#pragma unroll
                        for (int i = 0; i < 4; ++i) { acc[i] += w0[i] * xv[i]; acc[4 + i] += w1[i] * xv[4 + i]; }
                    }
                }
#pragma unroll
                for (int i = 0; i < 8; ++i) acc[i] = silu_f(acc[i]);
                *(v4u*)(WSP(A,bf16,WS_XC) + (size_t)t * D_XBC + c0) = pack8(acc);
            }
            {
                float h[16]; const v2u* xr = (const v2u*)(WSP(A,bf16,WS_XN) + (size_t)t * D) + lane;
#pragma unroll
                for (int j = 0; j < 4; ++j) { const v2u w = xr[64 * j]; h[4 * j] = __uint_as_float(w.x << 16); h[4 * j + 1] = __uint_as_float(w.x & 0xffff0000u); h[4 * j + 2] = __uint_as_float(w.y << 16); h[4 * j + 3] = __uint_as_float(w.y & 0xffff0000u); }
                const float mine = rowdot32(h, WT, lane);
                if (lane < 32) { const float z = mine + IN_DTB(A)[lane]; WSP(A,float,WS_DT)[(size_t)t * 32 + lane] = fmaxf(z, 0.f) + log1pf(__expf(-fabsf(z))); }
            }
        }
        float* kmp = WSP(A,float,WS_KM) + ((size_t)(b * NH + (lane >> 2)) * NBLK + blk) * HD + 16 * (lane & 3);
#pragma unroll
        for (int i = 0; i < 16; ++i) unsafeAtomicAdd(kmp + i, km[i] * (1.f / MBLK));
    }
    __syncthreads();
}

__device__ __forceinline__ void p3_ssd(Frame& F, const Args& A) {
    LAS float* xs = (LAS float*)(F.lds + RING_OFF);
    LAS float* Bc = (LAS float*)(F.lds + RING_OFF + 16384);
    LAS float* Cc = (LAS float*)(F.lds + RING_OFF + 49152);
    LAS float* dtv = (LAS float*)(F.lds + RING_OFF + 81920);
    LAS float* yb = (LAS float*)(F.lds + RING_OFF + 82944);
    const int tid = F.tid;
    for (int unit = F.vcu; unit < BATCH * SSD_H; unit += F.G) {
        const int b = unit / SSD_H, h = unit % SSD_H, g = h / (SSD_H / NGRP);
        const float Aneg = -__expf(IN_ALOG(A)[h]), Dh = IN_DSKIP(A)[h];
        const int p = tid >> 3, ng = tid & 7;
        float st[16];
#pragma unroll
        for (int i = 0; i < 16; ++i) st[i] = 0.f;
        for (int ch = 0; ch < SEQ / 64; ++ch) {
            const int tb = b * SEQ + ch * 64;
            {
                const int r = tid >> 3, c8 = tid & 7;
                float v[8]; unpk8(*(const v4u*)(WSP(A,bf16,WS_XC) + (size_t)(tb + r) * D_XBC + h * 64 + 8 * c8), v);
#pragma unroll
                for (int i = 0; i < 8; ++i) xs[r * 64 + 8 * c8 + i] = v[i];
#pragma unroll
                for (int q = 0; q < 2; ++q) { const int idx = tid + 512 * q, rr = idx >> 4, c16 = idx & 15;
                    float bv[8], cv[8]; unpk8(*(const v4u*)(WSP(A,bf16,WS_XC) + (size_t)(tb + rr) * D_XBC + D_INNER + g * DSTATE + 8 * c16), bv); unpk8(*(const v4u*)(WSP(A,bf16,WS_XC) + (size_t)(tb + rr) * D_XBC + D_INNER + NGRP * DSTATE + g * DSTATE + 8 * c16), cv);
#pragma unroll
                    for (int i = 0; i < 8; ++i) { Bc[rr * 128 + 8 * c16 + i] = bv[i]; Cc[rr * 128 + 8 * c16 + i] = cv[i]; } }
                if (tid < 64) dtv[tid] = WSP(A,float,WS_DT)[(size_t)(tb + tid) * 32 + h];
            }
            __syncthreads();
            for (int tok = 0; tok < 64; ++tok) {
                const float dt = dtv[tok], decay = __expf(dt * Aneg), xdt = xs[tok * 64 + p] * dt;
                float yp = 0.f;
#pragma unroll
                for (int q = 0; q < 4; ++q) { const f32x4 bb = *(const LAS f32x4*)(Bc + tok * 128 + 16 * ng + 4 * q), cc = *(const LAS f32x4*)(Cc + tok * 128 + 16 * ng + 4 * q);
#pragma unroll
                    for (int i = 0; i < 4; ++i) { st[4 * q + i] = st[4 * q + i] * decay + bb[i] * xdt; yp += cc[i] * st[4 * q + i]; } }
                yp += __shfl_xor(yp, 1); yp += __shfl_xor(yp, 2); yp += __shfl_xor(yp, 4);
                if (ng == 0) yb[tok * 64 + p] = yp;
            }
            __syncthreads();
            {
                const int r = tid >> 3, c8 = tid & 7; const size_t t = (size_t)(tb + r);
                float z[8]; unpk8(*(const v4u*)(WSP(A,bf16,WS_PROJ) + t * NPROJ + PZ + h * 64 + 8 * c8), z);
                float o[8]; float ss = 0.f;
#pragma unroll
                for (int i = 0; i < 8; ++i) { const float y = yb[r * 64 + 8 * c8 + i] + Dh * xs[r * 64 + 8 * c8 + i]; o[i] = y * silu_f(z[i]); ss += o[i] * o[i]; }
                *(v4u*)(WSP(A,bf16,WS_YG) + t * D_INNER + h * 64 + 8 * c8) = pack8(o);
                ss += __shfl_xor(ss, 1); ss += __shfl_xor(ss, 2); ss += __shfl_xor(ss, 4);
                if (c8 == 0) WSP(A,float,WS_SSQ)[t * 32 + h] = ss;
            }
            __syncthreads();
        }
    }
}

__device__ __forceinline__ void p4_norm_attn(Frame& F, const Args& A) {
    const int lane = F.lane, gw = F.vcu * NWAVES + F.wave, NGW = F.G * NWAVES;
    for (int t = gw; t < M; t += NGW) {
        bf16* row = WSP(A,bf16,WS_YG) + (size_t)t * D_INNER + 32 * lane; const int g = lane >> 4;
        float ss = 0.f;
#pragma unroll
        for (int hh = 0; hh < 8; ++hh) ss += WSP(A,float,WS_SSQ)[(size_t)t * 32 + 8 * g + hh];
        const float rs = 1.0f / sqrtf(ss * (1.f / 512.f) + NORM_EPS);
#pragma unroll
        for (int q = 0; q < 4; ++q) { float v[8]; unpk8(*(const v4u*)(row + 8 * q), v); const f32x4 w0 = *(const f32x4*)(IN_SSDNW(A) + 32 * lane + 8 * q), w1 = *(const f32x4*)(IN_SSDNW(A) + 32 * lane + 8 * q + 4);
#pragma unroll
            for (int i = 0; i < 4; ++i) { v[i] = v[i] * rs * w0[i]; v[4 + i] = v[4 + i] * rs * w1[i]; }
            *(v4u*)(row + 8 * q) = pack8(v); }
    }
    const float qwm = wave_max(fabsf(IN_QNW(A)[lane])), kwm = wave_max(fabsf(IN_KNW(A)[lane]));
    const float REF = 8.0f * qwm * kwm * 1.4426950408889634f + 0.25f;
    const bf16* QN = WSP(A,bf16,WS_PROJ) + PQ; const bf16* KN = WSP(A,bf16,WS_PROJ) + PK; const bf16* VV = WSP(A,bf16,WS_PROJ) + PV;
    for (long a = gw; a < (long)M * NH; a += NGW) {
        const int grp = (int)(a >> 7), within = (int)(a & 127), h = within >> 3, t = grp * 8 + (within & 7);
        const int b = t / SEQ, pos = t % SEQ, qb = pos >> 8;
        const bf16* qp = QN + (size_t)t * NPROJ + h * 64;
        float q[64];
#pragma unroll
        for (int c = 0; c < 8; ++c) { float v[8]; unpk8(*(const v4u*)(qp + 8 * c), v);
#pragma unroll
            for (int i = 0; i < 8; ++i) q[8 * c + i] = v[i]; }
        const float qd = bf2f(qp[lane]);
        float sc[7];
#pragma unroll
        for (int j = 0; j < 7; ++j) { sc[j] = -3.0e38f; if (j < qb) sc[j] = wave_sum(qd * WSP(A,float,WS_KM)[((size_t)(b * NH + h) * NBLK + j) * HD + lane]); }
        unsigned sel = 0u; const int nsel = qb < MOBA_TOPK ? qb : MOBA_TOPK;
#pragma unroll
        for (int k = 0; k < MOBA_TOPK; ++k) if (k < nsel) { float best = -3.0e38f; int bi = 0;
#pragma unroll
            for (int j = 0; j < 7; ++j) if (j < qb && !((sel >> j) & 1u) && sc[j] > best) { best = sc[j]; bi = j; }
            sel |= 1u << bi; }
        sel |= 1u << qb;
        float o = 0.f, lsum = 0.f;
        for (int j = 0; j <= qb; ++j) {
            if (!((sel >> j) & 1u)) continue;
            for (int tile = 0; tile < 4; ++tile) {
                const int kbase = j * MBLK + tile * 64; if (j == qb && kbase > pos) break;
                const int kk = kbase + lane; const bf16* kp = KN + (size_t)(b * SEQ + kk) * NPROJ + h * 64;
                float dot = 0.f;
#pragma unroll
                for (int c = 0; c < 8; ++c) { float v[8]; unpk8(*(const v4u*)(kp + 8 * c), v);
#pragma unroll
                    for (int i = 0; i < 8; ++i) dot += v[i] * q[8 * c + i]; }
                const bool valid = (j < qb) || (kk <= pos);
                const float pr = valid ? __builtin_amdgcn_exp2f(dot - REF) : 0.f; lsum += pr;
                const bf16* vp = VV + (size_t)(b * SEQ + kbase) * NPROJ + h * 64 + lane;
#pragma unroll 16
                for (int jj = 0; jj < 64; ++jj) { const float pj = __shfl(pr, jj); o += pj * bf2f(vp[(size_t)jj * NPROJ]); }
            }
        }
        const float l = wave_sum(lsum);
        WSP(A,bf16,WS_AO)[(size_t)t * D + h * 64 + lane] = (bf16)f2bf(o / l);
    }
}

__device__ __forceinline__ void p7_route(Frame& F, const Args& A) {
    stage_wt(F, WSP(A,float,WS_WRT));
    const LAS float* WT = (const LAS float*)(F.lds + RING_OFF);
    const int lane = F.lane, gw = F.vcu * NWAVES + F.wave, NGW = F.G * NWAVES;
    for (int t = gw; t < M; t += NGW) {
        const f32x4* xr = (const f32x4*)((A).out + (size_t)t * D) + lane; const f32x4* wr = (const f32x4*)IN_LN2W(A) + lane;
        f32x4 v[4]; float s = 0.f;
#pragma unroll
        for (int j = 0; j < 4; ++j) { v[j] = xr[64 * j]; s += (v[j].x * v[j].x + v[j].y * v[j].y) + (v[j].z * v[j].z + v[j].w * v[j].w); }
        const float rs = 1.0f / sqrtf(wave_sum(s) * (1.f / D) + NORM_EPS);
        float h[16]; v2u* o8 = (v2u*)(WSP(A,bf16,WS_H2) + (size_t)t * D) + lane;
#pragma unroll
        for (int j = 0; j < 4; ++j) { const f32x4 w = wr[64 * j]; h[4 * j] = v[j].x * rs * w.x; h[4 * j + 1] = v[j].y * rs * w.y; h[4 * j + 2] = v[j].z * rs * w.z; h[4 * j + 3] = v[j].w * rs * w.w;
            v2u o; o.x = pk2(h[4 * j], h[4 * j + 1]); o.y = pk2(h[4 * j + 2], h[4 * j + 3]); o8[64 * j] = o; }
        float val = rowdot32(h, WT, lane); val = (lane < 32) ? val + IN_BR(A)[lane & 31] : -3.0e38f;
        float tv[4]; int ti[4];
#pragma unroll
        for (int k = 0; k < 4; ++k) { const float mx = wave_max(val); const unsigned long long bm = __ballot(val == mx); const int idx = __builtin_ctzll(bm);
            tv[k] = mx; ti[k] = idx; if (lane == idx) val = -3.0e38f; }
        float ex[4], es = 0.f;
#pragma unroll
        for (int k = 0; k < 4; ++k) { ex[k] = __expf(tv[k] - tv[0]); es += ex[k]; }
        if (lane == 0) {
#pragma unroll
            for (int k = 0; k < 4; ++k) { const unsigned j = __hip_atomic_fetch_add((WSP(A,unsigned,WS_CTL) + CW_CNT) + ti[k], 1u, RLX_AGENT); WSP(A,int,WS_TOKL)[ti[k] * EXPCAP + (int)j] = t * 4 + k; WSP(A,float,WS_GATEW)[t * 4 + k] = ex[k] / es; }
        }
    }
    __syncthreads();
}

__device__ __forceinline__ int moe_tables(Frame& F, const Args& A) {
    LAS int* tile_e = (LAS int*)(F.lds + TILEE_OFF); LAS int* rowb = (LAS int*)(F.lds + ROWB_OFF); LAS int* cntl = (LAS int*)(F.lds + CNTL_OFF);
    if (F.tid == 0) { int acc = 0, rt = 0;
        for (int e = 0; e < NEXP; ++e) { int c = (int)__hip_atomic_load((WSP(A,unsigned,WS_CTL) + CW_CNT) + e, RLX_AGENT); if (c > EXPCAP) c = EXPCAP; cntl[e] = c; rowb[e] = acc; const int n = (c + 255) >> 8; for (int i = 0; i < n; ++i) tile_e[rt++] = e; acc += n * 256; }
        rowb[NEXP] = acc; }
    __syncthreads();
    return rowb[NEXP] >> 8;
}
__device__ __forceinline__ void p8_gather(Frame& F, const Args& A) {
    const int NT = moe_tables(F, A);
    const LAS int* rowb = (const LAS int*)(F.lds + ROWB_OFF); const LAS int* cntl = (const LAS int*)(F.lds + CNTL_OFF);
    const int lane = F.lane, gw = F.vcu * NWAVES + F.wave, NGW = F.G * NWAVES, total = NT * 256;
    for (int r = gw; r < total; r += NGW) {
        int e = 0;
#pragma unroll
        for (int q = 1; q < NEXP; ++q) e += (rowb[q] <= r) ? 1 : 0;
        const int j = r - rowb[e];
        if (j < cntl[e]) { const int a = WSP(A,int,WS_TOKL)[e * EXPCAP + j], t = a >> 2;
            const v4u x0 = *(const v4u*)(WSP(A,bf16,WS_H2) + (size_t)t * D + 16 * lane), x1 = *(const v4u*)(WSP(A,bf16,WS_H2) + (size_t)t * D + 16 * lane + 8);
            *(v4u*)(WSP(A,bf16,WS_XG) + (size_t)r * D + 16 * lane) = x0; *(v4u*)(WSP(A,bf16,WS_XG) + (size_t)r * D + 16 * lane + 8) = x1;
            if (lane == 0) { WSP(A,float,WS_ROWW)[r] = WSP(A,float,WS_GATEW)[a]; WSP(A,int,WS_POS)[a] = r; } }
        else if (lane == 0) WSP(A,float,WS_ROWW)[r] = 0.f;
    }
    __syncthreads();
}
__device__ __forceinline__ void p11_combine(Frame& F, const Args& A) {
    const int lane = F.lane, gw = F.vcu * NWAVES + F.wave, NGW = F.G * NWAVES;
    for (int t = gw; t < M; t += NGW) {
        f32x4* xr = (f32x4*)((A).out + (size_t)t * D) + lane; f32x4 v[4];
#pragma unroll
        for (int j = 0; j < 4; ++j) v[j] = xr[64 * j];
#pragma unroll
        for (int k = 0; k < 4; ++k) { const int r = WSP(A,int,WS_POS)[t * 4 + k]; const v2u* yr = (const v2u*)(WSP(A,bf16,WS_Y) + (size_t)r * D) + lane;
#pragma unroll
            for (int j = 0; j < 4; ++j) { const v2u w = yr[64 * j]; v[j].x += __uint_as_float(w.x << 16); v[j].y += __uint_as_float(w.x & 0xffff0000u); v[j].z += __uint_as_float(w.y << 16); v[j].w += __uint_as_float(w.y & 0xffff0000u); } }
#pragma unroll
        for (int j = 0; j < 4; ++j) xr[64 * j] = v[j];
    }
}
enum { PH_PRO = 0, PH_INPROJ, PH_PREP, PH_SSD, PH_ATTN, PH_OPROJ, PH_WOUT, PH_ROUTE, PH_GATHER, PH_GU, PH_DOWN, PH_COMB, N_PHASES };
__global__ void __launch_bounds__(NWAVES * 64, 2) mk_fwd(Args args) {
    extern __shared__ __attribute__((aligned(16))) unsigned char lds[];
    Frame F;
    F.lds = (LAS unsigned char*)lds;
    F.MISC = (volatile LAS unsigned*)(F.lds + MISC_OFF);
    F.tid = threadIdx.x; F.lane = F.tid & 63; F.wave = __builtin_amdgcn_readfirstlane(F.tid >> 6);
    F.G = gridDim.x; { const int bx = blockIdx.x; F.vcu = (F.G % 8 == 0) ? (bx % 8) * (F.G / 8) + bx / 8 : bx; }
    const Args& A = args;
    F.ctl = (gu32*)(args.ws + WS_CTL);
    for (int u = F.tid; u < (LDS_BYTES - LDSCTL_OFF) / 4; u += NWAVES * 64) ((LAS unsigned*)(F.lds + LDSCTL_OFF))[u] = 0u;
    __syncthreads();
    XcdBarrier bar; bar.bar = (unsigned*)(F.ctl + CW_BAR); bar.x = 0; bar.st = nullptr;
    if (!MK_PER_PHASE) bar = xcd_barrier_post((unsigned*)(F.ctl + CW_BAR), F.MISC + 8);
    const int lo = args.ph_lo, hi = args.ph_hi;
#ifndef PH_MASK
#define PH_MASK 0xFFF
#endif
#define IN(k) ((((PH_MASK) >> (k)) & 1) && lo <= (k) && (k) < hi)
#define SEAM(k) do { if (!MK_PER_PHASE && IN(k) && IN((k) + 1)) xcd_barrier(bar); } while (0)

    if (IN(PH_PRO)) { p0_prologue(F, A); SEAM(PH_PRO); }
    if (IN(PH_INPROJ)) {
        pg8::Gemm g{WSP(A,bf16,WS_XN), WSP(A,bf16,WS_WIN), M, NPROJ, D}; pg8::StaticOrder S; S.init(M, NPROJ, F.G, (int)blockIdx.x);
        pg8::EpiPlain E{WSP(A,bf16,WS_PROJ), NPROJ};
        pg8::gemm_phase<pg8::EpiPlain, pg8::StaticOrder, true, true>(F.lds + RING_OFF, g, S, E);
        SEAM(PH_INPROJ);
    }
    if (IN(PH_PREP)) { p2_prep(F, A); SEAM(PH_PREP); }
    if (IN(PH_SSD)) { p3_ssd(F, A); SEAM(PH_SSD); }
    if (IN(PH_ATTN)) { p4_norm_attn(F, A); SEAM(PH_ATTN); }
    if (IN(PH_OPROJ)) {
        { pg8::Gemm g{WSP(A,bf16,WS_AO), WSP(A,bf16,WS_WOA), M, D, D}; pg8::StaticOrder S; S.init(M, D, F.G, (int)blockIdx.x);
          pg8::EpiGate1 E{WSP(A,bf16,WS_PROJ) + PGATE, NPROJ, IN_GATEB(A), WSP(A,float,WS_MIXF)};
          pg8::gemm_phase<pg8::EpiGate1, pg8::StaticOrder, true, true>(F.lds + RING_OFF, g, S, E); }
        { pg8::Gemm g{WSP(A,bf16,WS_YG), WSP(A,bf16,WS_WOS), M, D, D_INNER}; pg8::StaticOrder S; S.init(M, D, F.G, (int)blockIdx.x);
          pg8::EpiGate2 E{WSP(A,bf16,WS_PROJ) + PGATE + D, NPROJ, IN_GATEB(A) + D, WSP(A,float,WS_MIXF), WSP(A,bf16,WS_MIX)};
          pg8::gemm_phase<pg8::EpiGate2, pg8::StaticOrder, true, true>(F.lds + RING_OFF, g, S, E); }
        SEAM(PH_OPROJ);
    }
    if (IN(PH_WOUT)) {
        pg8::Gemm g{WSP(A,bf16,WS_MIX), WSP(A,bf16,WS_WOUT), M, D, D}; pg8::StaticOrder S; S.init(M, D, F.G, (int)blockIdx.x);
        pg8::EpiResid E{IN_X(A), (A).out};
        pg8::gemm_phase<pg8::EpiResid, pg8::StaticOrder, true, true>(F.lds + RING_OFF, g, S, E);
        SEAM(PH_WOUT);
    }
    if (IN(PH_ROUTE)) { p7_route(F, A); SEAM(PH_ROUTE); }
    if (IN(PH_GATHER)) { p8_gather(F, A); SEAM(PH_GATHER); }
    if (IN(PH_GU)) {
        const int NT = moe_tables(F, A);
        pg8::Gemm g{WSP(A,bf16,WS_XG), WSP(A,bf16,WS_WGU), NT * 256, 2048, D}; pg8::GroupedOrder S{8, NT, F.G, (int)blockIdx.x, (const LAS int*)(F.lds + TILEE_OFF)};
        pg8::EpiSwiglu E{WSP(A,bf16,WS_ACT), IN_BGU(A)};
        pg8::gemm_phase<pg8::EpiSwiglu, pg8::GroupedOrder, true, true>(F.lds + RING_OFF, g, S, E);
        SEAM(PH_GU);
    }
    if (IN(PH_DOWN)) {
        const int NT = moe_tables(F, A);
        pg8::Gemm g{WSP(A,bf16,WS_ACT), WSP(A,bf16,WS_WDN), NT * 256, 1024, D}; pg8::GroupedOrder S{4, NT, F.G, (int)blockIdx.x, (const LAS int*)(F.lds + TILEE_OFF)};
        pg8::EpiDown E{WSP(A,bf16,WS_Y), IN_BDN(A), WSP(A,float,WS_ROWW)};
        pg8::gemm_phase<pg8::EpiDown, pg8::GroupedOrder, true, true>(F.lds + RING_OFF, g, S, E);
        SEAM(PH_DOWN);
    }
    if (IN(PH_COMB)) { p11_combine(F, A); }
#undef IN
#undef SEAM
}

extern "C" void kernel_launch(void* const* d_in, const int* in_sizes, int n_in, void* d_out, int out_size, void* d_ws, size_t ws_size, hipStream_t stream) {
    static int grid = 0;
    if (grid == 0) {
        if (n_in != 22 || in_sizes[0] != M * D || out_size != M * D || ws_size < WS_END) { fprintf(stderr, "kernel_launch: unexpected shapes / workspace (n_in %d, in0 %d, out %d, ws %zu, need %zu); nothing launched\n", n_in, n_in > 0 ? in_sizes[0] : -1, out_size, ws_size, (size_t)WS_END); grid = -1; return; }
        int dev = 0, cus = 0, per_cu = 0;
        if (hipGetDevice(&dev) != hipSuccess || hipDeviceGetAttribute(&cus, hipDeviceAttributeMultiprocessorCount, dev) != hipSuccess) { fprintf(stderr, "kernel_launch: device query failed\n"); grid = -1; return; }
        if (hipFuncSetAttribute((const void*)mk_fwd, hipFuncAttributeMaxDynamicSharedMemorySize, LDS_BYTES) != hipSuccess) { fprintf(stderr, "kernel_launch: hipFuncSetAttribute failed\n"); grid = -1; return; }
        if (hipOccupancyMaxActiveBlocksPerMultiprocessor(&per_cu, (const void*)mk_fwd, NWAVES * 64, LDS_BYTES) != hipSuccess || per_cu < 1) fprintf(stderr, "kernel_launch: note: occupancy query reports %d blocks per CU\n", per_cu);
        (void)hipGetLastError();
        grid = cus;
    }
    if (grid < 0) return;
    if (hipMemsetAsync((char*)d_ws + WS_CTL, 0, CTL_ZERO_BYTES, stream) != hipSuccess) { fprintf(stderr, "kernel_launch: memset failed\n"); return; }
    Args a{};
    for (int i = 0; i < 22; ++i) a.in[i] = (const float*)d_in[i];
    a.out = (float*)d_out; a.ws = (unsigned char*)d_ws;
#if MK_PER_PHASE
    for (int p = 0; p < N_PHASES; ++p) { a.ph_lo = p; a.ph_hi = p + 1; hipLaunchKernelGGL(mk_fwd, dim3(grid), dim3(NWAVES * 64), LDS_BYTES, stream, a); }
#else
    a.ph_lo = 0; a.ph_hi = N_PHASES;
    hipLaunchKernelGGL(mk_fwd, dim3(grid), dim3(NWAVES * 64), LDS_BYTES, stream, a);
#endif
    const hipError_t le = hipPeekAtLastError();
    if (le != hipSuccess) fprintf(stderr, "kernel_launch: launch failed: %s\n", hipGetErrorName(le));
}
```

```cpp
#include <hip/hip_runtime.h>
#include <cstdio>
#include <cstdint>
namespace pg8 {
#define PG8_LAS __attribute__((address_space(3)))
typedef unsigned short bf16_t;
typedef short bf16x8 __attribute__((ext_vector_type(8)));
typedef float f32x4 __attribute__((ext_vector_type(4)));
typedef unsigned u32x4 __attribute__((ext_vector_type(4)));
constexpr int BM = 256, BK = 64, HALF = 128, HTB = HALF * BK * 2  , STAGE_BYTES = 8 * HTB, NXCD = 8, WGM = 8;

__host__ __device__ __forceinline__ int lds_byte(int r, int c) { const int st = (r >> 4) * 2 + (c >> 5), rr = r & 15, cc = c & 31, ob = rr * 64 + cc * 2; return st * 1024 + (ob ^ (((ob >> 9) & 1) << 5)); }
__host__ __device__ __forceinline__ void stage_rc(int b, int& R, int& C) { const int st = b / 1024, sb = b % 1024, swz = sb ^ (((sb >> 9) & 1) << 5); R = (st >> 1) * 16 + swz / 64; C = (st & 1) * 32 + (swz % 64) / 2; }
__host__ __device__ __forceinline__ int perm32(int rho) { const int n = rho >> 4, i = rho & 15; return 8 * (i >> 2) + 4 * n + (i & 3); }

struct Unit { int pm, pn; };
struct Gemm { const bf16_t* A; const bf16_t* Bt; int M, N, K; };

struct StaticOrder {
    int nM, nN, nwg, G, c;
    __host__ __device__ void init(int M, int N, int G_, int c_) { nM = M / BM; nN = N / BM; nwg = nM * nN; G = G_; c = c_; }
    __host__ __device__ bool next(int i, Unit& u) const {
        const long L = (long)i * G + c; if (L >= nwg) return false;
        int wgid = (int)L; { const int q = nwg / NXCD, r = nwg % NXCD, xcd = wgid % NXCD, off = wgid / NXCD; wgid = (xcd < r ? xcd * (q + 1) : r * (q + 1) + (xcd - r) * q) + off; }
        const int nig = WGM * nN, gid = wgid / nig, fm = gid * WGM, gsz = (nM - fm) < WGM ? (nM - fm) : WGM;
        u.pm = fm + ((wgid % nig) % gsz); u.pn = (wgid % nig) / gsz; return true;
    }
    __device__ __forceinline__ void a_ready(const Unit&) const {}
    __device__ __forceinline__ void done(const Unit&) const {}
};

struct GroupedOrder {
    int nN, NT, G, c; const PG8_LAS int* tile_e;
    __device__ __forceinline__ bool next(int i, Unit& u) const {
        const long L = (long)i * G + c; const int nwg = NT * nN; if (L >= nwg) return false;
        int wgid = (int)L; { const int q = nwg / NXCD, r = nwg % NXCD, xcd = wgid % NXCD, off = wgid / NXCD; wgid = (xcd < r ? xcd * (q + 1) : r * (q + 1) + (xcd - r) * q) + off; }
        const int rt = wgid / nN, pl = wgid % nN;
        u.pm = rt; u.pn = tile_e[rt] * nN + pl; return true;
    }
    __device__ __forceinline__ void a_ready(const Unit&) const {}
    __device__ __forceinline__ void done(const Unit&) const {}
};

__device__ __forceinline__ unsigned cvt_pk_bf16(float lo, float hi) { unsigned r; asm volatile("v_cvt_pk_bf16_f32 %0, %1, %2" : "=v"(r) : "v"(lo), "v"(hi)); return r; }
__device__ __forceinline__ float sigm(float x) { return __builtin_amdgcn_rcpf(1.f + __builtin_amdgcn_exp2f(-1.44269504f * x)); }
__device__ __forceinline__ void unpack8(const u32x4 w, float (&f)[8]) {
#pragma unroll
    for (int i = 0; i < 4; ++i) { f[2 * i] = __uint_as_float(w[i] << 16); f[2 * i + 1] = __uint_as_float(w[i] & 0xffff0000u); }
}
struct EpiPlain {
    static constexpr bool PERM = true, AFTER_DRAIN = false; bf16_t* O; int ldc;
    __device__ __forceinline__ void operator()(const f32x4 (&acc)[2][2][4][2], const Unit& u, int wr, int wc, int fr, int fq) const {
        const int row0 = u.pm * BM + wr * 64 + fr, col0 = u.pn * BM + wc * 32 + 8 * fq;
#pragma unroll
        for (int ai = 0; ai < 2; ++ai)
#pragma unroll
            for (int m = 0; m < 4; ++m) { bf16_t* rowp = O + (size_t)(row0 + ai * HALF + m * 16) * ldc + col0;
#pragma unroll
                for (int bj = 0; bj < 2; ++bj) { const f32x4 v0 = acc[ai][bj][m][0], v1 = acc[ai][bj][m][1]; u32x4 w;
                    w.x = cvt_pk_bf16(v0[0], v0[1]); w.y = cvt_pk_bf16(v0[2], v0[3]); w.z = cvt_pk_bf16(v1[0], v1[1]); w.w = cvt_pk_bf16(v1[2], v1[3]);
                    *(u32x4*)(rowp + bj * HALF) = w; } }
    }
};
struct EpiGate1 {
    static constexpr bool PERM = true, AFTER_DRAIN = false; const bf16_t* Gp; int ldg; const float* gb; float* MIXF;
    __device__ __forceinline__ void operator()(const f32x4 (&acc)[2][2][4][2], const Unit& u, int wr, int wc, int fr, int fq) const {
        const int row0 = u.pm * BM + wr * 64 + fr, col0 = u.pn * BM + wc * 32 + 8 * fq;
#pragma unroll
        for (int ai = 0; ai < 2; ++ai)
#pragma unroll
            for (int m = 0; m < 4; ++m) { const size_t row = (size_t)(row0 + ai * HALF + m * 16);
#pragma unroll
                for (int bj = 0; bj < 2; ++bj) { const int c = col0 + bj * HALF; float g[8]; unpack8(*(const u32x4*)(Gp + row * ldg + c), g);
                    const f32x4 b0 = *(const f32x4*)(gb + c), b1 = *(const f32x4*)(gb + c + 4); const f32x4 v0 = acc[ai][bj][m][0], v1 = acc[ai][bj][m][1]; f32x4 o0, o1;
#pragma unroll
                    for (int i = 0; i < 4; ++i) { o0[i] = sigm(g[i] + b0[i]) * v0[i]; o1[i] = sigm(g[4 + i] + b1[i]) * v1[i]; }
                    *(f32x4*)(MIXF + row * 1024 + c) = o0; *(f32x4*)(MIXF + row * 1024 + c + 4) = o1; } }
    }
};
struct EpiGate2 {
    static constexpr bool PERM = true, AFTER_DRAIN = false; const bf16_t* Gp; int ldg; const float* gb; const float* MIXF; bf16_t* MIX;
    __device__ __forceinline__ void operator()(const f32x4 (&acc)[2][2][4][2], const Unit& u, int wr, int wc, int fr, int fq) const {
        const int row0 = u.pm * BM + wr * 64 + fr, col0 = u.pn * BM + wc * 32 + 8 * fq;
#pragma unroll
        for (int ai = 0; ai < 2; ++ai)
#pragma unroll
            for (int m = 0; m < 4; ++m) { const size_t row = (size_t)(row0 + ai * HALF + m * 16);
#pragma unroll
                for (int bj = 0; bj < 2; ++bj) { const int c = col0 + bj * HALF; float g[8]; unpack8(*(const u32x4*)(Gp + row * ldg + c), g);
                    const f32x4 b0 = *(const f32x4*)(gb + c), b1 = *(const f32x4*)(gb + c + 4); const f32x4 v0 = acc[ai][bj][m][0], v1 = acc[ai][bj][m][1];
                    const f32x4 p0 = *(const f32x4*)(MIXF + row * 1024 + c), p1 = *(const f32x4*)(MIXF + row * 1024 + c + 4); f32x4 o0, o1;
#pragma unroll
                    for (int i = 0; i < 4; ++i) { o0[i] = p0[i] + sigm(g[i] + b0[i]) * v0[i]; o1[i] = p1[i] + sigm(g[4 + i] + b1[i]) * v1[i]; }
                    u32x4 w; w.x = cvt_pk_bf16(o0[0], o0[1]); w.y = cvt_pk_bf16(o0[2], o0[3]); w.z = cvt_pk_bf16(o1[0], o1[1]); w.w = cvt_pk_bf16(o1[2], o1[3]);
                    *(u32x4*)(MIX + row * 1024 + c) = w; } }
    }
};
struct EpiResid {
    static constexpr bool PERM = true, AFTER_DRAIN = false; const float* base; float* out;
    __device__ __forceinline__ void operator()(const f32x4 (&acc)[2][2][4][2], const Unit& u, int wr, int wc, int fr, int fq) const {
        const int row0 = u.pm * BM + wr * 64 + fr, col0 = u.pn * BM + wc * 32 + 8 * fq;
#pragma unroll
        for (int ai = 0; ai < 2; ++ai)
#pragma unroll
            for (int m = 0; m < 4; ++m) { const size_t row = (size_t)(row0 + ai * HALF + m * 16);
#pragma unroll
                for (int bj = 0; bj < 2; ++bj) { const size_t o = row * 1024 + col0 + bj * HALF;
                    const f32x4 p0 = *(const f32x4*)(base + o), p1 = *(const f32x4*)(base + o + 4);
                    *(f32x4*)(out + o) = p0 + acc[ai][bj][m][0]; *(f32x4*)(out + o + 4) = p1 + acc[ai][bj][m][1]; } }
    }
};
struct EpiSwiglu {
    static constexpr bool PERM = true, AFTER_DRAIN = false; bf16_t* ACT; const float* bgu;
    __device__ __forceinline__ void operator()(const f32x4 (&acc)[2][2][4][2], const Unit& u, int wr, int wc, int fr, int fq) const {
        const int e = u.pn >> 3, pl = u.pn & 7, j0 = 128 * pl + wc * 32 + 8 * fq; const int row0 = u.pm * BM + wr * 64 + fr;
        float bg[8], bu[8];
        { const float* bs = bgu + (size_t)e * 2048 + 2 * j0;
#pragma unroll
          for (int q = 0; q < 4; ++q) { const f32x4 t = *(const f32x4*)(bs + 4 * q); bg[2 * q] = t[0]; bu[2 * q] = t[1]; bg[2 * q + 1] = t[2]; bu[2 * q + 1] = t[3]; } }
#pragma unroll
        for (int ai = 0; ai < 2; ++ai)
#pragma unroll
            for (int m = 0; m < 4; ++m) { const size_t row = (size_t)(row0 + ai * HALF + m * 16); float a[8];
#pragma unroll
                for (int i = 0; i < 8; ++i) { const float gr = (i < 4 ? acc[ai][0][m][0][i & 3] : acc[ai][0][m][1][i & 3]) + bg[i], ur = (i < 4 ? acc[ai][1][m][0][i & 3] : acc[ai][1][m][1][i & 3]) + bu[i];
                    const float g = fminf(gr, 7.0f), uu = fminf(fmaxf(ur, -7.0f), 7.0f); a[i] = (uu + 1.0f) * (g * sigm(1.702f * g)); }
                u32x4 w; w.x = cvt_pk_bf16(a[0], a[1]); w.y = cvt_pk_bf16(a[2], a[3]); w.z = cvt_pk_bf16(a[4], a[5]); w.w = cvt_pk_bf16(a[6], a[7]);
                *(u32x4*)(ACT + row * 1024 + j0) = w; }
    }
};
struct EpiDown {
    static constexpr bool PERM = true, AFTER_DRAIN = false; bf16_t* Y; const float* bd; const float* roww;
    __device__ __forceinline__ void operator()(const f32x4 (&acc)[2][2][4][2], const Unit& u, int wr, int wc, int fr, int fq) const {
        const int e = u.pn >> 2, pl = u.pn & 3, col0 = pl * BM + wc * 32 + 8 * fq; const int row0 = u.pm * BM + wr * 64 + fr;
#pragma unroll
        for (int ai = 0; ai < 2; ++ai)
#pragma unroll
            for (int m = 0; m < 4; ++m) { const size_t row = (size_t)(row0 + ai * HALF + m * 16); const float rw = roww[row];
#pragma unroll
                for (int bj = 0; bj < 2; ++bj) { const int c = col0 + bj * HALF; const f32x4 b0 = *(const f32x4*)(bd + (size_t)e * 1024 + c), b1 = *(const f32x4*)(bd + (size_t)e * 1024 + c + 4);
                    const f32x4 v0 = (acc[ai][bj][m][0] + b0) * rw, v1 = (acc[ai][bj][m][1] + b1) * rw; u32x4 w;
                    w.x = cvt_pk_bf16(v0[0], v0[1]); w.y = cvt_pk_bf16(v0[2], v0[3]); w.z = cvt_pk_bf16(v1[0], v1[1]); w.w = cvt_pk_bf16(v1[2], v1[3]);
                    *(u32x4*)(Y + row * 1024 + c) = w; } }
    }
};
template <class Epi, class Sched, bool ALIGN_EPI = false, bool SP2 = false>
__device__ __forceinline__ void gemm_phase(PG8_LAS unsigned char* lds, const Gemm g, const Sched& S, const Epi& E) {
    const int tid = threadIdx.x, wid = __builtin_amdgcn_readfirstlane(tid >> 6), lane = tid & 63, wr = wid >> 2, wc = wid & 3, fr = lane & 15, fq = lane >> 4;
    const int K = g.K, nt = K / BK;
    unsigned voffA[2], voffB[2];
#pragma unroll
    for (int i = 0; i < 2; ++i) { int R, C; stage_rc(tid * 16 + i * 8192, R, C); const int Rb = Epi::PERM ? ((R & ~31) + perm32(R & 31)) : R;
        voffA[i] = (unsigned)(R * K + C) * 2u; voffB[i] = (unsigned)(Rb * K + C) * 2u; }
    const size_t kstep = (size_t)(BK * 2);
    const size_t hstep = (size_t)HALF * K * 2;
    const size_t tstep = 2 * hstep;
    const unsigned ldsw = (unsigned)wid * 1024u;
    const int aoff = lds_byte(wr * 64 + fr, fq * 8), boff = lds_byte(wc * 32 + fr, fq * 8);
#define PG8_SA(b, h) (((b) * 2 + (h)) * HTB)
#define PG8_SB(b, h) ((4 + (b) * 2 + (h)) * HTB)
#define PG8_STAGE(bufoff, gbase, voff) do { _Pragma("unroll") for (int _i = 0; _i < 2; ++_i) \
        __builtin_amdgcn_global_load_lds((const unsigned*)((const char*)(gbase) + (voff)[_i]), (PG8_LAS unsigned*)(lds + (bufoff) + ldsw + _i * 8192), 16, 0, 0); } while (0)
#define PG8_LDA(dst, b, h) do { _Pragma("unroll") for (int m = 0; m < 4; ++m) _Pragma("unroll") for (int k = 0; k < 2; ++k) dst[m][k] = *(const PG8_LAS bf16x8*)(lds + PG8_SA(b, h) + aoff + m * 2048 + k * 1024); } while (0)
#define PG8_LDB(dst, b, h) do { _Pragma("unroll") for (int n = 0; n < 2; ++n) _Pragma("unroll") for (int k = 0; k < 2; ++k) dst[n][k] = *(const PG8_LAS bf16x8*)(lds + PG8_SB(b, h) + boff + n * 2048 + k * 1024); } while (0)
#define PG8_MMA(ai, bj, At, Bt) do { __builtin_amdgcn_s_setprio(1); _Pragma("unroll") for (int m = 0; m < 4; ++m) _Pragma("unroll") for (int n = 0; n < 2; ++n) _Pragma("unroll") for (int k = 0; k < 2; ++k) \
        acc[ai][bj][m][n] = __builtin_amdgcn_mfma_f32_16x16x32_bf16(Bt[n][k], At[m][k], acc[ai][bj][m][n], 0, 0, 0); __builtin_amdgcn_s_setprio(0); } while (0)
#define PG8_WAIT_V(n) asm volatile("s_waitcnt vmcnt(" #n ")" ::: "memory")
#define PG8_WAIT_L(n) asm volatile("s_waitcnt lgkmcnt(" #n ")" ::: "memory")
#define PG8_BAR __builtin_amdgcn_s_barrier()
#define PG8_SCHED __builtin_amdgcn_sched_barrier(0)
    Unit cur, nxt; int ui = 0;
    if (!S.next(0, cur)) return;
    f32x4 acc[2][2][4][2];
#pragma unroll
    for (int a = 0; a < 2; ++a)
#pragma unroll
        for (int b = 0; b < 2; ++b)
#pragma unroll
            for (int m = 0; m < 4; ++m)
#pragma unroll
                for (int n = 0; n < 2; ++n) acc[a][b][m][n] = (f32x4){0.f, 0.f, 0.f, 0.f};
    bf16x8 At[4][2], B0[2][2], B1[2][2];
    const char* cA = (const char*)g.A + (size_t)cur.pm * tstep; const char* cB = (const char*)g.Bt + (size_t)cur.pn * tstep;
    S.a_ready(cur);
    if constexpr (SP2) {
        PG8_STAGE(PG8_SB(0, 0), cB, voffB); PG8_STAGE(PG8_SB(0, 1), cB + hstep, voffB); PG8_STAGE(PG8_SA(0, 0), cA, voffA); PG8_STAGE(PG8_SA(0, 1), cA + hstep, voffA);
        if (wr == 1) PG8_BAR;
        PG8_WAIT_V(2); PG8_BAR;
        PG8_STAGE(PG8_SB(1, 0), cB + kstep, voffB); PG8_STAGE(PG8_SA(1, 0), cA + kstep, voffA); PG8_STAGE(PG8_SB(1, 1), cB + hstep + kstep, voffB);
        PG8_WAIT_V(6); PG8_BAR;
    } else {
        PG8_STAGE(PG8_SB(0, 0), cB, voffB); PG8_STAGE(PG8_SA(0, 0), cA, voffA); PG8_STAGE(PG8_SB(0, 1), cB + hstep, voffB); PG8_STAGE(PG8_SA(0, 1), cA + hstep, voffA);
        if (wr == 1) PG8_BAR;
        PG8_WAIT_V(4); PG8_BAR;
        PG8_STAGE(PG8_SB(1, 0), cB + kstep, voffB); PG8_STAGE(PG8_SA(1, 0), cA + kstep, voffA); PG8_STAGE(PG8_SB(1, 1), cB + hstep + kstep, voffB);
        PG8_WAIT_V(6); PG8_BAR;
    }
    for (;;) {
        const bool has_next = S.next(ui + 1, nxt);
        const char* nA = has_next ? (const char*)g.A + (size_t)nxt.pm * tstep : cA; const char* nB = has_next ? (const char*)g.Bt + (size_t)nxt.pn * tstep : cB;
        for (int t = 0; t < nt; t += 2) {
            const bool last = (t == nt - 2);
            const char* a1 = cA + (size_t)(t + 1) * kstep;
            const char* a2 = last ? nA : cA + (size_t)(t + 2) * kstep; const char* b2 = last ? nB : cB + (size_t)(t + 2) * kstep;
            const char* a3 = a2 + kstep; const char* b3 = b2 + kstep;
            if (last && has_next) S.a_ready(nxt);
            if constexpr (SP2) {
            PG8_LDB(B0, 0, 0); PG8_LDB(B1, 0, 1); PG8_SCHED; PG8_LDA(At, 0, 0); PG8_STAGE(PG8_SA(1, 1), a1 + hstep, voffA);
            PG8_WAIT_V(8); PG8_WAIT_L(0); PG8_BAR; PG8_MMA(0, 0, At, B0); PG8_MMA(0, 1, At, B1); PG8_BAR; PG8_SCHED;
            PG8_LDA(At, 0, 1); PG8_STAGE(PG8_SB(0, 0), b2, voffB); PG8_STAGE(PG8_SB(0, 1), b2 + hstep, voffB); PG8_STAGE(PG8_SA(0, 0), a2, voffA);
            PG8_WAIT_V(8); PG8_WAIT_L(0); PG8_BAR; PG8_MMA(1, 0, At, B0); PG8_MMA(1, 1, At, B1); PG8_BAR; PG8_SCHED;
            PG8_LDB(B0, 1, 0); PG8_LDB(B1, 1, 1); PG8_SCHED; PG8_LDA(At, 1, 0); PG8_STAGE(PG8_SA(0, 1), a2 + hstep, voffA);
            PG8_WAIT_V(8); PG8_WAIT_L(0); PG8_BAR; PG8_MMA(0, 0, At, B0); PG8_MMA(0, 1, At, B1); PG8_BAR; PG8_SCHED;
            PG8_LDA(At, 1, 1); PG8_STAGE(PG8_SB(1, 0), b3, voffB); PG8_STAGE(PG8_SB(1, 1), b3 + hstep, voffB); PG8_STAGE(PG8_SA(1, 0), a3, voffA);
            PG8_WAIT_V(8); PG8_WAIT_L(0); PG8_BAR; PG8_MMA(1, 0, At, B0); PG8_MMA(1, 1, At, B1); PG8_BAR; PG8_SCHED;
            } else {
            PG8_LDB(B0, 0, 0); PG8_SCHED; PG8_LDA(At, 0, 0); PG8_STAGE(PG8_SA(1, 1), a1 + hstep, voffA);
            PG8_WAIT_L(8); PG8_BAR; PG8_WAIT_L(0); PG8_MMA(0, 0, At, B0); PG8_BAR; PG8_SCHED;
            PG8_LDB(B1, 0, 1); PG8_STAGE(PG8_SB(0, 0), b2, voffB);
            PG8_BAR; PG8_WAIT_L(0); PG8_MMA(0, 1, At, B1); PG8_BAR;
            PG8_LDA(At, 0, 1); PG8_STAGE(PG8_SA(0, 0), a2, voffA);
            PG8_BAR; PG8_WAIT_L(0); PG8_MMA(1, 0, At, B0); PG8_BAR; PG8_SCHED;
            PG8_STAGE(PG8_SB(0, 1), b2 + hstep, voffB);
            PG8_WAIT_V(6); PG8_BAR; PG8_MMA(1, 1, At, B1); PG8_BAR;
            PG8_LDB(B0, 1, 0); PG8_SCHED; PG8_LDA(At, 1, 0); PG8_STAGE(PG8_SA(0, 1), a2 + hstep, voffA);
            PG8_WAIT_L(8); PG8_BAR; PG8_WAIT_L(0); PG8_MMA(0, 0, At, B0); PG8_BAR; PG8_SCHED;
            PG8_LDB(B1, 1, 1); PG8_STAGE(PG8_SB(1, 0), b3, voffB);
            PG8_BAR; PG8_WAIT_L(0); PG8_MMA(0, 1, At, B1); PG8_BAR;
            PG8_LDA(At, 1, 1); PG8_STAGE(PG8_SA(1, 0), a3, voffA);
            PG8_BAR; PG8_WAIT_L(0); PG8_MMA(1, 0, At, B0); PG8_BAR; PG8_SCHED;
            PG8_STAGE(PG8_SB(1, 1), b3 + hstep, voffB);
            PG8_WAIT_V(6); PG8_BAR; PG8_MMA(1, 1, At, B1); PG8_BAR;
            }
        }
        if constexpr (ALIGN_EPI) { if (wr == 0) PG8_BAR; }
        if constexpr (!Epi::AFTER_DRAIN) { E(acc, cur, wr, wc, fr, fq); S.done(cur); }
        if (!has_next) break;
#pragma unroll
        for (int a = 0; a < 2; ++a)
#pragma unroll
            for (int b = 0; b < 2; ++b)
#pragma unroll
                for (int m = 0; m < 4; ++m)
#pragma unroll
                    for (int n = 0; n < 2; ++n) acc[a][b][m][n] = (f32x4){0.f, 0.f, 0.f, 0.f};
        cur = nxt; cA = nA; cB = nB; ++ui;
        if constexpr (ALIGN_EPI) { if (wr == 1) PG8_BAR; }
    }
    PG8_WAIT_V(0);
    if constexpr (!ALIGN_EPI) { if (wr == 0) PG8_BAR; }
    PG8_BAR;
    if constexpr (Epi::AFTER_DRAIN) { E.fused(acc, cur, wr, wc, fr, fq, lds, wid, lane); S.done(cur); }
#undef PG8_SA
#undef PG8_SB
#undef PG8_STAGE
#undef PG8_LDA
#undef PG8_LDB
#undef PG8_MMA
#undef PG8_WAIT_V
#undef PG8_WAIT_L
#undef PG8_BAR
#undef PG8_SCHED
}
}
constexpr int NWAVES = 8;
#ifndef MK_PER_PHASE
#define MK_PER_PHASE 0
#endif
constexpr int BATCH = 8, SEQ = 2048, D = 1024, M = BATCH * SEQ;
constexpr int NH = 16, HD = 64, MBLK = 256, NBLK = SEQ / MBLK, MOBA_TOPK = 3;
constexpr int D_INNER = 2048, SSD_H = 32, NGRP = 4, DSTATE = 128, D_XBC = 3072, CONVK = 4;
constexpr int N_IN = 10272, NPROJ = 10240;
constexpr int PQ = 0, PK = 1024, PV = 2048, PZ = 3072, PXBC = 5120, PGATE = 8192;
constexpr int COL_DT = 8192;
constexpr int NEXP = 32, TOPK = 4, EXPCAP = 16384, MAXROWS = M * TOPK + NEXP * 256, MAXTILES = MAXROWS / 256;
constexpr float NORM_EPS = 1e-6f;
constexpr float QSCALE = 0.125f * 1.4426950408889634f;

constexpr size_t MiB = 1u << 20;
constexpr size_t WS_CTL = 0, CTL_ZERO_BYTES = 2 * MiB;
constexpr size_t WS_KM = 1 * MiB;
constexpr size_t WS_WIN = 2 * MiB, WS_WOA = 22 * MiB, WS_WOS = 24 * MiB, WS_WOUT = 28 * MiB, WS_WGU = 30 * MiB, WS_WDN = 158 * MiB;
constexpr size_t WS_WDT = 222 * MiB, WS_WRT = 222 * MiB + 512 * 1024;
constexpr size_t WS_XN = 223 * MiB, WS_DT = 255 * MiB, WS_SSQ = 257 * MiB, WS_YG = 259 * MiB, WS_AO = 323 * MiB, WS_MIXF = 355 * MiB, WS_MIX = 419 * MiB, WS_H2 = 451 * MiB;
constexpr size_t WS_TOKL = 483 * MiB, WS_GATEW = 485 * MiB, WS_POS = 486 * MiB, WS_ROWW = 487 * MiB;
constexpr size_t WS_PROJ = 488 * MiB, WS_XC = 808 * MiB, WS_END = 904 * MiB;
constexpr size_t WS_XG = WS_PROJ, WS_ACT = WS_PROJ + 144 * MiB, WS_Y = WS_XG;
static_assert(WS_ACT + (size_t)MAXROWS * 1024 * 2 <= WS_END, "MoE overlay");
constexpr int CW_TMO = 0, CW_CODE = 1, CW_BAR = 4096, CW_CNT = 16384;

constexpr int RING_OFF = 0, RING_BYTES = 131072;
constexpr int LDSCTL_OFF = RING_BYTES, MISC_OFF = LDSCTL_OFF + 320, TILEE_OFF = LDSCTL_OFF + 1024, ROWB_OFF = LDSCTL_OFF + 2560, CNTL_OFF = LDSCTL_OFF + 2816;
constexpr int LDS_BYTES = 147456;

#define GAS __attribute__((address_space(1)))
#define LAS __attribute__((address_space(3)))
typedef unsigned short bf16;
typedef unsigned v4u __attribute__((ext_vector_type(4)));
typedef unsigned v2u __attribute__((ext_vector_type(2)));
typedef float f32x4 __attribute__((ext_vector_type(4)));
typedef GAS unsigned gu32;
#define RLX_AGENT __ATOMIC_RELAXED, __HIP_MEMORY_SCOPE_AGENT
#define LDS_WAIT() asm volatile("s_waitcnt lgkmcnt(0)" ::: "memory")
#define VM_WAIT() asm volatile("s_waitcnt vmcnt(0)" ::: "memory")
__device__ __forceinline__ unsigned f2bf(float f) { unsigned u = __builtin_bit_cast(unsigned, f); return (u + 0x7fffu + ((u >> 16) & 1u)) >> 16; }
__device__ __forceinline__ unsigned pk2(float lo, float hi) { return f2bf(lo) | (f2bf(hi) << 16); }
__device__ __forceinline__ float bf2f(bf16 b) { return __uint_as_float((unsigned)b << 16); }
__device__ __forceinline__ void unpk8(const v4u w, float (&f)[8]) {
#pragma unroll
    for (int i = 0; i < 4; ++i) { f[2 * i] = __uint_as_float(w[i] << 16); f[2 * i + 1] = __uint_as_float(w[i] & 0xffff0000u); }
}
__device__ __forceinline__ v4u pack8(const float (&f)[8]) { v4u w; w.x = pk2(f[0], f[1]); w.y = pk2(f[2], f[3]); w.z = pk2(f[4], f[5]); w.w = pk2(f[6], f[7]); return w; }
__device__ __forceinline__ float wave_sum(float v) {
#pragma unroll
    for (int o = 1; o < 64; o <<= 1) v += __shfl_xor(v, o);
    return v;
}
__device__ __forceinline__ float wave_max(float v) {
#pragma unroll
    for (int o = 1; o < 64; o <<= 1) v = fmaxf(v, __shfl_xor(v, o));
    return v;
}
__device__ __forceinline__ float silu_f(float x) { return x / (1.f + __expf(-x)); }
#define XB_TMO      128
#define XB_XCNT(j)  (256  + 64 * (j))
#define XB_XSUB(j)  (1280 + 64 * (j))
#define XB_XGEN(j)  (2304 + 64 * (j))
#define XB_TOP      3328
#define XB_TOPGEN   3392
#define XCD_BAR_WORDS 3456
#define XB_SPIN_CAP (1u << 18)

__device__ __forceinline__ unsigned xb_ld(unsigned* p)              { return __hip_atomic_load(p, __ATOMIC_RELAXED, __HIP_MEMORY_SCOPE_AGENT); }
__device__ __forceinline__ unsigned xb_add(unsigned* p, unsigned v) { return __hip_atomic_fetch_add(p, v, __ATOMIC_RELAXED, __HIP_MEMORY_SCOPE_AGENT); }
__device__ __forceinline__ unsigned xb_xcc_id() { return (unsigned)__builtin_amdgcn_s_getreg((3 << 11) | 20) & 0xFu; }
#define XB_SPIN(cond, bar) do { unsigned _sp = 0; while (cond) { __builtin_amdgcn_s_sleep(1); \
    if ((++_sp & 255u) == 0u) { if (xb_ld(&(bar)[XB_TMO])) break; if (_sp > XB_SPIN_CAP) { atomicAdd(&(bar)[XB_TMO], 1u); break; } } } } while (0)

struct XcdBarrier {
    unsigned* bar; unsigned x;
    volatile LAS unsigned* st;
};

__device__ __forceinline__ XcdBarrier xcd_barrier_post(unsigned* bar, volatile LAS unsigned* st) {
    XcdBarrier b; b.bar = bar; b.x = xb_xcc_id(); b.st = st;
    if (threadIdx.x == 0) (void)xb_add(&bar[XB_XCNT(b.x)], 1u);
    return b;
}
__device__ __forceinline__ void xcd_barrier_complete(unsigned* bar, unsigned x, unsigned& nloc, unsigned& nx) {
    const unsigned G = gridDim.x * gridDim.y * gridDim.z;
    unsigned sum, cnt, mine, sp = 0u;
    for (;;) {
        sum = 0u; cnt = 0u; mine = 0u;
#pragma unroll
        for (unsigned j = 0; j < 16; ++j) { const unsigned c = xb_ld(&bar[XB_XCNT(j)]); sum += c; cnt += (c > 0u) ? 1u : 0u; mine = (j == x) ? c : mine; }
        if (sum == G) break;
        __builtin_amdgcn_s_sleep(1);
        if ((++sp & 255u) == 0u) { if (xb_ld(&bar[XB_TMO])) break; if (sp > XB_SPIN_CAP) { atomicAdd(&bar[XB_TMO], 1u); break; } }
    }
    nloc = mine > 0u ? mine : 1u; nx = cnt > 0u ? cnt : 1u;
}

__device__ __forceinline__ void xcd_barrier(const XcdBarrier& b) {
    asm volatile("s_waitcnt vmcnt(0)" ::: "memory");
    __syncthreads();
    if (threadIdx.x == 0) {
        unsigned* bar = b.bar;
        __builtin_amdgcn_s_waitcnt(0);
        unsigned nloc = b.st[0], nx = b.st[1];
        if (nloc == 0u) { xcd_barrier_complete(bar, b.x, nloc, nx); b.st[0] = nloc; b.st[1] = nx; }
        const unsigned old = xb_add(&bar[XB_XSUB(b.x)], 1u);
        const unsigned gen = old / nloc;
        if (old + 1u == (gen + 1u) * nloc) {
            __builtin_amdgcn_fence(__ATOMIC_RELEASE, "agent");
            asm volatile("s_waitcnt vmcnt(0)" ::: "memory");
            const unsigned og = xb_add(&bar[XB_TOP], 1u);
            const unsigned tg = og / nx;
            if (og + 1u == (tg + 1u) * nx) xb_add(&bar[XB_TOPGEN], 1u);
            else XB_SPIN(xb_ld(&bar[XB_TOPGEN]) == tg, bar);
            __builtin_amdgcn_fence(__ATOMIC_ACQUIRE, "agent");
            xb_add(&bar[XB_XGEN(b.x)], 1u);
            asm volatile("s_waitcnt vmcnt(0)" ::: "memory");
        } else {
            XB_SPIN(xb_ld(&bar[XB_XGEN(b.x)]) == gen, bar);
            __builtin_amdgcn_fence(__ATOMIC_ACQUIRE, "agent");
            asm volatile("s_waitcnt vmcnt(0)" ::: "memory");
        }
    }
    __syncthreads();
}
struct Args { const float* in[22]; float* out; unsigned char* ws; int ph_lo, ph_hi; };
struct Frame {
    LAS unsigned char* lds;
    volatile LAS unsigned* MISC;
    gu32* ctl;
    int tid, lane, wave, vcu, G;
};
#define IN_X(A)      ((A).in[0])
#define IN_LN1W(A)   ((A).in[1])
#define IN_WIN(A)    ((A).in[2])
#define IN_GATEB(A)  ((A).in[3])
#define IN_QNW(A)    ((A).in[4])
#define IN_KNW(A)    ((A).in[5])
#define IN_CONVW(A)  ((A).in[6])
#define IN_CONVB(A)  ((A).in[7])
#define IN_DTB(A)    ((A).in[8])
#define IN_ALOG(A)   ((A).in[9])
#define IN_DSKIP(A)  ((A).in[10])
#define IN_SSDNW(A)  ((A).in[11])
#define IN_WOA(A)    ((A).in[12])
#define IN_WOS(A)    ((A).in[13])
#define IN_WOUT(A)   ((A).in[14])
#define IN_LN2W(A)   ((A).in[15])
#define IN_WR(A)     ((A).in[16])
#define IN_BR(A)     ((A).in[17])
#define IN_WGU(A)    ((A).in[18])
#define IN_BGU(A)    ((A).in[19])
#define IN_WDN(A)    ((A).in[20])
#define IN_BDN(A)    ((A).in[21])
#define WSP(A, T, off) ((T*)((A).ws + (off)))

template <class Map>
__device__ __forceinline__ void transpose_item(const float* W, int K, int N, bf16* WT, LAS unsigned* scr, int kb, int nb, int lane, const Map& dest_row) {
    const int k0 = 64 * kb, n0 = 64 * nb, cc = lane & 15, kpl = lane >> 4;
    int col = n0 + 4 * cc; if (col > N - 4) col = N - 4;
    f32x4 a[8], b[8];
#pragma unroll
    for (int it = 0; it < 8; ++it) { const int kp = 4 * it + kpl; a[it] = *(const f32x4*)(W + (size_t)(k0 + 2 * kp) * N + col); b[it] = *(const f32x4*)(W + (size_t)(k0 + 2 * kp + 1) * N + col); }
#pragma unroll
    for (int it = 0; it < 8; ++it) { const int kp = 4 * it + kpl;
#pragma unroll
        for (int i = 0; i < 4; ++i) scr[(4 * cc + i) * 33 + kp] = pk2(a[it][i], b[it][i]); }
    LDS_WAIT(); asm volatile("" ::: "memory");
    const int rr = lane >> 3, ch = lane & 7;
#pragma unroll
    for (int j = 0; j < 8; ++j) { const int n = 8 * j + rr; const LAS unsigned* s = scr + n * 33 + 4 * ch; v4u o; o.x = s[0]; o.y = s[1]; o.z = s[2]; o.w = s[3];
        const int dr = dest_row(n0 + n); if (dr >= 0) *(v4u*)(WT + (size_t)dr * K + k0 + 8 * ch) = o; }
    LDS_WAIT(); asm volatile("" ::: "memory");
}
struct MapId { int N; __device__ __forceinline__ int operator()(int s) const { return s < N ? s : -1; } };
struct MapWin { __device__ __forceinline__ int operator()(int s) const { return s < COL_DT ? s : (s < COL_DT + SSD_H ? -1 : (s < N_IN ? s - SSD_H : -1)); } };
struct MapGu { __device__ __forceinline__ int operator()(int s) const { const int j = s >> 1, isu = s & 1; return (j >> 7) * 256 + (j & 127) + 128 * isu; } };

__device__ __forceinline__ void p0_prologue(Frame& F, const Args& A) {
    LAS unsigned* scr = (LAS unsigned*)(F.lds + RING_OFF + F.wave * 8704);
    const int gw = F.vcu * NWAVES + F.wave, NGW = F.G * NWAVES, lane = F.lane;
    constexpr int I_IN = 16 * 161, I_OA = 16 * 16, I_OS = 32 * 16, I_OUT = 16 * 16, I_GU1 = 16 * 32, I_GU = NEXP * I_GU1, I_DN1 = 16 * 16, I_DN = NEXP * I_DN1;
    constexpr int NITEMS = I_IN + I_OA + I_OS + I_OUT + I_GU + I_DN;
    for (int it = gw; it < NITEMS; it += NGW) {
        int r = it;
        if (r < I_IN) { transpose_item(IN_WIN(A), 1024, N_IN, WSP(A,bf16,WS_WIN), scr, r / 161, r % 161, lane, MapWin{}); continue; } r -= I_IN;
        if (r < I_OA) { transpose_item(IN_WOA(A), 1024, 1024, WSP(A,bf16,WS_WOA), scr, r / 16, r % 16, lane, MapId{1024}); continue; } r -= I_OA;
        if (r < I_OS) { transpose_item(IN_WOS(A), 2048, 1024, WSP(A,bf16,WS_WOS), scr, r / 16, r % 16, lane, MapId{1024}); continue; } r -= I_OS;
        if (r < I_OUT) { transpose_item(IN_WOUT(A), 1024, 1024, WSP(A,bf16,WS_WOUT), scr, r / 16, r % 16, lane, MapId{1024}); continue; } r -= I_OUT;
        if (r < I_GU) { const int e = r / I_GU1, q = r % I_GU1; transpose_item(IN_WGU(A) + (size_t)e * 1024 * 2048, 1024, 2048, WSP(A,bf16,WS_WGU) + (size_t)e * 2048 * 1024, scr, q / 32, q % 32, lane, MapGu{}); continue; } r -= I_GU;
        { const int e = r / I_DN1, q = r % I_DN1; transpose_item(IN_WDN(A) + (size_t)e * 1024 * 1024, 1024, 1024, WSP(A,bf16,WS_WDN) + (size_t)e * 1024 * 1024, scr, q / 16, q % 16, lane, MapId{1024}); }
    }
    { const int gt = F.vcu * 512 + F.tid, NGT = F.G * 512;
      for (int i = gt; i < 32 * 1024; i += NGT) { const int e = i >> 10, k = i & 1023; WSP(A,float,WS_WDT)[i] = IN_WIN(A)[(size_t)k * N_IN + COL_DT + e]; WSP(A,float,WS_WRT)[i] = IN_WR(A)[k * 32 + e]; } }
    for (int m = gw; m < M; m += NGW) {
        const f32x4* xr = (const f32x4*)(IN_X(A) + (size_t)m * D) + lane; const f32x4* wr = (const f32x4*)IN_LN1W(A) + lane;
        f32x4 v[4]; float s = 0.f;
#pragma unroll
        for (int j = 0; j < 4; ++j) { v[j] = xr[64 * j]; s += (v[j].x * v[j].x + v[j].y * v[j].y) + (v[j].z * v[j].z + v[j].w * v[j].w); }
        const float rs = 1.0f / sqrtf(wave_sum(s) * (1.f / D) + NORM_EPS);
        v2u* o8 = (v2u*)(WSP(A,bf16,WS_XN) + (size_t)m * D) + lane;
#pragma unroll
        for (int j = 0; j < 4; ++j) { const f32x4 w = wr[64 * j]; v2u o; o.x = pk2(v[j].x * rs * w.x, v[j].y * rs * w.y); o.y = pk2(v[j].z * rs * w.z, v[j].w * rs * w.w); o8[64 * j] = o; }
    }
}

__device__ __forceinline__ float rowdot32(const float (&h)[16], const LAS float* WT, int lane) {
    float mine = 0.f;
#pragma unroll 2
    for (int e = 0; e < 32; ++e) { float s = 0.f;
#pragma unroll
        for (int j = 0; j < 4; ++j) { const f32x4 w = *(const LAS f32x4*)(WT + e * 1024 + 256 * j + 4 * lane); s += (h[4 * j] * w.x + h[4 * j + 1] * w.y) + (h[4 * j + 2] * w.z + h[4 * j + 3] * w.w); }
        s = wave_sum(s); mine = (lane == e) ? s : mine; }
    return mine;
}
__device__ __forceinline__ void stage_wt(Frame& F, const float* src) {
    LAS f32x4* dst = (LAS f32x4*)(F.lds + RING_OFF); const f32x4* s4 = (const f32x4*)src;
    for (int i = F.tid; i < 8192; i += NWAVES * 64) dst[i] = s4[i];
    __syncthreads();
}

__device__ __forceinline__ void p2_prep(Frame& F, const Args& A) {
    stage_wt(F, WSP(A,float,WS_WDT));
    const LAS float* WT = (const LAS float*)(F.lds + RING_OFF);
    const int lane = F.lane, wave = F.wave;
    float qw[16], kw[16];
#pragma unroll
    for (int q = 0; q < 4; ++q) { const f32x4 a = *(const f32x4*)(IN_QNW(A) + 16 * (lane & 3) + 4 * q), b = *(const f32x4*)(IN_KNW(A) + 16 * (lane & 3) + 4 * q);
#pragma unroll
        for (int i = 0; i < 4; ++i) { qw[4 * q + i] = a[i] * QSCALE; kw[4 * q + i] = b[i]; } }
    for (int item = F.vcu; item < M / 32; item += F.G) {
        const int t0 = item * 32 + wave * 4, b = t0 / SEQ, blk = (t0 % SEQ) / MBLK;
        float km[16];
#pragma unroll
        for (int i = 0; i < 16; ++i) km[i] = 0.f;
        for (int tt = 0; tt < 4; ++tt) {
            const int t = t0 + tt, pos = t % SEQ;
            bf16* prow = WSP(A,bf16,WS_PROJ) + (size_t)t * NPROJ;
            {
                float v[16]; { float lo[8], hi[8]; unpk8(*(const v4u*)(prow + PQ + 16 * lane), lo); unpk8(*(const v4u*)(prow + PQ + 16 * lane + 8), hi);
#pragma unroll
                    for (int i = 0; i < 8; ++i) { v[i] = lo[i]; v[8 + i] = hi[i]; } }
                float ss = 0.f;
#pragma unroll
                for (int i = 0; i < 16; ++i) ss += v[i] * v[i];
                ss += __shfl_xor(ss, 1); ss += __shfl_xor(ss, 2);
                const float rs = 1.0f / sqrtf(ss * (1.f / 64.f) + NORM_EPS);
                float lo[8], hi[8];
#pragma unroll
                for (int i = 0; i < 8; ++i) { lo[i] = v[i] * rs * qw[i]; hi[i] = v[8 + i] * rs * qw[8 + i]; }
                *(v4u*)(prow + PQ + 16 * lane) = pack8(lo); *(v4u*)(prow + PQ + 16 * lane + 8) = pack8(hi);
            }
            {
                float v[16]; { float lo[8], hi[8]; unpk8(*(const v4u*)(prow + PK + 16 * lane), lo); unpk8(*(const v4u*)(prow + PK + 16 * lane + 8), hi);
#pragma unroll
                    for (int i = 0; i < 8; ++i) { v[i] = lo[i]; v[8 + i] = hi[i]; } }
                float ss = 0.f;
#pragma unroll
                for (int i = 0; i < 16; ++i) ss += v[i] * v[i];
                ss += __shfl_xor(ss, 1); ss += __shfl_xor(ss, 2);
                const float rs = 1.0f / sqrtf(ss * (1.f / 64.f) + NORM_EPS);
                float lo[8], hi[8];
#pragma unroll
                for (int i = 0; i < 8; ++i) { lo[i] = v[i] * rs * kw[i]; hi[i] = v[8 + i] * rs * kw[8 + i]; km[i] += lo[i]; km[8 + i] += hi[i]; }
                *(v4u*)(prow + PK + 16 * lane) = pack8(lo); *(v4u*)(prow + PK + 16 * lane + 8) = pack8(hi);
            }
#pragma unroll 1
            for (int g6 = 0; g6 < 6; ++g6) {
                const int c0 = g6 * 512 + 8 * lane; float acc[8];
                { const f32x4 b0 = *(const f32x4*)(IN_CONVB(A) + c0), b1 = *(const f32x4*)(IN_CONVB(A) + c0 + 4);
#pragma unroll
                  for (int i = 0; i < 4; ++i) { acc[i] = b0[i]; acc[4 + i] = b1[i]; } }
#pragma unroll
                for (int j = 0; j < CONVK; ++j) {
                    if (pos - (CONVK - 1) + j >= 0) {
                        float xv[8]; unpk8(*(const v4u*)(WSP(A,bf16,WS_PROJ) + (size_t)(t - (CONVK - 1) + j) * NPROJ + PXBC + c0), xv);
                        const f32x4 w0 = *(const f32x4*)(IN_CONVW(A) + j * D_XBC + c0), w1 = *(const f32x4*)(IN_CONVW(A) + j * D_XBC + c0 + 4);
#pragma unroll
                        for (int i = 0; i < 4; ++i) { acc[i] += w0[i] * xv[i]; acc[4 + i] += w1[i] * xv[4 + i]; }
                    }
                }
#pragma unroll
                for (int i = 0; i < 8; ++i) acc[i] = silu_f(acc[i]);
                *(v4u*)(WSP(A,bf16,WS_XC) + (size_t)t * D_XBC + c0) = pack8(acc);
            }
            {
                float h[16]; const v2u* xr = (const v2u*)(WSP(A,bf16,WS_XN) + (size_t)t * D) + lane;
#pragma unroll
                for (int j = 0; j < 4; ++j) { const v2u w = xr[64 * j]; h[4 * j] = __uint_as_float(w.x << 16); h[4 * j + 1] = __uint_as_float(w.x & 0xffff0000u); h[4 * j + 2] = __uint_as_float(w.y << 16); h[4 * j + 3] = __uint_as_float(w.y & 0xffff0000u); }
                const float mine = rowdot32(h, WT, lane);
                if (lane < 32) { const float z = mine + IN_DTB(A)[lane]; WSP(A,float,WS_DT)[(size_t)t * 32 + lane] = fmaxf(z, 0.f) + log1pf(__expf(-fabsf(z))); }
            }
        }
        float* kmp = WSP(A,float,WS_KM) + ((size_t)(b * NH + (lane >> 2)) * NBLK + blk) * HD + 16 * (lane & 3);
#pragma unroll
        for (int i = 0; i < 16; ++i) unsafeAtomicAdd(kmp + i, km[i] * (1.f / MBLK));
    }
    __syncthreads();
}

__device__ __forceinline__ void p3_ssd(Frame& F, const Args& A) {
    LAS float* xs = (LAS float*)(F.lds + RING_OFF);
    LAS float* Bc = (LAS float*)(F.lds + RING_OFF + 16384);
    LAS float* Cc = (LAS float*)(F.lds + RING_OFF + 49152);
    LAS float* dtv = (LAS float*)(F.lds + RING_OFF + 81920);
    LAS float* yb = (LAS float*)(F.lds + RING_OFF + 82944);
    const int tid = F.tid;
    for (int unit = F.vcu; unit < BATCH * SSD_H; unit += F.G) {
        const int b = unit / SSD_H, h = unit % SSD_H, g = h / (SSD_H / NGRP);
        const float Aneg = -__expf(IN_ALOG(A)[h]), Dh = IN_DSKIP(A)[h];
        const int p = tid >> 3, ng = tid & 7;
        float st[16];
#pragma unroll
        for (int i = 0; i < 16; ++i) st[i] = 0.f;
        for (int ch = 0; ch < SEQ / 64; ++ch) {
            const int tb = b * SEQ + ch * 64;
            {
                const int r = tid >> 3, c8 = tid & 7;
                float v[8]; unpk8(*(const v4u*)(WSP(A,bf16,WS_XC) + (size_t)(tb + r) * D_XBC + h * 64 + 8 * c8), v);
#pragma unroll
                for (int i = 0; i < 8; ++i) xs[r * 64 + 8 * c8 + i] = v[i];
#pragma unroll
                for (int q = 0; q < 2; ++q) { const int idx = tid + 512 * q, rr = idx >> 4, c16 = idx & 15;
                    float bv[8], cv[8]; unpk8(*(const v4u*)(WSP(A,bf16,WS_XC) + (size_t)(tb + rr) * D_XBC + D_INNER + g * DSTATE + 8 * c16), bv); unpk8(*(const v4u*)(WSP(A,bf16,WS_XC) + (size_t)(tb + rr) * D_XBC + D_INNER + NGRP * DSTATE + g * DSTATE + 8 * c16), cv);
#pragma unroll
                    for (int i = 0; i < 8; ++i) { Bc[rr * 128 + 8 * c16 + i] = bv[i]; Cc[rr * 128 + 8 * c16 + i] = cv[i]; } }
                if (tid < 64) dtv[tid] = WSP(A,float,WS_DT)[(size_t)(tb + tid) * 32 + h];
            }
            __syncthreads();
            for (int tok = 0; tok < 64; ++tok) {
                const float dt = dtv[tok], decay = __expf(dt * Aneg), xdt = xs[tok * 64 + p] * dt;
                float yp = 0.f;
#pragma unroll
                for (int q = 0; q < 4; ++q) { const f32x4 bb = *(const LAS f32x4*)(Bc + tok * 128 + 16 * ng + 4 * q), cc = *(const LAS f32x4*)(Cc + tok * 128 + 16 * ng + 4 * q);
#pragma unroll
                    for (int i = 0; i < 4; ++i) { st[4 * q + i] = st[4 * q + i] * decay + bb[i] * xdt; yp += cc[i] * st[4 * q + i]; } }
                yp += __shfl_xor(yp, 1); yp += __shfl_xor(yp, 2); yp += __shfl_xor(yp, 4);
                if (ng == 0) yb[tok * 64 + p] = yp;
            }
            __syncthreads();
            {
                const int r = tid >> 3, c8 = tid & 7; const size_t t = (size_t)(tb + r);
                float z[8]; unpk8(*(const v4u*)(WSP(A,bf16,WS_PROJ) + t * NPROJ + PZ + h * 64 + 8 * c8), z);
                float o[8]; float ss = 0.f;
#pragma unroll
                for (int i = 0; i < 8; ++i) { const float y = yb[r * 64 + 8 * c8 + i] + Dh * xs[r * 64 + 8 * c8 + i]; o[i] = y * silu_f(z[i]); ss += o[i] * o[i]; }
                *(v4u*)(WSP(A,bf16,WS_YG) + t * D_INNER + h * 64 + 8 * c8) = pack8(o);
                ss += __shfl_xor(ss, 1); ss += __shfl_xor(ss, 2); ss += __shfl_xor(ss, 4);
                if (c8 == 0) WSP(A,float,WS_SSQ)[t * 32 + h] = ss;
            }
            __syncthreads();
        }
    }
}

__device__ __forceinline__ void p4_norm_attn(Frame& F, const Args& A) {
    const int lane = F.lane, gw = F.vcu * NWAVES + F.wave, NGW = F.G * NWAVES;
    for (int t = gw; t < M; t += NGW) {
        bf16* row = WSP(A,bf16,WS_YG) + (size_t)t * D_INNER + 32 * lane; const int g = lane >> 4;
        float ss = 0.f;
#pragma unroll
        for (int hh = 0; hh < 8; ++hh) ss += WSP(A,float,WS_SSQ)[(size_t)t * 32 + 8 * g + hh];
        const float rs = 1.0f / sqrtf(ss * (1.f / 512.f) + NORM_EPS);
#pragma unroll
        for (int q = 0; q < 4; ++q) { float v[8]; unpk8(*(const v4u*)(row + 8 * q), v); const f32x4 w0 = *(const f32x4*)(IN_SSDNW(A) + 32 * lane + 8 * q), w1 = *(const f32x4*)(IN_SSDNW(A) + 32 * lane + 8 * q + 4);
#pragma unroll
            for (int i = 0; i < 4; ++i) { v[i] = v[i] * rs * w0[i]; v[4 + i] = v[4 + i] * rs * w1[i]; }
            *(v4u*)(row + 8 * q) = pack8(v); }
    }
    const float qwm = wave_max(fabsf(IN_QNW(A)[lane])), kwm = wave_max(fabsf(IN_KNW(A)[lane]));
    const float REF = 8.0f * qwm * kwm * 1.4426950408889634f + 0.25f;
    const bf16* QN = WSP(A,bf16,WS_PROJ) + PQ; const bf16* KN = WSP(A,bf16,WS_PROJ) + PK; const bf16* VV = WSP(A,bf16,WS_PROJ) + PV;
    for (long a = gw; a < (long)M * NH; a += NGW) {
        const int grp = (int)(a >> 7), within = (int)(a & 127), h = within >> 3, t = grp * 8 + (within & 7);
        const int b = t / SEQ, pos = t % SEQ, qb = pos >> 8;
        const bf16* qp = QN + (size_t)t * NPROJ + h * 64;
        float q[64];
#pragma unroll
        for (int c = 0; c < 8; ++c) { float v[8]; unpk8(*(const v4u*)(qp + 8 * c), v);
#pragma unroll
            for (int i = 0; i < 8; ++i) q[8 * c + i] = v[i]; }
        const float qd = bf2f(qp[lane]);
        float sc[7];
#pragma unroll
        for (int j = 0; j < 7; ++j) { sc[j] = -3.0e38f; if (j < qb) sc[j] = wave_sum(qd * WSP(A,float,WS_KM)[((size_t)(b * NH + h) * NBLK + j) * HD + lane]); }
        unsigned sel = 0u; const int nsel = qb < MOBA_TOPK ? qb : MOBA_TOPK;
#pragma unroll
        for (int k = 0; k < MOBA_TOPK; ++k) if (k < nsel) { float best = -3.0e38f; int bi = 0;
#pragma unroll
            for (int j = 0; j < 7; ++j) if (j < qb && !((sel >> j) & 1u) && sc[j] > best) { best = sc[j]; bi = j; }
            sel |= 1u << bi; }
        sel |= 1u << qb;
        float o = 0.f, lsum = 0.f;
        for (int j = 0; j <= qb; ++j) {
            if (!((sel >> j) & 1u)) continue;
            for (int tile = 0; tile < 4; ++tile) {
                const int kbase = j * MBLK + tile * 64; if (j == qb && kbase > pos) break;
                const int kk = kbase + lane; const bf16* kp = KN + (size_t)(b * SEQ + kk) * NPROJ + h * 64;
                float dot = 0.f;
#pragma unroll
                for (int c = 0; c < 8; ++c) { float v[8]; unpk8(*(const v4u*)(kp + 8 * c), v);
#pragma unroll
                    for (int i = 0; i < 8; ++i) dot += v[i] * q[8 * c + i]; }
                const bool valid = (j < qb) || (kk <= pos);
                const float pr = valid ? __builtin_amdgcn_exp2f(dot - REF) : 0.f; lsum += pr;
                const bf16* vp = VV + (size_t)(b * SEQ + kbase) * NPROJ + h * 64 + lane;
#pragma unroll 16
                for (int jj = 0; jj < 64; ++jj) { const float pj = __shfl(pr, jj); o += pj * bf2f(vp[(size_t)jj * NPROJ]); }
            }
        }
        const float l = wave_sum(lsum);
        WSP(A,bf16,WS_AO)[(size_t)t * D + h * 64 + lane] = (bf16)f2bf(o / l);
    }
}

__device__ __forceinline__ void p7_route(Frame& F, const Args& A) {
    stage_wt(F, WSP(A,float,WS_WRT));
    const LAS float* WT = (const LAS float*)(F.lds + RING_OFF);
    const int lane = F.lane, gw = F.vcu * NWAVES + F.wave, NGW = F.G * NWAVES;
    for (int t = gw; t < M; t += NGW) {
        const f32x4* xr = (const f32x4*)((A).out + (size_t)t * D) + lane; const f32x4* wr = (const f32x4*)IN_LN2W(A) + lane;
        f32x4 v[4]; float s = 0.f;
#pragma unroll
        for (int j = 0; j < 4; ++j) { v[j] = xr[64 * j]; s += (v[j].x * v[j].x + v[j].y * v[j].y) + (v[j].z * v[j].z + v[j].w * v[j].w); }
        const float rs = 1.0f / sqrtf(wave_sum(s) * (1.f / D) + NORM_EPS);
        float h[16]; v2u* o8 = (v2u*)(WSP(A,bf16,WS_H2) + (size_t)t * D) + lane;
#pragma unroll
        for (int j = 0; j < 4; ++j) { const f32x4 w = wr[64 * j]; h[4 * j] = v[j].x * rs * w.x; h[4 * j + 1] = v[j].y * rs * w.y; h[4 * j + 2] = v[j].z * rs * w.z; h[4 * j + 3] = v[j].w * rs * w.w;
            v2u o; o.x = pk2(h[4 * j], h[4 * j + 1]); o.y = pk2(h[4 * j + 2], h[4 * j + 3]); o8[64 * j] = o; }
        float val = rowdot32(h, WT, lane); val = (lane < 32) ? val + IN_BR(A)[lane & 31] : -3.0e38f;
        float tv[4]; int ti[4];
#pragma unroll
        for (int k = 0; k < 4; ++k) { const float mx = wave_max(val); const unsigned long long bm = __ballot(val == mx); const int idx = __builtin_ctzll(bm);
            tv[k] = mx; ti[k] = idx; if (lane == idx) val = -3.0e38f; }
        float ex[4], es = 0.f;
#pragma unroll
        for (int k = 0; k < 4; ++k) { ex[k] = __expf(tv[k] - tv[0]); es += ex[k]; }
        if (lane == 0) {
#pragma unroll
            for (int k = 0; k < 4; ++k) { const unsigned j = __hip_atomic_fetch_add((WSP(A,unsigned,WS_CTL) + CW_CNT) + ti[k], 1u, RLX_AGENT); WSP(A,int,WS_TOKL)[ti[k] * EXPCAP + (int)j] = t * 4 + k; WSP(A,float,WS_GATEW)[t * 4 + k] = ex[k] / es; }
        }
    }
    __syncthreads();
}

__device__ __forceinline__ int moe_tables(Frame& F, const Args& A) {
    LAS int* tile_e = (LAS int*)(F.lds + TILEE_OFF); LAS int* rowb = (LAS int*)(F.lds + ROWB_OFF); LAS int* cntl = (LAS int*)(F.lds + CNTL_OFF);
    if (F.tid == 0) { int acc = 0, rt = 0;
        for (int e = 0; e < NEXP; ++e) { int c = (int)__hip_atomic_load((WSP(A,unsigned,WS_CTL) + CW_CNT) + e, RLX_AGENT); if (c > EXPCAP) c = EXPCAP; cntl[e] = c; rowb[e] = acc; const int n = (c + 255) >> 8; for (int i = 0; i < n; ++i) tile_e[rt++] = e; acc += n * 256; }
        rowb[NEXP] = acc; }
    __syncthreads();
    return rowb[NEXP] >> 8;
}
__device__ __forceinline__ void p8_gather(Frame& F, const Args& A) {
    const int NT = moe_tables(F, A);
    const LAS int* rowb = (const LAS int*)(F.lds + ROWB_OFF); const LAS int* cntl = (const LAS int*)(F.lds + CNTL_OFF);
    const int lane = F.lane, gw = F.vcu * NWAVES + F.wave, NGW = F.G * NWAVES, total = NT * 256;
    for (int r = gw; r < total; r += NGW) {
        int e = 0;
#pragma unroll
        for (int q = 1; q < NEXP; ++q) e += (rowb[q] <= r) ? 1 : 0;
        const int j = r - rowb[e];
        if (j < cntl[e]) { const int a = WSP(A,int,WS_TOKL)[e * EXPCAP + j], t = a >> 2;
            const v4u x0 = *(const v4u*)(WSP(A,bf16,WS_H2) + (size_t)t * D + 16 * lane), x1 = *(const v4u*)(WSP(A,bf16,WS_H2) + (size_t)t * D + 16 * lane + 8);
            *(v4u*)(WSP(A,bf16,WS_XG) + (size_t)r * D + 16 * lane) = x0; *(v4u*)(WSP(A,bf16,WS_XG) + (size_t)r * D + 16 * lane + 8) = x1;
            if (lane == 0) { WSP(A,float,WS_ROWW)[r] = WSP(A,float,WS_GATEW)[a]; WSP(A,int,WS_POS)[a] = r; } }
        else if (lane == 0) WSP(A,float,WS_ROWW)[r] = 0.f;
    }
    __syncthreads();
}
__device__ __forceinline__ void p11_combine(Frame& F, const Args& A) {
    const int lane = F.lane, gw = F.vcu * NWAVES + F.wave, NGW = F.G * NWAVES;
    for (int t = gw; t < M; t += NGW) {
        f32x4* xr = (f32x4*)((A).out + (size_t)t * D) + lane; f32x4 v[4];
#pragma unroll
        for (int j = 0; j < 4; ++j) v[j] = xr[64 * j];
#pragma unroll
        for (int k = 0; k < 4; ++k) { const int r = WSP(A,int,WS_POS)[t * 4 + k]; const v2u* yr = (const v2u*)(WSP(A,bf16,WS_Y) + (size_t)r * D) + lane;
#pragma unroll
            for (int j = 0; j < 4; ++j) { const v2u w = yr[64 * j]; v[j].x += __uint_as_float(w.x << 16); v[j].y += __uint_as_float(w.x & 0xffff0000u); v[j].z += __uint_as_float(w.y << 16); v[j].w += __uint_as_float(w.y & 0xffff0000u); } }
#pragma unroll
        for (int j = 0; j < 4; ++j) xr[64 * j] = v[j];
    }
}
enum { PH_PRO = 0, PH_INPROJ, PH_PREP, PH_SSD, PH_ATTN, PH_OPROJ, PH_WOUT, PH_ROUTE, PH_GATHER, PH_GU, PH_DOWN, PH_COMB, N_PHASES };
__global__ void __launch_bounds__(NWAVES * 64, 2) mk_fwd(Args args) {
    extern __shared__ __attribute__((aligned(16))) unsigned char lds[];
    Frame F;
    F.lds = (LAS unsigned char*)lds;
    F.MISC = (volatile LAS unsigned*)(F.lds + MISC_OFF);
    F.tid = threadIdx.x; F.lane = F.tid & 63; F.wave = __builtin_amdgcn_readfirstlane(F.tid >> 6);
    F.G = gridDim.x; { const int bx = blockIdx.x; F.vcu = (F.G % 8 == 0) ? (bx % 8) * (F.G / 8) + bx / 8 : bx; }
    const Args& A = args;
    F.ctl = (gu32*)(args.ws + WS_CTL);
    for (int u = F.tid; u < (LDS_BYTES - LDSCTL_OFF) / 4; u += NWAVES * 64) ((LAS unsigned*)(F.lds + LDSCTL_OFF))[u] = 0u;
    __syncthreads();
    XcdBarrier bar; bar.bar = (unsigned*)(F.ctl + CW_BAR); bar.x = 0; bar.st = nullptr;
    if (!MK_PER_PHASE) bar = xcd_barrier_post((unsigned*)(F.ctl + CW_BAR), F.MISC + 8);
    const int lo = args.ph_lo, hi = args.ph_hi;
#ifndef PH_MASK
#define PH_MASK 0xFFF
#endif
#define IN(k) ((((PH_MASK) >> (k)) & 1) && lo <= (k) && (k) < hi)
#define SEAM(k) do { if (!MK_PER_PHASE && IN(k) && IN((k) + 1)) xcd_barrier(bar); } while (0)

    if (IN(PH_PRO)) { p0_prologue(F, A); SEAM(PH_PRO); }
    if (IN(PH_INPROJ)) {
        pg8::Gemm g{WSP(A,bf16,WS_XN), WSP(A,bf16,WS_WIN), M, NPROJ, D}; pg8::StaticOrder S; S.init(M, NPROJ, F.G, (int)blockIdx.x);
        pg8::EpiPlain E{WSP(A,bf16,WS_PROJ), NPROJ};
        pg8::gemm_phase<pg8::EpiPlain, pg8::StaticOrder, true, true>(F.lds + RING_OFF, g, S, E);
        SEAM(PH_INPROJ);
    }
    if (IN(PH_PREP)) { p2_prep(F, A); SEAM(PH_PREP); }
    if (IN(PH_SSD)) { p3_ssd(F, A); SEAM(PH_SSD); }
    if (IN(PH_ATTN)) { p4_norm_attn(F, A); SEAM(PH_ATTN); }
    if (IN(PH_OPROJ)) {
        { pg8::Gemm g{WSP(A,bf16,WS_AO), WSP(A,bf16,WS_WOA), M, D, D}; pg8::StaticOrder S; S.init(M, D, F.G, (int)blockIdx.x);
          pg8::EpiGate1 E{WSP(A,bf16,WS_PROJ) + PGATE, NPROJ, IN_GATEB(A), WSP(A,float,WS_MIXF)};
          pg8::gemm_phase<pg8::EpiGate1, pg8::StaticOrder, true, true>(F.lds + RING_OFF, g, S, E); }
        { pg8::Gemm g{WSP(A,bf16,WS_YG), WSP(A,bf16,WS_WOS), M, D, D_INNER}; pg8::StaticOrder S; S.init(M, D, F.G, (int)blockIdx.x);
          pg8::EpiGate2 E{WSP(A,bf16,WS_PROJ) + PGATE + D, NPROJ, IN_GATEB(A) + D, WSP(A,float,WS_MIXF), WSP(A,bf16,WS_MIX)};
          pg8::gemm_phase<pg8::EpiGate2, pg8::StaticOrder, true, true>(F.lds + RING_OFF, g, S, E); }
        SEAM(PH_OPROJ);
    }
    if (IN(PH_WOUT)) {
        pg8::Gemm g{WSP(A,bf16,WS_MIX), WSP(A,bf16,WS_WOUT), M, D, D}; pg8::StaticOrder S; S.init(M, D, F.G, (int)blockIdx.x);
        pg8::EpiResid E{IN_X(A), (A).out};
        pg8::gemm_phase<pg8::EpiResid, pg8::StaticOrder, true, true>(F.lds + RING_OFF, g, S, E);
        SEAM(PH_WOUT);
    }
    if (IN(PH_ROUTE)) { p7_route(F, A); SEAM(PH_ROUTE); }
    if (IN(PH_GATHER)) { p8_gather(F, A); SEAM(PH_GATHER); }
    if (IN(PH_GU)) {
        const int NT = moe_tables(F, A);
        pg8::Gemm g{WSP(A,bf16,WS_XG), WSP(A,bf16,WS_WGU), NT * 256, 2048, D}; pg8::GroupedOrder S{8, NT, F.G, (int)blockIdx.x, (const LAS int*)(F.lds + TILEE_OFF)};
        pg8::EpiSwiglu E{WSP(A,bf16,WS_ACT), IN_BGU(A)};
        pg8::gemm_phase<pg8::EpiSwiglu, pg8::GroupedOrder, true, true>(F.lds + RING_OFF, g, S, E);
        SEAM(PH_GU);
    }
    if (IN(PH_DOWN)) {
        const int NT = moe_tables(F, A);
        pg8::Gemm g{WSP(A,bf16,WS_ACT), WSP(A,bf16,WS_WDN), NT * 256, 1024, D}; pg8::GroupedOrder S{4, NT, F.G, (int)blockIdx.x, (const LAS int*)(F.lds + TILEE_OFF)};
        pg8::EpiDown E{WSP(A,bf16,WS_Y), IN_BDN(A), WSP(A,float,WS_ROWW)};
        pg8::gemm_phase<pg8::EpiDown, pg8::GroupedOrder, true, true>(F.lds + RING_OFF, g, S, E);
        SEAM(PH_DOWN);
    }
    if (IN(PH_COMB)) { p11_combine(F, A); }
#undef IN
#undef SEAM
}

extern "C" void kernel_launch(void* const* d_in, const int* in_sizes, int n_in, void* d_out, int out_size, void* d_ws, size_t ws_size, hipStream_t stream) {
    static int grid = 0;
    if (grid == 0) {
        if (n_in != 22 || in_sizes[0] != M * D || out_size != M * D || ws_size < WS_END) { fprintf(stderr, "kernel_launch: unexpected shapes / workspace (n_in %d, in0 %d, out %d, ws %zu, need %zu); nothing launched\n", n_in, n_in > 0 ? in_sizes[0] : -1, out_size, ws_size, (size_t)WS_END); grid = -1; return; }
        int dev = 0, cus = 0, per_cu = 0;
        if (hipGetDevice(&dev) != hipSuccess || hipDeviceGetAttribute(&cus, hipDeviceAttributeMultiprocessorCount, dev) != hipSuccess) { fprintf(stderr, "kernel_launch: device query failed\n"); grid = -1; return; }
        if (hipFuncSetAttribute((const void*)mk_fwd, hipFuncAttributeMaxDynamicSharedMemorySize, LDS_BYTES) != hipSuccess) { fprintf(stderr, "kernel_launch: hipFuncSetAttribute failed\n"); grid = -1; return; }
        if (hipOccupancyMaxActiveBlocksPerMultiprocessor(&per_cu, (const void*)mk_fwd, NWAVES * 64, LDS_BYTES) != hipSuccess || per_cu < 1) fprintf(stderr, "kernel_launch: note: occupancy query reports %d blocks per CU\n", per_cu);
        (void)hipGetLastError();
        grid = cus;
    }
    if (grid < 0) return;
    if (hipMemsetAsync((char*)d_ws + WS_CTL, 0, CTL_ZERO_BYTES, stream) != hipSuccess) { fprintf(stderr, "kernel_launch: memset failed\n"); return; }
    Args a{};
    for (int i = 0; i < 22; ++i) a.in[i] = (const float*)d_in[i];
    a.out = (float*)d_out; a.ws = (unsigned char*)d_ws;
#if MK_PER_PHASE
    for (int p = 0; p < N_PHASES; ++p) { a.ph_lo = p; a.ph_hi = p + 1; hipLaunchKernelGGL(mk_fwd, dim3(grid), dim3(NWAVES * 64), LDS_BYTES, stream, a); }
#else
    a.ph_lo = 0; a.ph_hi = N_PHASES;
    hipLaunchKernelGGL(mk_fwd, dim3(grid), dim3(NWAVES * 64), LDS_BYTES, stream, a);
#endif
    const hipError_t le = hipPeekAtLastError();
    if (le != hipSuccess) fprintf(stderr, "kernel_launch: launch failed: %s\n", hipGetErrorName(le));
}
```

```cpp
#include <hip/hip_runtime.h>
#include <cstdio>
#include <cstdint>
namespace pg8 {
#define PG8_LAS __attribute__((address_space(3)))
typedef unsigned short bf16_t;
typedef short bf16x8 __attribute__((ext_vector_type(8)));
typedef float f32x4 __attribute__((ext_vector_type(4)));
typedef unsigned u32x4 __attribute__((ext_vector_type(4)));
constexpr int BM = 256, BK = 64, HALF = 128, HTB = HALF * BK * 2  , STAGE_BYTES = 8 * HTB, NXCD = 8, WGM = 8;

__host__ __device__ __forceinline__ int lds_byte(int r, int c) { const int st = (r >> 4) * 2 + (c >> 5), rr = r & 15, cc = c & 31, ob = rr * 64 + cc * 2; return st * 1024 + (ob ^ (((ob >> 9) & 1) << 5)); }
__host__ __device__ __forceinline__ void stage_rc(int b, int& R, int& C) { const int st = b / 1024, sb = b % 1024, swz = sb ^ (((sb >> 9) & 1) << 5); R = (st >> 1) * 16 + swz / 64; C = (st & 1) * 32 + (swz % 64) / 2; }
__host__ __device__ __forceinline__ int perm32(int rho) { const int n = rho >> 4, i = rho & 15; return 8 * (i >> 2) + 4 * n + (i & 3); }

struct Unit { int pm, pn; };
struct Gemm { const bf16_t* A; const bf16_t* Bt; int M, N, K; };

struct StaticOrder {
    int nM, nN, nwg, G, c;
    __host__ __device__ void init(int M, int N, int G_, int c_) { nM = M / BM; nN = N / BM; nwg = nM * nN; G = G_; c = c_; }
    __host__ __device__ bool next(int i, Unit& u) const {
        const long L = (long)i * G + c; if (L >= nwg) return false;
        int wgid = (int)L; { const int q = nwg / NXCD, r = nwg % NXCD, xcd = wgid % NXCD, off = wgid / NXCD; wgid = (xcd < r ? xcd * (q + 1) : r * (q + 1) + (xcd - r) * q) + off; }
        const int nig = WGM * nN, gid = wgid / nig, fm = gid * WGM, gsz = (nM - fm) < WGM ? (nM - fm) : WGM;
        u.pm = fm + ((wgid % nig) % gsz); u.pn = (wgid % nig) / gsz; return true;
    }
    __device__ __forceinline__ void a_ready(const Unit&) const {}
    __device__ __forceinline__ void done(const Unit&) const {}
};

struct GroupedOrder {
    int nN, NT, G, c; const PG8_LAS int* tile_e;
    __device__ __forceinline__ bool next(int i, Unit& u) const {
        const long L = (long)i * G + c; const int nwg = NT * nN; if (L >= nwg) return false;
        int wgid = (int)L; { const int q = nwg / NXCD, r = nwg % NXCD, xcd = wgid % NXCD, off = wgid / NXCD; wgid = (xcd < r ? xcd * (q + 1) : r * (q + 1) + (xcd - r) * q) + off; }
        const int rt = wgid / nN, pl = wgid % nN;
        u.pm = rt; u.pn = tile_e[rt] * nN + pl; return true;
    }
    __device__ __forceinline__ void a_ready(const Unit&) const {}
    __device__ __forceinline__ void done(const Unit&) const {}
};

__device__ __forceinline__ unsigned cvt_pk_bf16(float lo, float hi) { unsigned r; asm volatile("v_cvt_pk_bf16_f32 %0, %1, %2" : "=v"(r) : "v"(lo), "v"(hi)); return r; }
__device__ __forceinline__ float sigm(float x) { return __builtin_amdgcn_rcpf(1.f + __builtin_amdgcn_exp2f(-1.44269504f * x)); }
__device__ __forceinline__ void unpack8(const u32x4 w, float (&f)[8]) {
#pragma unroll
    for (int i = 0; i < 4; ++i) { f[2 * i] = __uint_as_float(w[i] << 16); f[2 * i + 1] = __uint_as_float(w[i] & 0xffff0000u); }
}
struct EpiPlain {
    static constexpr bool PERM = true, AFTER_DRAIN = false; bf16_t* O; int ldc;
    __device__ __forceinline__ void operator()(const f32x4 (&acc)[2][2][4][2], const Unit& u, int wr, int wc, int fr, int fq) const {
        const int row0 = u.pm * BM + wr * 64 + fr, col0 = u.pn * BM + wc * 32 + 8 * fq;
#pragma unroll
        for (int ai = 0; ai < 2; ++ai)
#pragma unroll
            for (int m = 0; m < 4; ++m) { bf16_t* rowp = O + (size_t)(row0 + ai * HALF + m * 16) * ldc + col0;
#pragma unroll
                for (int bj = 0; bj < 2; ++bj) { const f32x4 v0 = acc[ai][bj][m][0], v1 = acc[ai][bj][m][1]; u32x4 w;
                    w.x = cvt_pk_bf16(v0[0], v0[1]); w.y = cvt_pk_bf16(v0[2], v0[3]); w.z = cvt_pk_bf16(v1[0], v1[1]); w.w = cvt_pk_bf16(v1[2], v1[3]);
                    *(u32x4*)(rowp + bj * HALF) = w; } }
    }
};
struct EpiGate1 {
    static constexpr bool PERM = true, AFTER_DRAIN = false; const bf16_t* Gp; int ldg; const float* gb; float* MIXF;
    __device__ __forceinline__ void operator()(const f32x4 (&acc)[2][2][4][2], const Unit& u, int wr, int wc, int fr, int fq) const {
        const int row0 = u.pm * BM + wr * 64 + fr, col0 = u.pn * BM + wc * 32 + 8 * fq;
#pragma unroll
        for (int ai = 0; ai < 2; ++ai)
#pragma unroll
            for (int m = 0; m < 4; ++m) { const size_t row = (size_t)(row0 + ai * HALF + m * 16);
#pragma unroll
                for (int bj = 0; bj < 2; ++bj) { const int c = col0 + bj * HALF; float g[8]; unpack8(*(const u32x4*)(Gp + row * ldg + c), g);
                    const f32x4 b0 = *(const f32x4*)(gb + c), b1 = *(const f32x4*)(gb + c + 4); const f32x4 v0 = acc[ai][bj][m][0], v1 = acc[ai][bj][m][1]; f32x4 o0, o1;
#pragma unroll
                    for (int i = 0; i < 4; ++i) { o0[i] = sigm(g[i] + b0[i]) * v0[i]; o1[i] = sigm(g[4 + i] + b1[i]) * v1[i]; }
                    *(f32x4*)(MIXF + row * 1024 + c) = o0; *(f32x4*)(MIXF + row * 1024 + c + 4) = o1; } }
    }
};
struct EpiGate2 {
    static constexpr bool PERM = true, AFTER_DRAIN = false; const bf16_t* Gp; int ldg; const float* gb; const float* MIXF; bf16_t* MIX;
    __device__ __forceinline__ void operator()(const f32x4 (&acc)[2][2][4][2], const Unit& u, int wr, int wc, int fr, int fq) const {
        const int row0 = u.pm * BM + wr * 64 + fr, col0 = u.pn * BM + wc * 32 + 8 * fq;
#pragma unroll
        for (int ai = 0; ai < 2; ++ai)
#pragma unroll
            for (int m = 0; m < 4; ++m) { const size_t row = (size_t)(row0 + ai * HALF + m * 16);
#pragma unroll
                for (int bj = 0; bj < 2; ++bj) { const int c = col0 + bj * HALF; float g[8]; unpack8(*(const u32x4*)(Gp + row * ldg + c), g);
                    const f32x4 b0 = *(const f32x4*)(gb + c), b1 = *(const f32x4*)(gb + c + 4); const f32x4 v0 = acc[ai][bj][m][0], v1 = acc[ai][bj][m][1];
                    const f32x4 p0 = *(const f32x4*)(MIXF + row * 1024 + c), p1 = *(const f32x4*)(MIXF + row * 1024 + c + 4); f32x4 o0, o1;
#pragma unroll
                    for (int i = 0; i < 4; ++i) { o0[i] = p0[i] + sigm(g[i] + b0[i]) * v0[i]; o1[i] = p1[i] + sigm(g[4 + i] + b1[i]) * v1[i]; }
                    u32x4 w; w.x = cvt_pk_bf16(o0[0], o0[1]); w.y = cvt_pk_bf16(o0[2], o0[3]); w.z = cvt_pk_bf16(o1[0], o1[1]); w.w = cvt_pk_bf16(o1[2], o1[3]);
                    *(u32x4*)(MIX + row * 1024 + c) = w; } }
    }
};
struct EpiResid {
    static constexpr bool PERM = true, AFTER_DRAIN = false; const float* base; float* out;
    __device__ __forceinline__ void operator()(const f32x4 (&acc)[2][2][4][2], const Unit& u, int wr, int wc, int fr, int fq) const {
        const int row0 = u.pm * BM + wr * 64 + fr, col0 = u.pn * BM + wc * 32 + 8 * fq;
#pragma unroll
        for (int ai = 0; ai < 2; ++ai)
#pragma unroll
            for (int m = 0; m < 4; ++m) { const size_t row = (size_t)(row0 + ai * HALF + m * 16);
#pragma unroll
                for (int bj = 0; bj < 2; ++bj) { const size_t o = row * 1024 + col0 + bj * HALF;
                    const f32x4 p0 = *(const f32x4*)(base + o), p1 = *(const f32x4*)(base + o + 4);
                    *(f32x4*)(out + o) = p0 + acc[ai][bj][m][0]; *(f32x4*)(out + o + 4) = p1 + acc[ai][bj][m][1]; } }
    }
};
struct EpiSwiglu {
    static constexpr bool PERM = true, AFTER_DRAIN = false; bf16_t* ACT; const float* bgu;
    __device__ __forceinline__ void operator()(const f32x4 (&acc)[2][2][4][2], const Unit& u, int wr, int wc, int fr, int fq) const {
        const int e = u.pn >> 3, pl = u.pn & 7, j0 = 128 * pl + wc * 32 + 8 * fq; const int row0 = u.pm * BM + wr * 64 + fr;
        float bg[8], bu[8];
        { const float* bs = bgu + (size_t)e * 2048 + 2 * j0;
#pragma unroll
          for (int q = 0; q < 4; ++q) { const f32x4 t = *(const f32x4*)(bs + 4 * q); bg[2 * q] = t[0]; bu[2 * q] = t[1]; bg[2 * q + 1] = t[2]; bu[2 * q + 1] = t[3]; } }
#pragma unroll
        for (int ai = 0; ai < 2; ++ai)
#pragma unroll
            for (int m = 0; m < 4; ++m) { const size_t row = (size_t)(row0 + ai * HALF + m * 16); float a[8];
#pragma unroll
                for (int i = 0; i < 8; ++i) { const float gr = (i < 4 ? acc[ai][0][m][0][i & 3] : acc[ai][0][m][1][i & 3]) + bg[i], ur = (i < 4 ? acc[ai][1][m][0][i & 3] : acc[ai][1][m][1][i & 3]) + bu[i];
                    const float g = fminf(gr, 7.0f), uu = fminf(fmaxf(ur, -7.0f), 7.0f); a[i] = (uu + 1.0f) * (g * sigm(1.702f * g)); }
                u32x4 w; w.x = cvt_pk_bf16(a[0], a[1]); w.y = cvt_pk_bf16(a[2], a[3]); w.z = cvt_pk_bf16(a[4], a[5]); w.w = cvt_pk_bf16(a[6], a[7]);
                *(u32x4*)(ACT + row * 1024 + j0) = w; }
    }
};
struct EpiDown {
    static constexpr bool PERM = true, AFTER_DRAIN = false; bf16_t* Y; const float* bd; const float* roww;
    __device__ __forceinline__ void operator()(const f32x4 (&acc)[2][2][4][2], const Unit& u, int wr, int wc, int fr, int fq) const {
        const int e = u.pn >> 2, pl = u.pn & 3, col0 = pl * BM + wc * 32 + 8 * fq; const int row0 = u.pm * BM + wr * 64 + fr;
#pragma unroll
        for (int ai = 0; ai < 2; ++ai)
#pragma unroll
            for (int m = 0; m < 4; ++m) { const size_t row = (size_t)(row0 + ai * HALF + m * 16); const float rw = roww[row];
#pragma unroll
                for (int bj = 0; bj < 2; ++bj) { const int c = col0 + bj * HALF; const f32x4 b0 = *(const f32x4*)(bd + (size_t)e * 1024 + c), b1 = *(const f32x4*)(bd + (size_t)e * 1024 + c + 4);
                    const f32x4 v0 = (acc[ai][bj][m][0] + b0) * rw, v1 = (acc[ai][bj][m][1] + b1) * rw; u32x4 w;
                    w.x = cvt_pk_bf16(v0[0], v0[1]); w.y = cvt_pk_bf16(v0[2], v0[3]); w.z = cvt_pk_bf16(v1[0], v1[1]); w.w = cvt_pk_bf16(v1[2], v1[3]);
                    *(u32x4*)(Y + row * 1024 + c) = w; } }
    }
};
template <class Epi, class Sched, bool ALIGN_EPI = false, bool SP2 = false>
__device__ __forceinline__ void gemm_phase(PG8_LAS unsigned char* lds, const Gemm g, const Sched& S, const Epi& E) {
    const int tid = threadIdx.x, wid = __builtin_amdgcn_readfirstlane(tid >> 6), lane = tid & 63, wr = wid >> 2, wc = wid & 3, fr = lane & 15, fq = lane >> 4;
    const int K = g.K, nt = K / BK;
    unsigned voffA[2], voffB[2];
#pragma unroll
    for (int i = 0; i < 2; ++i) { int R, C; stage_rc(tid * 16 + i * 8192, R, C); const int Rb = Epi::PERM ? ((R & ~31) + perm32(R & 31)) : R;
        voffA[i] = (unsigned)(R * K + C) * 2u; voffB[i] = (unsigned)(Rb * K + C) * 2u; }
    const size_t kstep = (size_t)(BK * 2);
    const size_t hstep = (size_t)HALF * K * 2;
    const size_t tstep = 2 * hstep;
    const unsigned ldsw = (unsigned)wid * 1024u;
    const int aoff = lds_byte(wr * 64 + fr, fq * 8), boff = lds_byte(wc * 32 + fr, fq * 8);
#define PG8_SA(b, h) (((b) * 2 + (h)) * HTB)
#define PG8_SB(b, h) ((4 + (b) * 2 + (h)) * HTB)
#define PG8_STAGE(bufoff, gbase, voff) do { _Pragma("unroll") for (int _i = 0; _i < 2; ++_i) \
        __builtin_amdgcn_global_load_lds((const unsigned*)((const char*)(gbase) + (voff)[_i]), (PG8_LAS unsigned*)(lds + (bufoff) + ldsw + _i * 8192), 16, 0, 0); } while (0)
#define PG8_LDA(dst, b, h) do { _Pragma("unroll") for (int m = 0; m < 4; ++m) _Pragma("unroll") for (int k = 0; k < 2; ++k) dst[m][k] = *(const PG8_LAS bf16x8*)(lds + PG8_SA(b, h) + aoff + m * 2048 + k * 1024); } while (0)
#define PG8_LDB(dst, b, h) do { _Pragma("unroll") for (int n = 0; n < 2; ++n) _Pragma("unroll") for (int k = 0; k < 2; ++k) dst[n][k] = *(const PG8_LAS bf16x8*)(lds + PG8_SB(b, h) + boff + n * 2048 + k * 1024); } while (0)
#define PG8_MMA(ai, bj, At, Bt) do { __builtin_amdgcn_s_setprio(1); _Pragma("unroll") for (int m = 0; m < 4; ++m) _Pragma("unroll") for (int n = 0; n < 2; ++n) _Pragma("unroll") for (int k = 0; k < 2; ++k) \
        acc[ai][bj][m][n] = __builtin_amdgcn_mfma_f32_16x16x32_bf16(Bt[n][k], At[m][k], acc[ai][bj][m][n], 0, 0, 0); __builtin_amdgcn_s_setprio(0); } while (0)
#define PG8_WAIT_V(n) asm volatile("s_waitcnt vmcnt(" #n ")" ::: "memory")
#define PG8_WAIT_L(n) asm volatile("s_waitcnt lgkmcnt(" #n ")" ::: "memory")
#define PG8_BAR __builtin_amdgcn_s_barrier()
#define PG8_SCHED __builtin_amdgcn_sched_barrier(0)
    Unit cur, nxt; int ui = 0;
    if (!S.next(0, cur)) return;
    f32x4 acc[2][2][4][2];
#pragma unroll
    for (int a = 0; a < 2; ++a)
#pragma unroll
        for (int b = 0; b < 2; ++b)
#pragma unroll
            for (int m = 0; m < 4; ++m)
#pragma unroll
                for (int n = 0; n < 2; ++n) acc[a][b][m][n] = (f32x4){0.f, 0.f, 0.f, 0.f};
    bf16x8 At[4][2], B0[2][2], B1[2][2];
    const char* cA = (const char*)g.A + (size_t)cur.pm * tstep; const char* cB = (const char*)g.Bt + (size_t)cur.pn * tstep;
    S.a_ready(cur);
    if constexpr (SP2) {
        PG8_STAGE(PG8_SB(0, 0), cB, voffB); PG8_STAGE(PG8_SB(0, 1), cB + hstep, voffB); PG8_STAGE(PG8_SA(0, 0), cA, voffA); PG8_STAGE(PG8_SA(0, 1), cA + hstep, voffA);
        if (wr == 1) PG8_BAR;
        PG8_WAIT_V(2); PG8_BAR;
        PG8_STAGE(PG8_SB(1, 0), cB + kstep, voffB); PG8_STAGE(PG8_SA(1, 0), cA + kstep, voffA); PG8_STAGE(PG8_SB(1, 1), cB + hstep + kstep, voffB);
        PG8_WAIT_V(6); PG8_BAR;
    } else {
        PG8_STAGE(PG8_SB(0, 0), cB, voffB); PG8_STAGE(PG8_SA(0, 0), cA, voffA); PG8_STAGE(PG8_SB(0, 1), cB + hstep, voffB); PG8_STAGE(PG8_SA(0, 1), cA + hstep, voffA);
        if (wr == 1) PG8_BAR;
        PG8_WAIT_V(4); PG8_BAR;
        PG8_STAGE(PG8_SB(1, 0), cB + kstep, voffB); PG8_STAGE(PG8_SA(1, 0), cA + kstep, voffA); PG8_STAGE(PG8_SB(1, 1), cB + hstep + kstep, voffB);
        PG8_WAIT_V(6); PG8_BAR;
    }
    for (;;) {
        const bool has_next = S.next(ui + 1, nxt);
        const char* nA = has_next ? (const char*)g.A + (size_t)nxt.pm * tstep : cA; const char* nB = has_next ? (const char*)g.Bt + (size_t)nxt.pn * tstep : cB;
        for (int t = 0; t < nt; t += 2) {
            const bool last = (t == nt - 2);
            const char* a1 = cA + (size_t)(t + 1) * kstep;
            const char* a2 = last ? nA : cA + (size_t)(t + 2) * kstep; const char* b2 = last ? nB : cB + (size_t)(t + 2) * kstep;
            const char* a3 = a2 + kstep; const char* b3 = b2 + kstep;
            if (last && has_next) S.a_ready(nxt);
            if constexpr (SP2) {
            PG8_LDB(B0, 0, 0); PG8_LDB(B1, 0, 1); PG8_SCHED; PG8_LDA(At, 0, 0); PG8_STAGE(PG8_SA(1, 1), a1 + hstep, voffA);
            PG8_WAIT_V(8); PG8_WAIT_L(0); PG8_BAR; PG8_MMA(0, 0, At, B0); PG8_MMA(0, 1, At, B1); PG8_BAR; PG8_SCHED;
            PG8_LDA(At, 0, 1); PG8_STAGE(PG8_SB(0, 0), b2, voffB); PG8_STAGE(PG8_SB(0, 1), b2 + hstep, voffB); PG8_STAGE(PG8_SA(0, 0), a2, voffA);
            PG8_WAIT_V(8); PG8_WAIT_L(0); PG8_BAR; PG8_MMA(1, 0, At, B0); PG8_MMA(1, 1, At, B1); PG8_BAR; PG8_SCHED;
            PG8_LDB(B0, 1, 0); PG8_LDB(B1, 1, 1); PG8_SCHED; PG8_LDA(At, 1, 0); PG8_STAGE(PG8_SA(0, 1), a2 + hstep, voffA);
            PG8_WAIT_V(8); PG8_WAIT_L(0); PG8_BAR; PG8_MMA(0, 0, At, B0); PG8_MMA(0, 1, At, B1); PG8_BAR; PG8_SCHED;
            PG8_LDA(At, 1, 1); PG8_STAGE(PG8_SB(1, 0), b3, voffB); PG8_STAGE(PG8_SB(1, 1), b3 + hstep, voffB); PG8_STAGE(PG8_SA(1, 0), a3, voffA);
            PG8_WAIT_V(8); PG8_WAIT_L(0); PG8_BAR; PG8_MMA(1, 0, At, B0); PG8_MMA(1, 1, At, B1); PG8_BAR; PG8_SCHED;
            } else {
            PG8_LDB(B0, 0, 0); PG8_SCHED; PG8_LDA(At, 0, 0); PG8_STAGE(PG8_SA(1, 1), a1 + hstep, voffA);
            PG8_WAIT_L(8); PG8_BAR; PG8_WAIT_L(0); PG8_MMA(0, 0, At, B0); PG8_BAR; PG8_SCHED;
            PG8_LDB(B1, 0, 1); PG8_STAGE(PG8_SB(0, 0), b2, voffB);
            PG8_BAR; PG8_WAIT_L(0); PG8_MMA(0, 1, At, B1); PG8_BAR;
            PG8_LDA(At, 0, 1); PG8_STAGE(PG8_SA(0, 0), a2, voffA);
            PG8_BAR; PG8_WAIT_L(0); PG8_MMA(1, 0, At, B0); PG8_BAR; PG8_SCHED;
            PG8_STAGE(PG8_SB(0, 1), b2 + hstep, voffB);
            PG8_WAIT_V(6); PG8_BAR; PG8_MMA(1, 1, At, B1); PG8_BAR;
            PG8_LDB(B0, 1, 0); PG8_SCHED; PG8_LDA(At, 1, 0); PG8_STAGE(PG8_SA(0, 1), a2 + hstep, voffA);
            PG8_WAIT_L(8); PG8_BAR; PG8_WAIT_L(0); PG8_MMA(0, 0, At, B0); PG8_BAR; PG8_SCHED;
            PG8_LDB(B1, 1, 1); PG8_STAGE(PG8_SB(1, 0), b3, voffB);
            PG8_BAR; PG8_WAIT_L(0); PG8_MMA(0, 1, At, B1); PG8_BAR;
            PG8_LDA(At, 1, 1); PG8_STAGE(PG8_SA(1, 0), a3, voffA);
            PG8_BAR; PG8_WAIT_L(0); PG8_MMA(1, 0, At, B0); PG8_BAR; PG8_SCHED;
            PG8_STAGE(PG8_SB(1, 1), b3 + hstep, voffB);
            PG8_WAIT_V(6); PG8_BAR; PG8_MMA(1, 1, At, B1); PG8_BAR;
            }
        }
        if constexpr (ALIGN_EPI) { if (wr == 0) PG8_BAR; }
        if constexpr (!Epi::AFTER_DRAIN) { E(acc, cur, wr, wc, fr, fq); S.done(cur); }
        if (!has_next) break;
#pragma unroll
        for (int a = 0; a < 2; ++a)
#pragma unroll
            for (int b = 0; b < 2; ++b)
#pragma unroll
                for (int m = 0; m < 4; ++m)
#pragma unroll
                    for (int n = 0; n < 2; ++n) acc[a][b][m][n] = (f32x4){0.f, 0.f, 0.f, 0.f};
        cur = nxt; cA = nA; cB = nB; ++ui;
        if constexpr (ALIGN_EPI) { if (wr == 1) PG8_BAR; }
    }
    PG8_WAIT_V(0);
    if constexpr (!ALIGN_EPI) { if (wr == 0) PG8_BAR; }
    PG8_BAR;
    if constexpr (Epi::AFTER_DRAIN) { E.fused(acc, cur, wr, wc, fr, fq, lds, wid, lane); S.done(cur); }
#undef PG8_SA
#undef PG8_SB
#undef PG8_STAGE
#undef PG8_LDA
#undef PG8_LDB
#undef PG8_MMA
#undef PG8_WAIT_V
#undef PG8_WAIT_L
#undef PG8_BAR
#undef PG8_SCHED
}
}
constexpr int NWAVES = 8;
#ifndef REP_MASK
#define REP_MASK 0
#endif
#define REP(k) (1 + (((REP_MASK) >> (k)) & 1))
enum { PH_PRO = 0, PH_INPROJ, PH_PREP, PH_SSD, PH_ATTN, PH_OPROJ, PH_WOUT, PH_ROUTE, PH_GATHER, PH_GU, PH_DOWN, PH_COMB, N_PHASES };
#ifndef ATTN_SIMPLE
#define ATTN_SIMPLE 0
#endif
#ifndef MK_PER_PHASE
#define MK_PER_PHASE 0
#endif
constexpr int BATCH = 8, SEQ = 2048, D = 1024, M = BATCH * SEQ;
constexpr int NH = 16, HD = 64, MBLK = 256, NBLK = SEQ / MBLK, MOBA_TOPK = 3;
constexpr int D_INNER = 2048, SSD_H = 32, NGRP = 4, DSTATE = 128, D_XBC = 3072, CONVK = 4;
constexpr int N_IN = 10272, NPROJ = 10240;
constexpr int PQ = 0, PK = 1024, PV = 2048, PZ = 3072, PXBC = 5120, PGATE = 8192;
constexpr int COL_DT = 8192;
constexpr int NEXP = 32, TOPK = 4, EXPCAP = 16384, MAXROWS = M * TOPK + NEXP * 256, MAXTILES = MAXROWS / 256;
constexpr float NORM_EPS = 1e-6f;
constexpr float QSCALE = 0.125f * 1.4426950408889634f;

constexpr size_t MiB = 1u << 20;
constexpr size_t WS_CTL = 0, CTL_ZERO_BYTES = 2 * MiB;
constexpr size_t WS_KM = 1 * MiB;
constexpr size_t WS_WIN = 2 * MiB, WS_WOA = 22 * MiB, WS_WOS = 24 * MiB, WS_WOUT = 28 * MiB, WS_WGU = 30 * MiB, WS_WDN = 158 * MiB;
constexpr size_t WS_WDT = 222 * MiB, WS_WRT = 222 * MiB + 512 * 1024;
constexpr size_t WS_XN = 223 * MiB, WS_DT = 255 * MiB, WS_SSQ = 257 * MiB, WS_YG = 259 * MiB, WS_AO = 323 * MiB, WS_MIXF = 355 * MiB, WS_MIX = 419 * MiB, WS_H2 = 451 * MiB;
constexpr size_t WS_TOKL = 483 * MiB, WS_GATEW = 485 * MiB, WS_POS = 486 * MiB, WS_ROWW = 487 * MiB;
constexpr size_t WS_PROJ = 488 * MiB, WS_XC = 808 * MiB, WS_END = 904 * MiB;
constexpr size_t WS_XG = WS_PROJ, WS_ACT = WS_PROJ + 144 * MiB, WS_Y = WS_XG;
static_assert(WS_ACT + (size_t)MAXROWS * 1024 * 2 <= WS_END, "MoE overlay");
constexpr int CW_TMO = 0, CW_CODE = 1, CW_BAR = 4096, CW_CNT = 16384;

constexpr int RING_OFF = 0, RING_BYTES = 131072;
constexpr int LDSCTL_OFF = RING_BYTES, MISC_OFF = LDSCTL_OFF + 320, TILEE_OFF = LDSCTL_OFF + 1024, ROWB_OFF = LDSCTL_OFF + 2560, CNTL_OFF = LDSCTL_OFF + 2816;
constexpr int LDS_BYTES = 147456;

#define GAS __attribute__((address_space(1)))
#define LAS __attribute__((address_space(3)))
typedef unsigned short bf16;
typedef unsigned v4u __attribute__((ext_vector_type(4)));
typedef unsigned v2u __attribute__((ext_vector_type(2)));
typedef float f32x4 __attribute__((ext_vector_type(4)));
typedef GAS unsigned gu32;
#define RLX_AGENT __ATOMIC_RELAXED, __HIP_MEMORY_SCOPE_AGENT
#define LDS_WAIT() asm volatile("s_waitcnt lgkmcnt(0)" ::: "memory")
#define VM_WAIT() asm volatile("s_waitcnt vmcnt(0)" ::: "memory")
__device__ __forceinline__ unsigned f2bf(float f) { unsigned u = __builtin_bit_cast(unsigned, f); return (u + 0x7fffu + ((u >> 16) & 1u)) >> 16; }
__device__ __forceinline__ unsigned pk2(float lo, float hi) { return f2bf(lo) | (f2bf(hi) << 16); }
__device__ __forceinline__ float bf2f(bf16 b) { return __uint_as_float((unsigned)b << 16); }
__device__ __forceinline__ void unpk8(const v4u w, float (&f)[8]) {
#pragma unroll
    for (int i = 0; i < 4; ++i) { f[2 * i] = __uint_as_float(w[i] << 16); f[2 * i + 1] = __uint_as_float(w[i] & 0xffff0000u); }
}
__device__ __forceinline__ v4u pack8(const float (&f)[8]) { v4u w; w.x = pk2(f[0], f[1]); w.y = pk2(f[2], f[3]); w.z = pk2(f[4], f[5]); w.w = pk2(f[6], f[7]); return w; }
__device__ __forceinline__ float wave_sum(float v) {
#pragma unroll
    for (int o = 1; o < 64; o <<= 1) v += __shfl_xor(v, o);
    return v;
}
__device__ __forceinline__ float wave_max(float v) {
#pragma unroll
    for (int o = 1; o < 64; o <<= 1) v = fmaxf(v, __shfl_xor(v, o));
    return v;
}
__device__ __forceinline__ float silu_f(float x) { return x / (1.f + __expf(-x)); }
#define XB_TMO      128
#define XB_XCNT(j)  (256  + 64 * (j))
#define XB_XSUB(j)  (1280 + 64 * (j))
#define XB_XGEN(j)  (2304 + 64 * (j))
#define XB_TOP      3328
#define XB_TOPGEN   3392
#define XCD_BAR_WORDS 3456
#define XB_SPIN_CAP (1u << 18)

__device__ __forceinline__ unsigned xb_ld(unsigned* p)              { return __hip_atomic_load(p, __ATOMIC_RELAXED, __HIP_MEMORY_SCOPE_AGENT); }
__device__ __forceinline__ unsigned xb_add(unsigned* p, unsigned v) { return __hip_atomic_fetch_add(p, v, __ATOMIC_RELAXED, __HIP_MEMORY_SCOPE_AGENT); }
__device__ __forceinline__ unsigned xb_xcc_id() { return (unsigned)__builtin_amdgcn_s_getreg((3 << 11) | 20) & 0xFu; }
#define XB_SPIN(cond, bar) do { unsigned _sp = 0; while (cond) { __builtin_amdgcn_s_sleep(1); \
    if ((++_sp & 255u) == 0u) { if (xb_ld(&(bar)[XB_TMO])) break; if (_sp > XB_SPIN_CAP) { atomicAdd(&(bar)[XB_TMO], 1u); break; } } } } while (0)

struct XcdBarrier {
    unsigned* bar; unsigned x;
    volatile LAS unsigned* st;
};

__device__ __forceinline__ XcdBarrier xcd_barrier_post(unsigned* bar, volatile LAS unsigned* st) {
    XcdBarrier b; b.bar = bar; b.x = xb_xcc_id(); b.st = st;
    if (threadIdx.x == 0) (void)xb_add(&bar[XB_XCNT(b.x)], 1u);
    return b;
}
__device__ __forceinline__ void xcd_barrier_complete(unsigned* bar, unsigned x, unsigned& nloc, unsigned& nx) {
    const unsigned G = gridDim.x * gridDim.y * gridDim.z;
    unsigned sum, cnt, mine, sp = 0u;
    for (;;) {
        sum = 0u; cnt = 0u; mine = 0u;
#pragma unroll
        for (unsigned j = 0; j < 16; ++j) { const unsigned c = xb_ld(&bar[XB_XCNT(j)]); sum += c; cnt += (c > 0u) ? 1u : 0u; mine = (j == x) ? c : mine; }
        if (sum == G) break;
        __builtin_amdgcn_s_sleep(1);
        if ((++sp & 255u) == 0u) { if (xb_ld(&bar[XB_TMO])) break; if (sp > XB_SPIN_CAP) { atomicAdd(&bar[XB_TMO], 1u); break; } }
    }
    nloc = mine > 0u ? mine : 1u; nx = cnt > 0u ? cnt : 1u;
}

__device__ __forceinline__ void xcd_barrier(const XcdBarrier& b) {
    asm volatile("s_waitcnt vmcnt(0)" ::: "memory");
    __syncthreads();
    if (threadIdx.x == 0) {
        unsigned* bar = b.bar;
        __builtin_amdgcn_s_waitcnt(0);
        unsigned nloc = b.st[0], nx = b.st[1];
        if (nloc == 0u) { xcd_barrier_complete(bar, b.x, nloc, nx); b.st[0] = nloc; b.st[1] = nx; }
        const unsigned old = xb_add(&bar[XB_XSUB(b.x)], 1u);
        const unsigned gen = old / nloc;
        if (old + 1u == (gen + 1u) * nloc) {
            __builtin_amdgcn_fence(__ATOMIC_RELEASE, "agent");
            asm volatile("s_waitcnt vmcnt(0)" ::: "memory");
            const unsigned og = xb_add(&bar[XB_TOP], 1u);
            const unsigned tg = og / nx;
            if (og + 1u == (tg + 1u) * nx) xb_add(&bar[XB_TOPGEN], 1u);
            else XB_SPIN(xb_ld(&bar[XB_TOPGEN]) == tg, bar);
            __builtin_amdgcn_fence(__ATOMIC_ACQUIRE, "agent");
            xb_add(&bar[XB_XGEN(b.x)], 1u);
            asm volatile("s_waitcnt vmcnt(0)" ::: "memory");
        } else {
            XB_SPIN(xb_ld(&bar[XB_XGEN(b.x)]) == gen, bar);
            __builtin_amdgcn_fence(__ATOMIC_ACQUIRE, "agent");
            asm volatile("s_waitcnt vmcnt(0)" ::: "memory");
        }
    }
    __syncthreads();
}
struct Args { const float* in[22]; float* out; unsigned char* ws; int ph_lo, ph_hi; };
struct Frame {
    LAS unsigned char* lds;
    volatile LAS unsigned* MISC;
    gu32* ctl;
    int tid, lane, wave, vcu, G;
};
#define IN_X(A)      ((A).in[0])
#define IN_LN1W(A)   ((A).in[1])
#define IN_WIN(A)    ((A).in[2])
#define IN_GATEB(A)  ((A).in[3])
#define IN_QNW(A)    ((A).in[4])
#define IN_KNW(A)    ((A).in[5])
#define IN_CONVW(A)  ((A).in[6])
#define IN_CONVB(A)  ((A).in[7])
#define IN_DTB(A)    ((A).in[8])
#define IN_ALOG(A)   ((A).in[9])
#define IN_DSKIP(A)  ((A).in[10])
#define IN_SSDNW(A)  ((A).in[11])
#define IN_WOA(A)    ((A).in[12])
#define IN_WOS(A)    ((A).in[13])
#define IN_WOUT(A)   ((A).in[14])
#define IN_LN2W(A)   ((A).in[15])
#define IN_WR(A)     ((A).in[16])
#define IN_BR(A)     ((A).in[17])
#define IN_WGU(A)    ((A).in[18])
#define IN_BGU(A)    ((A).in[19])
#define IN_WDN(A)    ((A).in[20])
#define IN_BDN(A)    ((A).in[21])
#define WSP(A, T, off) ((T*)((A).ws + (off)))

template <class Map>
__device__ __forceinline__ void transpose_item(const float* W, int K, int N, bf16* WT, LAS unsigned* scr, int kb, int nb, int lane, const Map& dest_row) {
    const int k0 = 64 * kb, n0 = 64 * nb, cc = lane & 15, kpl = lane >> 4;
    int col = n0 + 4 * cc; if (col > N - 4) col = N - 4;
    f32x4 a[8], b[8];
#pragma unroll
    for (int it = 0; it < 8; ++it) { const int kp = 4 * it + kpl; a[it] = *(const f32x4*)(W + (size_t)(k0 + 2 * kp) * N + col); b[it] = *(const f32x4*)(W + (size_t)(k0 + 2 * kp + 1) * N + col); }
#pragma unroll
    for (int it = 0; it < 8; ++it) { const int kp = 4 * it + kpl;
#pragma unroll
        for (int i = 0; i < 4; ++i) scr[(4 * cc + i) * 33 + kp] = pk2(a[it][i], b[it][i]); }
    LDS_WAIT(); asm volatile("" ::: "memory");
    const int rr = lane >> 3, ch = lane & 7;
#pragma unroll
    for (int j = 0; j < 8; ++j) { const int n = 8 * j + rr; const LAS unsigned* s = scr + n * 33 + 4 * ch; v4u o; o.x = s[0]; o.y = s[1]; o.z = s[2]; o.w = s[3];
        const int dr = dest_row(n0 + n); if (dr >= 0) *(v4u*)(WT + (size_t)dr * K + k0 + 8 * ch) = o; }
    LDS_WAIT(); asm volatile("" ::: "memory");
}
struct MapId { int N; __device__ __forceinline__ int operator()(int s) const { return s < N ? s : -1; } };
struct MapWin { __device__ __forceinline__ int operator()(int s) const { return s < COL_DT ? s : (s < COL_DT + SSD_H ? -1 : (s < N_IN ? s - SSD_H : -1)); } };
struct MapGu { __device__ __forceinline__ int operator()(int s) const { const int j = s >> 1, isu = s & 1; return (j >> 7) * 256 + (j & 127) + 128 * isu; } };

__device__ __forceinline__ void p0_prologue(Frame& F, const Args& A) {
    LAS unsigned* scr = (LAS unsigned*)(F.lds + RING_OFF + F.wave * 8704);
    const int gw = F.vcu * NWAVES + F.wave, NGW = F.G * NWAVES, lane = F.lane;
    constexpr int I_IN = 16 * 161, I_OA = 16 * 16, I_OS = 32 * 16, I_OUT = 16 * 16, I_GU1 = 16 * 32, I_GU = NEXP * I_GU1, I_DN1 = 16 * 16, I_DN = NEXP * I_DN1;
    constexpr int NITEMS = I_IN + I_OA + I_OS + I_OUT + I_GU + I_DN;
    for (int it = gw; it < NITEMS; it += NGW) {
        int r = it;
        if (r < I_IN) { transpose_item(IN_WIN(A), 1024, N_IN, WSP(A,bf16,WS_WIN), scr, r / 161, r % 161, lane, MapWin{}); continue; } r -= I_IN;
        if (r < I_OA) { transpose_item(IN_WOA(A), 1024, 1024, WSP(A,bf16,WS_WOA), scr, r / 16, r % 16, lane, MapId{1024}); continue; } r -= I_OA;
        if (r < I_OS) { transpose_item(IN_WOS(A), 2048, 1024, WSP(A,bf16,WS_WOS), scr, r / 16, r % 16, lane, MapId{1024}); continue; } r -= I_OS;
        if (r < I_OUT) { transpose_item(IN_WOUT(A), 1024, 1024, WSP(A,bf16,WS_WOUT), scr, r / 16, r % 16, lane, MapId{1024}); continue; } r -= I_OUT;
        if (r < I_GU) { const int e = r / I_GU1, q = r % I_GU1; transpose_item(IN_WGU(A) + (size_t)e * 1024 * 2048, 1024, 2048, WSP(A,bf16,WS_WGU) + (size_t)e * 2048 * 1024, scr, q / 32, q % 32, lane, MapGu{}); continue; } r -= I_GU;
        { const int e = r / I_DN1, q = r % I_DN1; transpose_item(IN_WDN(A) + (size_t)e * 1024 * 1024, 1024, 1024, WSP(A,bf16,WS_WDN) + (size_t)e * 1024 * 1024, scr, q / 16, q % 16, lane, MapId{1024}); }
    }
    { const int gt = F.vcu * 512 + F.tid, NGT = F.G * 512;
      for (int i = gt; i < 32 * 1024; i += NGT) { const int e = i >> 10, k = i & 1023; WSP(A,float,WS_WDT)[i] = IN_WIN(A)[(size_t)k * N_IN + COL_DT + e]; WSP(A,float,WS_WRT)[i] = IN_WR(A)[k * 32 + e]; } }
    for (int m = gw; m < M; m += NGW) {
        const f32x4* xr = (const f32x4*)(IN_X(A) + (size_t)m * D) + lane; const f32x4* wr = (const f32x4*)IN_LN1W(A) + lane;
        f32x4 v[4]; float s = 0.f;
#pragma unroll
        for (int j = 0; j < 4; ++j) { v[j] = xr[64 * j]; s += (v[j].x * v[j].x + v[j].y * v[j].y) + (v[j].z * v[j].z + v[j].w * v[j].w); }
        const float rs = 1.0f / sqrtf(wave_sum(s) * (1.f / D) + NORM_EPS);
        v2u* o8 = (v2u*)(WSP(A,bf16,WS_XN) + (size_t)m * D) + lane;
#pragma unroll
        for (int j = 0; j < 4; ++j) { const f32x4 w = wr[64 * j]; v2u o; o.x = pk2(v[j].x * rs * w.x, v[j].y * rs * w.y); o.y = pk2(v[j].z * rs * w.z, v[j].w * rs * w.w); o8[64 * j] = o; }
    }
}

__device__ __forceinline__ float rowdot32(const float (&h)[16], const LAS float* WT, int lane) {
    float mine = 0.f;
#pragma unroll 2
    for (int e = 0; e < 32; ++e) { float s = 0.f;
#pragma unroll
        for (int j = 0; j < 4; ++j) { const f32x4 w = *(const LAS f32x4*)(WT + e * 1024 + 256 * j + 4 * lane); s += (h[4 * j] * w.x + h[4 * j + 1] * w.y) + (h[4 * j + 2] * w.z + h[4 * j + 3] * w.w); }
        s = wave_sum(s); mine = (lane == e) ? s : mine; }
    return mine;
}
__device__ __forceinline__ void stage_wt(Frame& F, const float* src) {
    LAS f32x4* dst = (LAS f32x4*)(F.lds + RING_OFF); const f32x4* s4 = (const f32x4*)src;
    for (int i = F.tid; i < 8192; i += NWAVES * 64) dst[i] = s4[i];
    __syncthreads();
}

__device__ __forceinline__ void p2_prep(Frame& F, const Args& A) {
    stage_wt(F, WSP(A,float,WS_WDT));
    const LAS float* WT = (const LAS float*)(F.lds + RING_OFF);
    const int lane = F.lane, wave = F.wave;
    float qw[16], kw[16];
#pragma unroll
    for (int q = 0; q < 4; ++q) { const f32x4 a = *(const f32x4*)(IN_QNW(A) + 16 * (lane & 3) + 4 * q), b = *(const f32x4*)(IN_KNW(A) + 16 * (lane & 3) + 4 * q);
#pragma unroll
        for (int i = 0; i < 4; ++i) { qw[4 * q + i] = a[i] * QSCALE; kw[4 * q + i] = b[i]; } }
    for (int item = F.vcu; item < M / 32; item += F.G) {
        const int t0 = item * 32 + wave * 4, b = t0 / SEQ, blk = (t0 % SEQ) / MBLK;
        float km[16];
#pragma unroll
        for (int i = 0; i < 16; ++i) km[i] = 0.f;
        for (int tt = 0; tt < 4; ++tt) {
            const int t = t0 + tt, pos = t % SEQ;
            bf16* prow = WSP(A,bf16,WS_PROJ) + (size_t)t * NPROJ;
            {
                float v[16]; { float lo[8], hi[8]; unpk8(*(const v4u*)(prow + PQ + 16 * lane), lo); unpk8(*(const v4u*)(prow + PQ + 16 * lane + 8), hi);
#pragma unroll
                    for (int i = 0; i < 8; ++i) { v[i] = lo[i]; v[8 + i] = hi[i]; } }
                float ss = 0.f;
#pragma unroll
                for (int i = 0; i < 16; ++i) ss += v[i] * v[i];
                ss += __shfl_xor(ss, 1); ss += __shfl_xor(ss, 2);
                const float rs = 1.0f / sqrtf(ss * (1.f / 64.f) + NORM_EPS);
                float lo[8], hi[8];
#pragma unroll
                for (int i = 0; i < 8; ++i) { lo[i] = v[i] * rs * qw[i]; hi[i] = v[8 + i] * rs * qw[8 + i]; }
                *(v4u*)(prow + PQ + 16 * lane) = pack8(lo); *(v4u*)(prow + PQ + 16 * lane + 8) = pack8(hi);
            }
            {
                float v[16]; { float lo[8], hi[8]; unpk8(*(const v4u*)(prow + PK + 16 * lane), lo); unpk8(*(const v4u*)(prow + PK + 16 * lane + 8), hi);
#pragma unroll
                    for (int i = 0; i < 8; ++i) { v[i] = lo[i]; v[8 + i] = hi[i]; } }
                float ss = 0.f;
#pragma unroll
                for (int i = 0; i < 16; ++i) ss += v[i] * v[i];
                ss += __shfl_xor(ss, 1); ss += __shfl_xor(ss, 2);
                const float rs = 1.0f / sqrtf(ss * (1.f / 64.f) + NORM_EPS);
                float lo[8], hi[8];
#pragma unroll
                for (int i = 0; i < 8; ++i) { lo[i] = v[i] * rs * kw[i]; hi[i] = v[8 + i] * rs * kw[8 + i]; km[i] += lo[i]; km[8 + i] += hi[i]; }
                *(v4u*)(prow + PK + 16 * lane) = pack8(lo); *(v4u*)(prow + PK + 16 * lane + 8) = pack8(hi);
            }
#pragma unroll 1
            for (int g6 = 0; g6 < 6; ++g6) {
                const int c0 = g6 * 512 + 8 * lane; float acc[8];
                { const f32x4 b0 = *(const f32x4*)(IN_CONVB(A) + c0), b1 = *(const f32x4*)(IN_CONVB(A) + c0 + 4);
#pragma unroll
                  for (int i = 0; i < 4; ++i) { acc[i] = b0[i]; acc[4 + i] = b1[i]; } }
#pragma unroll
                for (int j = 0; j < CONVK; ++j) {
                    if (pos - (CONVK - 1) + j >= 0) {
                        float xv[8]; unpk8(*(const v4u*)(WSP(A,bf16,WS_PROJ) + (size_t)(t - (CONVK - 1) + j) * NPROJ + PXBC + c0), xv);
                        const f32x4 w0 = *(const f32x4*)(IN_CONVW(A) + j * D_XBC + c0), w1 = *(const f32x4*)(IN_CONVW(A) + j * D_XBC + c0 + 4);
#pragma unroll
                        for (int i = 0; i < 4; ++i) { acc[i] += w0[i] * xv[i]; acc[4 + i] += w1[i] * xv[4 + i]; }
                    }
                }
#pragma unroll
                for (int i = 0; i < 8; ++i) acc[i] = silu_f(acc[i]);
                *(v4u*)(WSP(A,bf16,WS_XC) + (size_t)t * D_XBC + c0) = pack8(acc);
            }
            {
                float h[16]; const v2u* xr = (const v2u*)(WSP(A,bf16,WS_XN) + (size_t)t * D) + lane;
#pragma unroll
                for (int j = 0; j < 4; ++j) { const v2u w = xr[64 * j]; h[4 * j] = __uint_as_float(w.x << 16); h[4 * j + 1] = __uint_as_float(w.x & 0xffff0000u); h[4 * j + 2] = __uint_as_float(w.y << 16); h[4 * j + 3] = __uint_as_float(w.y & 0xffff0000u); }
                const float mine = rowdot32(h, WT, lane);
                if (lane < 32) { const float z = mine + IN_DTB(A)[lane]; WSP(A,float,WS_DT)[(size_t)t * 32 + lane] = fmaxf(z, 0.f) + log1pf(__expf(-fabsf(z))); }
            }
        }
        float* kmp = WSP(A,float,WS_KM) + ((size_t)(b * NH + (lane >> 2)) * NBLK + blk) * HD + 16 * (lane & 3);
#pragma unroll
        for (int i = 0; i < 16; ++i) unsafeAtomicAdd(kmp + i, km[i] * (1.f / MBLK));
    }
    __syncthreads();
}

__device__ __forceinline__ void p3_ssd(Frame& F, const Args& A) {
    LAS float* xs = (LAS float*)(F.lds + RING_OFF);
    LAS float* Bc = (LAS float*)(F.lds + RING_OFF + 16384);
    LAS float* Cc = (LAS float*)(F.lds + RING_OFF + 49152);
    LAS float* dtv = (LAS float*)(F.lds + RING_OFF + 81920);
    LAS float* yb = (LAS float*)(F.lds + RING_OFF + 82944);
    const int tid = F.tid;
    for (int unit = F.vcu; unit < BATCH * SSD_H; unit += F.G) {
        const int b = unit / SSD_H, h = unit % SSD_H, g = h / (SSD_H / NGRP);
        const float Aneg = -__expf(IN_ALOG(A)[h]), Dh = IN_DSKIP(A)[h];
        const int p = tid >> 3, ng = tid & 7;
        float st[16];
#pragma unroll
        for (int i = 0; i < 16; ++i) st[i] = 0.f;
        for (int ch = 0; ch < SEQ / 64; ++ch) {
            const int tb = b * SEQ + ch * 64;
            {
                const int r = tid >> 3, c8 = tid & 7;
                float v[8]; unpk8(*(const v4u*)(WSP(A,bf16,WS_XC) + (size_t)(tb + r) * D_XBC + h * 64 + 8 * c8), v);
#pragma unroll
                for (int i = 0; i < 8; ++i) xs[r * 64 + 8 * c8 + i] = v[i];
#pragma unroll
                for (int q = 0; q < 2; ++q) { const int idx = tid + 512 * q, rr = idx >> 4, c16 = idx & 15;
                    float bv[8], cv[8]; unpk8(*(const v4u*)(WSP(A,bf16,WS_XC) + (size_t)(tb + rr) * D_XBC + D_INNER + g * DSTATE + 8 * c16), bv); unpk8(*(const v4u*)(WSP(A,bf16,WS_XC) + (size_t)(tb + rr) * D_XBC + D_INNER + NGRP * DSTATE + g * DSTATE + 8 * c16), cv);
#pragma unroll
                    for (int i = 0; i < 8; ++i) { Bc[rr * 128 + 8 * c16 + i] = bv[i]; Cc[rr * 128 + 8 * c16 + i] = cv[i]; } }
                if (tid < 64) dtv[tid] = WSP(A,float,WS_DT)[(size_t)(tb + tid) * 32 + h];
            }
            __syncthreads();
            for (int tok = 0; tok < 64; ++tok) {
                const float dt = dtv[tok], decay = __expf(dt * Aneg), xdt = xs[tok * 64 + p] * dt;
                float yp = 0.f;
#pragma unroll
                for (int q = 0; q < 4; ++q) { const f32x4 bb = *(const LAS f32x4*)(Bc + tok * 128 + 16 * ng + 4 * q), cc = *(const LAS f32x4*)(Cc + tok * 128 + 16 * ng + 4 * q);
#pragma unroll
                    for (int i = 0; i < 4; ++i) { st[4 * q + i] = st[4 * q + i] * decay + bb[i] * xdt; yp += cc[i] * st[4 * q + i]; } }
                yp += __shfl_xor(yp, 1); yp += __shfl_xor(yp, 2); yp += __shfl_xor(yp, 4);
                if (ng == 0) yb[tok * 64 + p] = yp;
            }
            __syncthreads();
            {
                const int r = tid >> 3, c8 = tid & 7; const size_t t = (size_t)(tb + r);
                float z[8]; unpk8(*(const v4u*)(WSP(A,bf16,WS_PROJ) + t * NPROJ + PZ + h * 64 + 8 * c8), z);
                float o[8]; float ss = 0.f;
#pragma unroll
                for (int i = 0; i < 8; ++i) { const float y = yb[r * 64 + 8 * c8 + i] + Dh * xs[r * 64 + 8 * c8 + i]; o[i] = y * silu_f(z[i]); ss += o[i] * o[i]; }
                *(v4u*)(WSP(A,bf16,WS_YG) + t * D_INNER + h * 64 + 8 * c8) = pack8(o);
                ss += __shfl_xor(ss, 1); ss += __shfl_xor(ss, 2); ss += __shfl_xor(ss, 4);
                if (c8 == 0) WSP(A,float,WS_SSQ)[t * 32 + h] = ss;
            }
            __syncthreads();
        }
    }
}

__device__ __forceinline__ void p4_norm(Frame& F, const Args& A) {
    const int lane = F.lane, gw = F.vcu * NWAVES + F.wave, NGW = F.G * NWAVES;
    for (int t = gw; t < M; t += NGW) {
        bf16* row = WSP(A,bf16,WS_YG) + (size_t)t * D_INNER + 32 * lane; const int g = lane >> 4;
        float ss = 0.f;
#pragma unroll
        for (int hh = 0; hh < 8; ++hh) ss += WSP(A,float,WS_SSQ)[(size_t)t * 32 + 8 * g + hh];
        const float rs = 1.0f / sqrtf(ss * (1.f / 512.f) + NORM_EPS);
#pragma unroll
        for (int q = 0; q < 4; ++q) { float v[8]; unpk8(*(const v4u*)(row + 8 * q), v); const f32x4 w0 = *(const f32x4*)(IN_SSDNW(A) + 32 * lane + 8 * q), w1 = *(const f32x4*)(IN_SSDNW(A) + 32 * lane + 8 * q + 4);
#pragma unroll
            for (int i = 0; i < 4; ++i) { v[i] = v[i] * rs * w0[i]; v[4 + i] = v[4 + i] * rs * w1[i]; }
            *(v4u*)(row + 8 * q) = pack8(v); }
    }
}
__device__ __forceinline__ void attn_simple(Frame& F, const Args& A) {
    const int lane = F.lane, gw = F.vcu * NWAVES + F.wave, NGW = F.G * NWAVES;
    const float qwm = wave_max(fabsf(IN_QNW(A)[lane])), kwm = wave_max(fabsf(IN_KNW(A)[lane]));
    const float REF = 8.0f * qwm * kwm * 1.4426950408889634f + 0.25f;
    const bf16* QN = WSP(A,bf16,WS_PROJ) + PQ; const bf16* KN = WSP(A,bf16,WS_PROJ) + PK; const bf16* VV = WSP(A,bf16,WS_PROJ) + PV;
    for (int rep = 0; rep < REP(PH_ATTN); ++rep)
    for (long a = gw; a < (long)M * NH; a += NGW) {
        const int grp = (int)(a >> 7), within = (int)(a & 127), h = within >> 3, t = grp * 8 + (within & 7);
        const int b = t / SEQ, pos = t % SEQ, qb = pos >> 8;
        const bf16* qp = QN + (size_t)t * NPROJ + h * 64;
        float q[64];
#pragma unroll
        for (int c = 0; c < 8; ++c) { float v[8]; unpk8(*(const v4u*)(qp + 8 * c), v);
#pragma unroll
            for (int i = 0; i < 8; ++i) q[8 * c + i] = v[i]; }
        const float qd = bf2f(qp[lane]);
        float sc[7];
#pragma unroll
        for (int j = 0; j < 7; ++j) { sc[j] = -3.0e38f; if (j < qb) sc[j] = wave_sum(qd * WSP(A,float,WS_KM)[((size_t)(b * NH + h) * NBLK + j) * HD + lane]); }
        unsigned sel = 0u; const int nsel = qb < MOBA_TOPK ? qb : MOBA_TOPK;
#pragma unroll
        for (int k = 0; k < MOBA_TOPK; ++k) if (k < nsel) { float best = -3.0e38f; int bi = 0;
#pragma unroll
            for (int j = 0; j < 7; ++j) if (j < qb && !((sel >> j) & 1u) && sc[j] > best) { best = sc[j]; bi = j; }
            sel |= 1u << bi; }
        sel |= 1u << qb;
        float o = 0.f, lsum = 0.f;
        for (int j = 0; j <= qb; ++j) {
            if (!((sel >> j) & 1u)) continue;
            for (int tile = 0; tile < 4; ++tile) {
                const int kbase = j * MBLK + tile * 64; if (j == qb && kbase > pos) break;
                const int kk = kbase + lane; const bf16* kp = KN + (size_t)(b * SEQ + kk) * NPROJ + h * 64;
                float dot = 0.f;
#pragma unroll
                for (int c = 0; c < 8; ++c) { float v[8]; unpk8(*(const v4u*)(kp + 8 * c), v);
#pragma unroll
                    for (int i = 0; i < 8; ++i) dot += v[i] * q[8 * c + i]; }
                const bool valid = (j < qb) || (kk <= pos);
                const float pr = valid ? __builtin_amdgcn_exp2f(dot - REF) : 0.f; lsum += pr;
                const bf16* vp = VV + (size_t)(b * SEQ + kbase) * NPROJ + h * 64 + lane;
#pragma unroll 16
                for (int jj = 0; jj < 64; ++jj) { const float pj = __shfl(pr, jj); o += pj * bf2f(vp[(size_t)jj * NPROJ]); }
            }
        }
        const float l = wave_sum(lsum);
        WSP(A,bf16,WS_AO)[(size_t)t * D + h * 64 + lane] = (bf16)f2bf(o / l);
    }
}


typedef short bf16x8v __attribute__((ext_vector_type(8)));
typedef float f32x16 __attribute__((ext_vector_type(16)));
__device__ __forceinline__ int crow(int r, int hi) { return (r & 3) + 8 * (r >> 2) + 4 * hi; }
__device__ __forceinline__ void attn_mfma(Frame& F, const Args& A) {
    const int tid = F.tid, lane = F.lane, wave = F.wave, r32 = lane & 31, hi = lane >> 5;
    constexpr int KP = 144, VP = 136, KBS = 9216, VB0 = 18432, VBS = 8704, KMOFF = 36864;
    LAS unsigned char* L = F.lds + RING_OFF;
    LAS float* KMs = (LAS float*)(L + KMOFF);
    const float qwm = wave_max(fabsf(IN_QNW(A)[lane])), kwm = wave_max(fabsf(IN_KNW(A)[lane]));
    const float REF = 8.0f * qwm * kwm * 1.4426950408889634f + 0.25f;
    const bf16* QN = WSP(A,bf16,WS_PROJ) + PQ; const bf16* KN = WSP(A,bf16,WS_PROJ) + PK; const bf16* VV = WSP(A,bf16,WS_PROJ) + PV;
    for (int slot = F.vcu; slot < 256; slot += F.G)
    for (int ui = 0; ui < 4; ++ui) {
        const int bh = slot >> 1, sp = slot & 1, b = bh >> 4, h = bh & 15;
        const int qb = (sp == 0) ? (ui == 0 ? 0 : ui == 1 ? 7 : ui == 2 ? 1 : 6) : (ui == 0 ? 2 : ui == 1 ? 5 : ui == 2 ? 3 : 4);
        const int tq0 = b * SEQ + qb * MBLK, NT = 4 * (qb + 1);
        const bf16* kg = KN + (size_t)(b * SEQ + (tid >> 3)) * NPROJ + h * 64 + 8 * (tid & 7);
        const bf16* vg = VV + (size_t)(b * SEQ + 2 * (tid >> 4)) * NPROJ + h * 64 + 4 * (tid & 15);
        v4u kreg; v2u vr0, vr1;
#define AT_LOAD(tt) do { kreg = *(const v4u*)(kg + (size_t)(tt) * 64 * NPROJ); vr0 = *(const v2u*)(vg + (size_t)(tt) * 64 * NPROJ); vr1 = *(const v2u*)(vg + (size_t)(tt) * 64 * NPROJ + NPROJ); } while (0)
#define AT_STORE(bufi) do { *(LAS v4u*)(L + (bufi) * KBS + (tid >> 3) * KP + (tid & 7) * 16) = kreg; \
            LAS unsigned char* vb_ = L + VB0 + (bufi) * VBS + (4 * (tid & 15)) * VP + (tid >> 4) * 4; \
            *(LAS unsigned*)(vb_) = (vr0.x & 0xffffu) | (vr1.x << 16); *(LAS unsigned*)(vb_ + VP) = (vr0.x >> 16) | (vr1.x & 0xffff0000u); \
            *(LAS unsigned*)(vb_ + 2 * VP) = (vr0.y & 0xffffu) | (vr1.y << 16); *(LAS unsigned*)(vb_ + 3 * VP) = (vr0.y >> 16) | (vr1.y & 0xffff0000u); } while (0)
        if (tid < 448) { const int j = tid >> 6; if (j < qb) KMs[tid] = WSP(A,float,WS_KM)[((size_t)(b * NH + h) * NBLK + j) * HD + (tid & 63)]; }
        AT_LOAD(0); AT_STORE(0);
        const bf16* qp = QN + (size_t)(tq0 + wave * 32 + r32) * NPROJ + h * 64;
        bf16x8v qr[4];
#pragma unroll
        for (int ds = 0; ds < 4; ++ds) qr[ds] = *(const bf16x8v*)(qp + 16 * ds + 8 * hi);
        __syncthreads();
        float sc[7];
#pragma unroll
        for (int j = 0; j < 7; ++j) { sc[j] = -3.0e38f;
            if (j < qb) { float s = 0.f;
#pragma unroll
                for (int ds = 0; ds < 4; ++ds) { float qv[8]; unpk8(__builtin_bit_cast(v4u, qr[ds]), qv);
                    const f32x4 k0 = *(const LAS f32x4*)(KMs + j * 64 + 16 * ds + 8 * hi), k1 = *(const LAS f32x4*)(KMs + j * 64 + 16 * ds + 8 * hi + 4);
                    s += (qv[0] * k0.x + qv[1] * k0.y) + (qv[2] * k0.z + qv[3] * k0.w) + (qv[4] * k1.x + qv[5] * k1.y) + (qv[6] * k1.z + qv[7] * k1.w); }
                s += __shfl_xor(s, 32); sc[j] = s; } }
        unsigned sel = 0u; const int nsel = qb < MOBA_TOPK ? qb : MOBA_TOPK;
#pragma unroll
        for (int k = 0; k < MOBA_TOPK; ++k) if (k < nsel) { float best = -3.0e38f; int bi = 0;
#pragma unroll
            for (int j = 0; j < 7; ++j) if (j < qb && !((sel >> j) & 1u) && sc[j] > best) { best = sc[j]; bi = j; }
            sel |= 1u << bi; }
        f32x16 o0 = {}, o1 = {}; float lsum = 0.f;
        const int qi = wave * 32 + r32;
        for (int tt = 0; tt < NT; ++tt) {
            const int cur = tt & 1;
            if (tt + 1 < NT) AT_LOAD(tt + 1);
            const int j = tt >> 2, tile = tt & 3; const bool own = (j == qb);
            if (!(own && tile * 64 > wave * 32 + 31)) {
                const LAS unsigned char* Kb = L + cur * KBS; const LAS unsigned char* Vb = L + VB0 + cur * VBS;
                f32x16 p0 = {}, p1 = {};
#pragma unroll
                for (int ds = 0; ds < 4; ++ds) {
                    const bf16x8v k0 = *(const LAS bf16x8v*)(Kb + r32 * KP + ds * 32 + hi * 16), k1 = *(const LAS bf16x8v*)(Kb + (32 + r32) * KP + ds * 32 + hi * 16);
                    p0 = __builtin_amdgcn_mfma_f32_32x32x16_bf16(k0, qr[ds], p0, 0, 0, 0); p1 = __builtin_amdgcn_mfma_f32_32x32x16_bf16(k1, qr[ds], p1, 0, 0, 0); }
                const bool selbit = ((sel >> j) & 1u) != 0u;
#pragma unroll
                for (int r = 0; r < 16; ++r) { const int kv0 = tile * 64 + crow(r, hi);
                    const bool v0 = own ? (kv0 <= qi) : selbit, v1 = own ? (kv0 + 32 <= qi) : selbit;
                    p0[r] = v0 ? __builtin_amdgcn_exp2f(p0[r] - REF) : 0.f; p1[r] = v1 ? __builtin_amdgcn_exp2f(p1[r] - REF) : 0.f; lsum += p0[r] + p1[r]; }
                v4u pf[4];
#pragma unroll
                for (int q = 0; q < 4; ++q) { pf[0][q] = pk2(p0[2 * q], p0[2 * q + 1]); pf[1][q] = pk2(p0[8 + 2 * q], p0[8 + 2 * q + 1]); pf[2][q] = pk2(p1[2 * q], p1[2 * q + 1]); pf[3][q] = pk2(p1[8 + 2 * q], p1[8 + 2 * q + 1]); }
#pragma unroll
                for (int ks = 0; ks < 4; ++ks) {
                    const bf16x8v pb = __builtin_bit_cast(bf16x8v, pf[ks]);
                    { const v2u a0 = *(const LAS v2u*)(Vb + r32 * VP + (16 * ks + 4 * hi) * 2), a1 = *(const LAS v2u*)(Vb + r32 * VP + (16 * ks + 8 + 4 * hi) * 2);
                      v4u av; av.x = a0.x; av.y = a0.y; av.z = a1.x; av.w = a1.y; o0 = __builtin_amdgcn_mfma_f32_32x32x16_bf16(__builtin_bit_cast(bf16x8v, av), pb, o0, 0, 0, 0); }
                    { const v2u a0 = *(const LAS v2u*)(Vb + (32 + r32) * VP + (16 * ks + 4 * hi) * 2), a1 = *(const LAS v2u*)(Vb + (32 + r32) * VP + (16 * ks + 8 + 4 * hi) * 2);
                      v4u av; av.x = a0.x; av.y = a0.y; av.z = a1.x; av.w = a1.y; o1 = __builtin_amdgcn_mfma_f32_32x32x16_bf16(__builtin_bit_cast(bf16x8v, av), pb, o1, 0, 0, 0); }
                }
            }
            if (tt + 1 < NT) AT_STORE(cur ^ 1);
            __syncthreads();
        }
#undef AT_LOAD
#undef AT_STORE
        const float l = lsum + __shfl_xor(lsum, 32), inv = 1.0f / l;
        bf16* op = WSP(A,bf16,WS_AO) + (size_t)(tq0 + qi) * D + h * 64 + 4 * hi;
#pragma unroll
        for (int g4 = 0; g4 < 4; ++g4) { v2u w0, w1; w0.x = pk2(o0[4 * g4] * inv, o0[4 * g4 + 1] * inv); w0.y = pk2(o0[4 * g4 + 2] * inv, o0[4 * g4 + 3] * inv);
            w1.x = pk2(o1[4 * g4] * inv, o1[4 * g4 + 1] * inv); w1.y = pk2(o1[4 * g4 + 2] * inv, o1[4 * g4 + 3] * inv);
            *(v2u*)(op + 8 * g4) = w0; *(v2u*)(op + 32 + 8 * g4) = w1; }
    }
    __syncthreads();
}
__device__ __forceinline__ void p7_route(Frame& F, const Args& A) {
    stage_wt(F, WSP(A,float,WS_WRT));
    const LAS float* WT = (const LAS float*)(F.lds + RING_OFF);
    const int lane = F.lane, gw = F.vcu * NWAVES + F.wave, NGW = F.G * NWAVES;
    for (int t = gw; t < M; t += NGW) {
        const f32x4* xr = (const f32x4*)((A).out + (size_t)t * D) + lane; const f32x4* wr = (const f32x4*)IN_LN2W(A) + lane;
        f32x4 v[4]; float s = 0.f;
#pragma unroll
        for (int j = 0; j < 4; ++j) { v[j] = xr[64 * j]; s += (v[j].x * v[j].x + v[j].y * v[j].y) + (v[j].z * v[j].z + v[j].w * v[j].w); }
        const float rs = 1.0f / sqrtf(wave_sum(s) * (1.f / D) + NORM_EPS);
        float h[16]; v2u* o8 = (v2u*)(WSP(A,bf16,WS_H2) + (size_t)t * D) + lane;
#pragma unroll
        for (int j = 0; j < 4; ++j) { const f32x4 w = wr[64 * j]; h[4 * j] = v[j].x * rs * w.x; h[4 * j + 1] = v[j].y * rs * w.y; h[4 * j + 2] = v[j].z * rs * w.z; h[4 * j + 3] = v[j].w * rs * w.w;
            v2u o; o.x = pk2(h[4 * j], h[4 * j + 1]); o.y = pk2(h[4 * j + 2], h[4 * j + 3]); o8[64 * j] = o; }
        float val = rowdot32(h, WT, lane); val = (lane < 32) ? val + IN_BR(A)[lane & 31] : -3.0e38f;
        float tv[4]; int ti[4];
#pragma unroll
        for (int k = 0; k < 4; ++k) { const float mx = wave_max(val); const unsigned long long bm = __ballot(val == mx); const int idx = __builtin_ctzll(bm);
            tv[k] = mx; ti[k] = idx; if (lane == idx) val = -3.0e38f; }
        float ex[4], es = 0.f;
#pragma unroll
        for (int k = 0; k < 4; ++k) { ex[k] = __expf(tv[k] - tv[0]); es += ex[k]; }
        if (lane == 0) {
#pragma unroll
            for (int k = 0; k < 4; ++k) { const unsigned j = __hip_atomic_fetch_add((WSP(A,unsigned,WS_CTL) + CW_CNT) + ti[k], 1u, RLX_AGENT); WSP(A,int,WS_TOKL)[ti[k] * EXPCAP + (int)j] = t * 4 + k; WSP(A,float,WS_GATEW)[t * 4 + k] = ex[k] / es; }
        }
    }
    __syncthreads();
}

__device__ __forceinline__ int moe_tables(Frame& F, const Args& A) {
    LAS int* tile_e = (LAS int*)(F.lds + TILEE_OFF); LAS int* rowb = (LAS int*)(F.lds + ROWB_OFF); LAS int* cntl = (LAS int*)(F.lds + CNTL_OFF);
    if (F.tid == 0) { int acc = 0, rt = 0;
        for (int e = 0; e < NEXP; ++e) { int c = (int)__hip_atomic_load((WSP(A,unsigned,WS_CTL) + CW_CNT) + e, RLX_AGENT); if (c > EXPCAP) c = EXPCAP; cntl[e] = c; rowb[e] = acc; const int n = (c + 255) >> 8; for (int i = 0; i < n; ++i) tile_e[rt++] = e; acc += n * 256; }
        rowb[NEXP] = acc; }
    __syncthreads();
    return rowb[NEXP] >> 8;
}
__device__ __forceinline__ void p8_gather(Frame& F, const Args& A) {
    const int NT = moe_tables(F, A);
    const LAS int* rowb = (const LAS int*)(F.lds + ROWB_OFF); const LAS int* cntl = (const LAS int*)(F.lds + CNTL_OFF);
    const int lane = F.lane, gw = F.vcu * NWAVES + F.wave, NGW = F.G * NWAVES, total = NT * 256;
    for (int r = gw; r < total; r += NGW) {
        int e = 0;
#pragma unroll
        for (int q = 1; q < NEXP; ++q) e += (rowb[q] <= r) ? 1 : 0;
        const int j = r - rowb[e];
        if (j < cntl[e]) { const int a = WSP(A,int,WS_TOKL)[e * EXPCAP + j], t = a >> 2;
            const v4u x0 = *(const v4u*)(WSP(A,bf16,WS_H2) + (size_t)t * D + 16 * lane), x1 = *(const v4u*)(WSP(A,bf16,WS_H2) + (size_t)t * D + 16 * lane + 8);
            *(v4u*)(WSP(A,bf16,WS_XG) + (size_t)r * D + 16 * lane) = x0; *(v4u*)(WSP(A,bf16,WS_XG) + (size_t)r * D + 16 * lane + 8) = x1;
            if (lane == 0) { WSP(A,float,WS_ROWW)[r] = WSP(A,float,WS_GATEW)[a]; WSP(A,int,WS_POS)[a] = r; } }
        else if (lane == 0) WSP(A,float,WS_ROWW)[r] = 0.f;
    }
    __syncthreads();
}
__device__ __forceinline__ void p11_combine(Frame& F, const Args& A) {
    const int lane = F.lane, gw = F.vcu * NWAVES + F.wave, NGW = F.G * NWAVES;
    for (int t = gw; t < M; t += NGW) {
        f32x4* xr = (f32x4*)((A).out + (size_t)t * D) + lane; f32x4 v[4];
#pragma unroll
        for (int j = 0; j < 4; ++j) v[j] = xr[64 * j];
#pragma unroll
        for (int k = 0; k < 4; ++k) { const int r = WSP(A,int,WS_POS)[t * 4 + k]; const v2u* yr = (const v2u*)(WSP(A,bf16,WS_Y) + (size_t)r * D) + lane;
#pragma unroll
            for (int j = 0; j < 4; ++j) { const v2u w = yr[64 * j]; v[j].x += __uint_as_float(w.x << 16); v[j].y += __uint_as_float(w.x & 0xffff0000u); v[j].z += __uint_as_float(w.y << 16); v[j].w += __uint_as_float(w.y & 0xffff0000u); } }
#pragma unroll
        for (int j = 0; j < 4; ++j) xr[64 * j] = v[j];
    }
}
__global__ void __launch_bounds__(NWAVES * 64, 2) mk_fwd(Args args) {
    extern __shared__ __attribute__((aligned(16))) unsigned char lds[];
    Frame F;
    F.lds = (LAS unsigned char*)lds;
    F.MISC = (volatile LAS unsigned*)(F.lds + MISC_OFF);
    F.tid = threadIdx.x; F.lane = F.tid & 63; F.wave = __builtin_amdgcn_readfirstlane(F.tid >> 6);
    F.G = gridDim.x; { const int bx = blockIdx.x; F.vcu = (F.G % 8 == 0) ? (bx % 8) * (F.G / 8) + bx / 8 : bx; }
    const Args& A = args;
    F.ctl = (gu32*)(args.ws + WS_CTL);
    for (int u = F.tid; u < (LDS_BYTES - LDSCTL_OFF) / 4; u += NWAVES * 64) ((LAS unsigned*)(F.lds + LDSCTL_OFF))[u] = 0u;
    __syncthreads();
    XcdBarrier bar; bar.bar = (unsigned*)(F.ctl + CW_BAR); bar.x = 0; bar.st = nullptr;
    if (!MK_PER_PHASE) bar = xcd_barrier_post((unsigned*)(F.ctl + CW_BAR), F.MISC + 8);
    const int lo = args.ph_lo, hi = args.ph_hi;
#ifndef PH_MASK
#define PH_MASK 0xFFF
#endif
#define IN(k) ((((PH_MASK) >> (k)) & 1) && lo <= (k) && (k) < hi)
#define SEAM(k) do { if (!MK_PER_PHASE && IN(k) && IN((k) + 1)) xcd_barrier(bar); } while (0)

    if (IN(PH_PRO)) { for (int rep = 0; rep < (1 + (((REP_MASK) >> PH_PRO) & 1)); ++rep) p0_prologue(F, A); SEAM(PH_PRO); }
    if (IN(PH_INPROJ)) {
        pg8::Gemm g{WSP(A,bf16,WS_XN), WSP(A,bf16,WS_WIN), M, NPROJ, D}; pg8::StaticOrder S; S.init(M, NPROJ, F.G, (int)blockIdx.x);
        pg8::EpiPlain E{WSP(A,bf16,WS_PROJ), NPROJ};
        pg8::gemm_phase<pg8::EpiPlain, pg8::StaticOrder, true, true>(F.lds + RING_OFF, g, S, E);
        SEAM(PH_INPROJ);
    }
    if (IN(PH_PREP)) { p2_prep(F, A); SEAM(PH_PREP); }
    if (IN(PH_SSD)) { for (int rep = 0; rep < REP(PH_SSD); ++rep) p3_ssd(F, A); SEAM(PH_SSD); }
    if (IN(PH_ATTN)) { p4_norm(F, A);
#if ATTN_SIMPLE
        attn_simple(F, A);
#else
        for (int rep = 0; rep < REP(PH_ATTN); ++rep) attn_mfma(F, A);
#endif
        SEAM(PH_ATTN); }
    if (IN(PH_OPROJ)) {
        { pg8::Gemm g{WSP(A,bf16,WS_AO), WSP(A,bf16,WS_WOA), M, D, D}; pg8::StaticOrder S; S.init(M, D, F.G, (int)blockIdx.x);
          pg8::EpiGate1 E{WSP(A,bf16,WS_PROJ) + PGATE, NPROJ, IN_GATEB(A), WSP(A,float,WS_MIXF)};
          pg8::gemm_phase<pg8::EpiGate1, pg8::StaticOrder, true, true>(F.lds + RING_OFF, g, S, E); }
        { pg8::Gemm g{WSP(A,bf16,WS_YG), WSP(A,bf16,WS_WOS), M, D, D_INNER}; pg8::StaticOrder S; S.init(M, D, F.G, (int)blockIdx.x);
          pg8::EpiGate2 E{WSP(A,bf16,WS_PROJ) + PGATE + D, NPROJ, IN_GATEB(A) + D, WSP(A,float,WS_MIXF), WSP(A,bf16,WS_MIX)};
          pg8::gemm_phase<pg8::EpiGate2, pg8::StaticOrder, true, true>(F.lds + RING_OFF, g, S, E); }
        SEAM(PH_OPROJ);
    }
    if (IN(PH_WOUT)) {
        pg8::Gemm g{WSP(A,bf16,WS_MIX), WSP(A,bf16,WS_WOUT), M, D, D}; pg8::StaticOrder S; S.init(M, D, F.G, (int)blockIdx.x);
        pg8::EpiResid E{IN_X(A), (A).out};
        pg8::gemm_phase<pg8::EpiResid, pg8::StaticOrder, true, true>(F.lds + RING_OFF, g, S, E);
        SEAM(PH_WOUT);
    }
    if (IN(PH_ROUTE)) { p7_route(F, A); SEAM(PH_ROUTE); }
    if (IN(PH_GATHER)) { p8_gather(F, A); SEAM(PH_GATHER); }
    if (IN(PH_GU)) {
        const int NT = moe_tables(F, A);
        pg8::Gemm g{WSP(A,bf16,WS_XG), WSP(A,bf16,WS_WGU), NT * 256, 2048, D}; pg8::GroupedOrder S{8, NT, F.G, (int)blockIdx.x, (const LAS int*)(F.lds + TILEE_OFF)};
        pg8::EpiSwiglu E{WSP(A,bf16,WS_ACT), IN_BGU(A)};
        pg8::gemm_phase<pg8::EpiSwiglu, pg8::GroupedOrder, true, true>(F.lds + RING_OFF, g, S, E);
        SEAM(PH_GU);
    }
    if (IN(PH_DOWN)) {
        const int NT = moe_tables(F, A);
        pg8::Gemm g{WSP(A,bf16,WS_ACT), WSP(A,bf16,WS_WDN), NT * 256, 1024, D}; pg8::GroupedOrder S{4, NT, F.G, (int)blockIdx.x, (const LAS int*)(F.lds + TILEE_OFF)};
        pg8::EpiDown E{WSP(A,bf16,WS_Y), IN_BDN(A), WSP(A,float,WS_ROWW)};
        pg8::gemm_phase<pg8::EpiDown, pg8::GroupedOrder, true, true>(F.lds + RING_OFF, g, S, E);
        SEAM(PH_DOWN);
    }
    if (IN(PH_COMB)) { p11_combine(F, A); }
#undef IN
#undef SEAM
}

extern "C" void kernel_launch(void* const* d_in, const int* in_sizes, int n_in, void* d_out, int out_size, void* d_ws, size_t ws_size, hipStream_t stream) {
    static int grid = 0;
    if (grid == 0) {
        if (n_in != 22 || in_sizes[0] != M * D || out_size != M * D || ws_size < WS_END) { fprintf(stderr, "kernel_launch: unexpected shapes / workspace (n_in %d, in0 %d, out %d, ws %zu, need %zu); nothing launched\n", n_in, n_in > 0 ? in_sizes[0] : -1, out_size, ws_size, (size_t)WS_END); grid = -1; return; }
        int dev = 0, cus = 0, per_cu = 0;
        if (hipGetDevice(&dev) != hipSuccess || hipDeviceGetAttribute(&cus, hipDeviceAttributeMultiprocessorCount, dev) != hipSuccess) { fprintf(stderr, "kernel_launch: device query failed\n"); grid = -1; return; }
        if (hipFuncSetAttribute((const void*)mk_fwd, hipFuncAttributeMaxDynamicSharedMemorySize, LDS_BYTES) != hipSuccess) { fprintf(stderr, "kernel_launch: hipFuncSetAttribute failed\n"); grid = -1; return; }
        if (hipOccupancyMaxActiveBlocksPerMultiprocessor(&per_cu, (const void*)mk_fwd, NWAVES * 64, LDS_BYTES) != hipSuccess || per_cu < 1) fprintf(stderr, "kernel_launch: note: occupancy query reports %d blocks per CU\n", per_cu);
        (void)hipGetLastError();
        grid = cus;
    }
    if (grid < 0) return;
    if (hipMemsetAsync((char*)d_ws + WS_CTL, 0, CTL_ZERO_BYTES, stream) != hipSuccess) { fprintf(stderr, "kernel_launch: memset failed\n"); return; }
    Args a{};
    for (int i = 0; i < 22; ++i) a.in[i] = (const float*)d_in[i];
    a.out = (float*)d_out; a.ws = (unsigned char*)d_ws;
#if MK_PER_PHASE
    for (int p = 0; p < N_PHASES; ++p) { a.ph_lo = p; a.ph_hi = p + 1; hipLaunchKernelGGL(mk_fwd, dim3(grid), dim3(NWAVES * 64), LDS_BYTES, stream, a); }
#else
    a.ph_lo = 0; a.ph_hi = N_PHASES;
    hipLaunchKernelGGL(mk_fwd, dim3(grid), dim3(NWAVES * 64), LDS_BYTES, stream, a);
#endif
    const hipError_t le = hipPeekAtLastError();
    if (le != hipSuccess) fprintf(stderr, "kernel_launch: launch failed: %s\n", hipGetErrorName(le));
}
```

```cpp
#include <hip/hip_runtime.h>
#include <cstdio>
#include <cstdint>
namespace pg8 {
#define PG8_LAS __attribute__((address_space(3)))
typedef unsigned short bf16_t;
typedef short bf16x8 __attribute__((ext_vector_type(8)));
typedef float f32x4 __attribute__((ext_vector_type(4)));
typedef unsigned u32x4 __attribute__((ext_vector_type(4)));
constexpr int BM = 256, BK = 64, HALF = 128, HTB = HALF * BK * 2  , STAGE_BYTES = 8 * HTB, NXCD = 8, WGM = 8;

__host__ __device__ __forceinline__ int lds_byte(int r, int c) { const int st = (r >> 4) * 2 + (c >> 5), rr = r & 15, cc = c & 31, ob = rr * 64 + cc * 2; return st * 1024 + (ob ^ (((ob >> 9) & 1) << 5)); }
__host__ __device__ __forceinline__ void stage_rc(int b, int& R, int& C) { const int st = b / 1024, sb = b % 1024, swz = sb ^ (((sb >> 9) & 1) << 5); R = (st >> 1) * 16 + swz / 64; C = (st & 1) * 32 + (swz % 64) / 2; }
__host__ __device__ __forceinline__ int perm32(int rho) { const int n = rho >> 4, i = rho & 15; return 8 * (i >> 2) + 4 * n + (i & 3); }

struct Unit { int pm, pn; };
struct Gemm { const bf16_t* A; const bf16_t* Bt; int M, N, K; };

struct StaticOrder {
    int nM, nN, nwg, G, c;
    __host__ __device__ void init(int M, int N, int G_, int c_) { nM = M / BM; nN = N / BM; nwg = nM * nN; G = G_; c = c_; }
    __host__ __device__ bool next(int i, Unit& u) const {
        const long L = (long)i * G + c; if (L >= nwg) return false;
        int wgid = (int)L; { const int q = nwg / NXCD, r = nwg % NXCD, xcd = wgid % NXCD, off = wgid / NXCD; wgid = (xcd < r ? xcd * (q + 1) : r * (q + 1) + (xcd - r) * q) + off; }
        const int nig = WGM * nN, gid = wgid / nig, fm = gid * WGM, gsz = (nM - fm) < WGM ? (nM - fm) : WGM;
        u.pm = fm + ((wgid % nig) % gsz); u.pn = (wgid % nig) / gsz; return true;
    }
    __device__ __forceinline__ void a_ready(const Unit&) const {}
    __device__ __forceinline__ void done(const Unit&) const {}
};

struct GroupedOrder {
    int nN, NT, G, c; const PG8_LAS int* tile_e;
    __device__ __forceinline__ bool next(int i, Unit& u) const {
        const long L = (long)i * G + c; const int nwg = NT * nN; if (L >= nwg) return false;
        int wgid = (int)L; { const int q = nwg / NXCD, r = nwg % NXCD, xcd = wgid % NXCD, off = wgid / NXCD; wgid = (xcd < r ? xcd * (q + 1) : r * (q + 1) + (xcd - r) * q) + off; }
        const int rt = wgid / nN, pl = wgid % nN;
        u.pm = rt; u.pn = tile_e[rt] * nN + pl; return true;
    }
    __device__ __forceinline__ void a_ready(const Unit&) const {}
    __device__ __forceinline__ void done(const Unit&) const {}
};

__device__ __forceinline__ unsigned cvt_pk_bf16(float lo, float hi) { unsigned r; asm volatile("v_cvt_pk_bf16_f32 %0, %1, %2" : "=v"(r) : "v"(lo), "v"(hi)); return r; }
__device__ __forceinline__ float sigm(float x) { return __builtin_amdgcn_rcpf(1.f + __builtin_amdgcn_exp2f(-1.44269504f * x)); }
__device__ __forceinline__ void unpack8(const u32x4 w, float (&f)[8]) {
#pragma unroll
    for (int i = 0; i < 4; ++i) { f[2 * i] = __uint_as_float(w[i] << 16); f[2 * i + 1] = __uint_as_float(w[i] & 0xffff0000u); }
}
struct EpiPlain {
    static constexpr bool PERM = true, AFTER_DRAIN = false; bf16_t* O; int ldc;
    __device__ __forceinline__ void operator()(const f32x4 (&acc)[2][2][4][2], const Unit& u, int wr, int wc, int fr, int fq) const {
        const int row0 = u.pm * BM + wr * 64 + fr, col0 = u.pn * BM + wc * 32 + 8 * fq;
#pragma unroll
        for (int ai = 0; ai < 2; ++ai)
#pragma unroll
            for (int m = 0; m < 4; ++m) { bf16_t* rowp = O + (size_t)(row0 + ai * HALF + m * 16) * ldc + col0;
#pragma unroll
                for (int bj = 0; bj < 2; ++bj) { const f32x4 v0 = acc[ai][bj][m][0], v1 = acc[ai][bj][m][1]; u32x4 w;
                    w.x = cvt_pk_bf16(v0[0], v0[1]); w.y = cvt_pk_bf16(v0[2], v0[3]); w.z = cvt_pk_bf16(v1[0], v1[1]); w.w = cvt_pk_bf16(v1[2], v1[3]);
                    *(u32x4*)(rowp + bj * HALF) = w; } }
    }
};
struct EpiGate1 {
    static constexpr bool PERM = true, AFTER_DRAIN = false; const bf16_t* Gp; int ldg; const float* gb; float* MIXF;
    __device__ __forceinline__ void operator()(const f32x4 (&acc)[2][2][4][2], const Unit& u, int wr, int wc, int fr, int fq) const {
        const int row0 = u.pm * BM + wr * 64 + fr, col0 = u.pn * BM + wc * 32 + 8 * fq;
#pragma unroll
        for (int ai = 0; ai < 2; ++ai)
#pragma unroll
            for (int m = 0; m < 4; ++m) { const size_t row = (size_t)(row0 + ai * HALF + m * 16);
#pragma unroll
                for (int bj = 0; bj < 2; ++bj) { const int c = col0 + bj * HALF; float g[8]; unpack8(*(const u32x4*)(Gp + row * ldg + c), g);
                    const f32x4 b0 = *(const f32x4*)(gb + c), b1 = *(const f32x4*)(gb + c + 4); const f32x4 v0 = acc[ai][bj][m][0], v1 = acc[ai][bj][m][1]; f32x4 o0, o1;
#pragma unroll
                    for (int i = 0; i < 4; ++i) { o0[i] = sigm(g[i] + b0[i]) * v0[i]; o1[i] = sigm(g[4 + i] + b1[i]) * v1[i]; }
                    *(f32x4*)(MIXF + row * 1024 + c) = o0; *(f32x4*)(MIXF + row * 1024 + c + 4) = o1; } }
    }
};
struct EpiGate2 {
    static constexpr bool PERM = true, AFTER_DRAIN = false; const bf16_t* Gp; int ldg; const float* gb; const float* MIXF; bf16_t* MIX;
    __device__ __forceinline__ void operator()(const f32x4 (&acc)[2][2][4][2], const Unit& u, int wr, int wc, int fr, int fq) const {
        const int row0 = u.pm * BM + wr * 64 + fr, col0 = u.pn * BM + wc * 32 + 8 * fq;
#pragma unroll
        for (int ai = 0; ai < 2; ++ai)
#pragma unroll
            for (int m = 0; m < 4; ++m) { const size_t row = (size_t)(row0 + ai * HALF + m * 16);
#pragma unroll
                for (int bj = 0; bj < 2; ++bj) { const int c = col0 + bj * HALF; float g[8]; unpack8(*(const u32x4*)(Gp + row * ldg + c), g);
                    const f32x4 b0 = *(const f32x4*)(gb + c), b1 = *(const f32x4*)(gb + c + 4); const f32x4 v0 = acc[ai][bj][m][0], v1 = acc[ai][bj][m][1];
                    const f32x4 p0 = *(const f32x4*)(MIXF + row * 1024 + c), p1 = *(const f32x4*)(MIXF + row * 1024 + c + 4); f32x4 o0, o1;
#pragma unroll
                    for (int i = 0; i < 4; ++i) { o0[i] = p0[i] + sigm(g[i] + b0[i]) * v0[i]; o1[i] = p1[i] + sigm(g[4 + i] + b1[i]) * v1[i]; }
                    u32x4 w; w.x = cvt_pk_bf16(o0[0], o0[1]); w.y = cvt_pk_bf16(o0[2], o0[3]); w.z = cvt_pk_bf16(o1[0], o1[1]); w.w = cvt_pk_bf16(o1[2], o1[3]);
                    *(u32x4*)(MIX + row * 1024 + c) = w; } }
    }
};
struct EpiResid {
    static constexpr bool PERM = true, AFTER_DRAIN = false; const float* base; float* out;
    __device__ __forceinline__ void operator()(const f32x4 (&acc)[2][2][4][2], const Unit& u, int wr, int wc, int fr, int fq) const {
        const int row0 = u.pm * BM + wr * 64 + fr, col0 = u.pn * BM + wc * 32 + 8 * fq;
#pragma unroll
        for (int ai = 0; ai < 2; ++ai)
#pragma unroll
            for (int m = 0; m < 4; ++m) { const size_t row = (size_t)(row0 + ai * HALF + m * 16);
#pragma unroll
                for (int bj = 0; bj < 2; ++bj) { const size_t o = row * 1024 + col0 + bj * HALF;
                    const f32x4 p0 = *(const f32x4*)(base + o), p1 = *(const f32x4*)(base + o + 4);
                    *(f32x4*)(out + o) = p0 + acc[ai][bj][m][0]; *(f32x4*)(out + o + 4) = p1 + acc[ai][bj][m][1]; } }
    }
};
struct EpiSwiglu {
    static constexpr bool PERM = true, AFTER_DRAIN = false; bf16_t* ACT; const float* bgu;
    __device__ __forceinline__ void operator()(const f32x4 (&acc)[2][2][4][2], const Unit& u, int wr, int wc, int fr, int fq) const {
        const int e = u.pn >> 3, pl = u.pn & 7, j0 = 128 * pl + wc * 32 + 8 * fq; const int row0 = u.pm * BM + wr * 64 + fr;
        float bg[8], bu[8];
        { const float* bs = bgu + (size_t)e * 2048 + 2 * j0;
#pragma unroll
          for (int q = 0; q < 4; ++q) { const f32x4 t = *(const f32x4*)(bs + 4 * q); bg[2 * q] = t[0]; bu[2 * q] = t[1]; bg[2 * q + 1] = t[2]; bu[2 * q + 1] = t[3]; } }
#pragma unroll
        for (int ai = 0; ai < 2; ++ai)
#pragma unroll
            for (int m = 0; m < 4; ++m) { const size_t row = (size_t)(row0 + ai * HALF + m * 16); float a[8];
#pragma unroll
                for (int i = 0; i < 8; ++i) { const float gr = (i < 4 ? acc[ai][0][m][0][i & 3] : acc[ai][0][m][1][i & 3]) + bg[i], ur = (i < 4 ? acc[ai][1][m][0][i & 3] : acc[ai][1][m][1][i & 3]) + bu[i];
                    const float g = fminf(gr, 7.0f), uu = fminf(fmaxf(ur, -7.0f), 7.0f); a[i] = (uu + 1.0f) * (g * sigm(1.702f * g)); }
                u32x4 w; w.x = cvt_pk_bf16(a[0], a[1]); w.y = cvt_pk_bf16(a[2], a[3]); w.z = cvt_pk_bf16(a[4], a[5]); w.w = cvt_pk_bf16(a[6], a[7]);
                *(u32x4*)(ACT + row * 1024 + j0) = w; }
    }
};
struct EpiDown {
    static constexpr bool PERM = true, AFTER_DRAIN = false; bf16_t* Y; const float* bd; const float* roww;
    __device__ __forceinline__ void operator()(const f32x4 (&acc)[2][2][4][2], const Unit& u, int wr, int wc, int fr, int fq) const {
        const int e = u.pn >> 2, pl = u.pn & 3, col0 = pl * BM + wc * 32 + 8 * fq; const int row0 = u.pm * BM + wr * 64 + fr;
#pragma unroll
        for (int ai = 0; ai < 2; ++ai)
#pragma unroll
            for (int m = 0; m < 4; ++m) { const size_t row = (size_t)(row0 + ai * HALF + m * 16); const float rw = roww[row];
#pragma unroll
                for (int bj = 0; bj < 2; ++bj) { const int c = col0 + bj * HALF; const f32x4 b0 = *(const f32x4*)(bd + (size_t)e * 1024 + c), b1 = *(const f32x4*)(bd + (size_t)e * 1024 + c + 4);
                    const f32x4 v0 = (acc[ai][bj][m][0] + b0) * rw, v1 = (acc[ai][bj][m][1] + b1) * rw; u32x4 w;
                    w.x = cvt_pk_bf16(v0[0], v0[1]); w.y = cvt_pk_bf16(v0[2], v0[3]); w.z = cvt_pk_bf16(v1[0], v1[1]); w.w = cvt_pk_bf16(v1[2], v1[3]);
                    *(u32x4*)(Y + row * 1024 + c) = w; } }
    }
};
template <class Epi, class Sched, bool ALIGN_EPI = false, bool SP2 = false>
__device__ __forceinline__ void gemm_phase(PG8_LAS unsigned char* lds, const Gemm g, const Sched& S, const Epi& E) {
    const int tid = threadIdx.x, wid = __builtin_amdgcn_readfirstlane(tid >> 6), lane = tid & 63, wr = wid >> 2, wc = wid & 3, fr = lane & 15, fq = lane >> 4;
    const int K = g.K, nt = K / BK;
    unsigned voffA[2], voffB[2];
#pragma unroll
    for (int i = 0; i < 2; ++i) { int R, C; stage_rc(tid * 16 + i * 8192, R, C); const int Rb = Epi::PERM ? ((R & ~31) + perm32(R & 31)) : R;
        voffA[i] = (unsigned)(R * K + C) * 2u; voffB[i] = (unsigned)(Rb * K + C) * 2u; }
    const size_t kstep = (size_t)(BK * 2);
    const size_t hstep = (size_t)HALF * K * 2;
    const size_t tstep = 2 * hstep;
    const unsigned ldsw = (unsigned)wid * 1024u;
    const int aoff = lds_byte(wr * 64 + fr, fq * 8), boff = lds_byte(wc * 32 + fr, fq * 8);
#define PG8_SA(b, h) (((b) * 2 + (h)) * HTB)
#define PG8_SB(b, h) ((4 + (b) * 2 + (h)) * HTB)
#define PG8_STAGE(bufoff, gbase, voff) do { _Pragma("unroll") for (int _i = 0; _i < 2; ++_i) \
        __builtin_amdgcn_global_load_lds((const unsigned*)((const char*)(gbase) + (voff)[_i]), (PG8_LAS unsigned*)(lds + (bufoff) + ldsw + _i * 8192), 16, 0, 0); } while (0)
#define PG8_LDA(dst, b, h) do { _Pragma("unroll") for (int m = 0; m < 4; ++m) _Pragma("unroll") for (int k = 0; k < 2; ++k) dst[m][k] = *(const PG8_LAS bf16x8*)(lds + PG8_SA(b, h) + aoff + m * 2048 + k * 1024); } while (0)
#define PG8_LDB(dst, b, h) do { _Pragma("unroll") for (int n = 0; n < 2; ++n) _Pragma("unroll") for (int k = 0; k < 2; ++k) dst[n][k] = *(const PG8_LAS bf16x8*)(lds + PG8_SB(b, h) + boff + n * 2048 + k * 1024); } while (0)
#define PG8_MMA(ai, bj, At, Bt) do { __builtin_amdgcn_s_setprio(1); _Pragma("unroll") for (int m = 0; m < 4; ++m) _Pragma("unroll") for (int n = 0; n < 2; ++n) _Pragma("unroll") for (int k = 0; k < 2; ++k) \
        acc[ai][bj][m][n] = __builtin_amdgcn_mfma_f32_16x16x32_bf16(Bt[n][k], At[m][k], acc[ai][bj][m][n], 0, 0, 0); __builtin_amdgcn_s_setprio(0); } while (0)
#define PG8_WAIT_V(n) asm volatile("s_waitcnt vmcnt(" #n ")" ::: "memory")
#define PG8_WAIT_L(n) asm volatile("s_waitcnt lgkmcnt(" #n ")" ::: "memory")
#define PG8_BAR __builtin_amdgcn_s_barrier()
#define PG8_SCHED __builtin_amdgcn_sched_barrier(0)
    Unit cur, nxt; int ui = 0;
    if (!S.next(0, cur)) return;
    f32x4 acc[2][2][4][2];
#pragma unroll
    for (int a = 0; a < 2; ++a)
#pragma unroll
        for (int b = 0; b < 2; ++b)
#pragma unroll
            for (int m = 0; m < 4; ++m)
#pragma unroll
                for (int n = 0; n < 2; ++n) acc[a][b][m][n] = (f32x4){0.f, 0.f, 0.f, 0.f};
    bf16x8 At[4][2], B0[2][2], B1[2][2];
    const char* cA = (const char*)g.A + (size_t)cur.pm * tstep; const char* cB = (const char*)g.Bt + (size_t)cur.pn * tstep;
    S.a_ready(cur);
    if constexpr (SP2) {
        PG8_STAGE(PG8_SB(0, 0), cB, voffB); PG8_STAGE(PG8_SB(0, 1), cB + hstep, voffB); PG8_STAGE(PG8_SA(0, 0), cA, voffA); PG8_STAGE(PG8_SA(0, 1), cA + hstep, voffA);
        if (wr == 1) PG8_BAR;
        PG8_WAIT_V(2); PG8_BAR;
        PG8_STAGE(PG8_SB(1, 0), cB + kstep, voffB); PG8_STAGE(PG8_SA(1, 0), cA + kstep, voffA); PG8_STAGE(PG8_SB(1, 1), cB + hstep + kstep, voffB);
        PG8_WAIT_V(6); PG8_BAR;
    } else {
        PG8_STAGE(PG8_SB(0, 0), cB, voffB); PG8_STAGE(PG8_SA(0, 0), cA, voffA); PG8_STAGE(PG8_SB(0, 1), cB + hstep, voffB); PG8_STAGE(PG8_SA(0, 1), cA + hstep, voffA);
        if (wr == 1) PG8_BAR;
        PG8_WAIT_V(4); PG8_BAR;
        PG8_STAGE(PG8_SB(1, 0), cB + kstep, voffB); PG8_STAGE(PG8_SA(1, 0), cA + kstep, voffA); PG8_STAGE(PG8_SB(1, 1), cB + hstep + kstep, voffB);
        PG8_WAIT_V(6); PG8_BAR;
    }
    for (;;) {
        const bool has_next = S.next(ui + 1, nxt);
        const char* nA = has_next ? (const char*)g.A + (size_t)nxt.pm * tstep : cA; const char* nB = has_next ? (const char*)g.Bt + (size_t)nxt.pn * tstep : cB;
        for (int t = 0; t < nt; t += 2) {
            const bool last = (t == nt - 2);
            const char* a1 = cA + (size_t)(t + 1) * kstep;
            const char* a2 = last ? nA : cA + (size_t)(t + 2) * kstep; const char* b2 = last ? nB : cB + (size_t)(t + 2) * kstep;
            const char* a3 = a2 + kstep; const char* b3 = b2 + kstep;
            if (last && has_next) S.a_ready(nxt);
            if constexpr (SP2) {
            PG8_LDB(B0, 0, 0); PG8_LDB(B1, 0, 1); PG8_SCHED; PG8_LDA(At, 0, 0); PG8_STAGE(PG8_SA(1, 1), a1 + hstep, voffA);
            PG8_WAIT_V(8); PG8_WAIT_L(0); PG8_BAR; PG8_MMA(0, 0, At, B0); PG8_MMA(0, 1, At, B1); PG8_BAR; PG8_SCHED;
            PG8_LDA(At, 0, 1); PG8_STAGE(PG8_SB(0, 0), b2, voffB); PG8_STAGE(PG8_SB(0, 1), b2 + hstep, voffB); PG8_STAGE(PG8_SA(0, 0), a2, voffA);
            PG8_WAIT_V(8); PG8_WAIT_L(0); PG8_BAR; PG8_MMA(1, 0, At, B0); PG8_MMA(1, 1, At, B1); PG8_BAR; PG8_SCHED;
            PG8_LDB(B0, 1, 0); PG8_LDB(B1, 1, 1); PG8_SCHED; PG8_LDA(At, 1, 0); PG8_STAGE(PG8_SA(0, 1), a2 + hstep, voffA);
            PG8_WAIT_V(8); PG8_WAIT_L(0); PG8_BAR; PG8_MMA(0, 0, At, B0); PG8_MMA(0, 1, At, B1); PG8_BAR; PG8_SCHED;
            PG8_LDA(At, 1, 1); PG8_STAGE(PG8_SB(1, 0), b3, voffB); PG8_STAGE(PG8_SB(1, 1), b3 + hstep, voffB); PG8_STAGE(PG8_SA(1, 0), a3, voffA);
            PG8_WAIT_V(8); PG8_WAIT_L(0); PG8_BAR; PG8_MMA(1, 0, At, B0); PG8_MMA(1, 1, At, B1); PG8_BAR; PG8_SCHED;
            } else {
            PG8_LDB(B0, 0, 0); PG8_SCHED; PG8_LDA(At, 0, 0); PG8_STAGE(PG8_SA(1, 1), a1 + hstep, voffA);
            PG8_WAIT_L(8); PG8_BAR; PG8_WAIT_L(0); PG8_MMA(0, 0, At, B0); PG8_BAR; PG8_SCHED;
            PG8_LDB(B1, 0, 1); PG8_STAGE(PG8_SB(0, 0), b2, voffB);
            PG8_BAR; PG8_WAIT_L(0); PG8_MMA(0, 1, At, B1); PG8_BAR;
            PG8_LDA(At, 0, 1); PG8_STAGE(PG8_SA(0, 0), a2, voffA);
            PG8_BAR; PG8_WAIT_L(0); PG8_MMA(1, 0, At, B0); PG8_BAR; PG8_SCHED;
            PG8_STAGE(PG8_SB(0, 1), b2 + hstep, voffB);
            PG8_WAIT_V(6); PG8_BAR; PG8_MMA(1, 1, At, B1); PG8_BAR;
            PG8_LDB(B0, 1, 0); PG8_SCHED; PG8_LDA(At, 1, 0); PG8_STAGE(PG8_SA(0, 1), a2 + hstep, voffA);
            PG8_WAIT_L(8); PG8_BAR; PG8_WAIT_L(0); PG8_MMA(0, 0, At, B0); PG8_BAR; PG8_SCHED;
            PG8_LDB(B1, 1, 1); PG8_STAGE(PG8_SB(1, 0), b3, voffB);
            PG8_BAR; PG8_WAIT_L(0); PG8_MMA(0, 1, At, B1); PG8_BAR;
            PG8_LDA(At, 1, 1); PG8_STAGE(PG8_SA(1, 0), a3, voffA);
            PG8_BAR; PG8_WAIT_L(0); PG8_MMA(1, 0, At, B0); PG8_BAR; PG8_SCHED;
            PG8_STAGE(PG8_SB(1, 1), b3 + hstep, voffB);
            PG8_WAIT_V(6); PG8_BAR; PG8_MMA(1, 1, At, B1); PG8_BAR;
            }
        }
        if constexpr (ALIGN_EPI) { if (wr == 0) PG8_BAR; }
        if constexpr (!Epi::AFTER_DRAIN) { E(acc, cur, wr, wc, fr, fq); S.done(cur); }
        if (!has_next) break;
#pragma unroll
        for (int a = 0; a < 2; ++a)
#pragma unroll
            for (int b = 0; b < 2; ++b)
#pragma unroll
                for (int m = 0; m < 4; ++m)
#pragma unroll
                    for (int n = 0; n < 2; ++n) acc[a][b][m][n] = (f32x4){0.f, 0.f, 0.f, 0.f};
        cur = nxt; cA = nA; cB = nB; ++ui;
        if constexpr (ALIGN_EPI) { if (wr == 1) PG8_BAR; }
    }
    PG8_WAIT_V(0);
    if constexpr (!ALIGN_EPI) { if (wr == 0) PG8_BAR; }
    PG8_BAR;
    if constexpr (Epi::AFTER_DRAIN) { E.fused(acc, cur, wr, wc, fr, fq, lds, wid, lane); S.done(cur); }
#undef PG8_SA
#undef PG8_SB
#undef PG8_STAGE
#undef PG8_LDA
#undef PG8_LDB
#undef PG8_MMA
#undef PG8_WAIT_V
#undef PG8_WAIT_L
#undef PG8_BAR
#undef PG8_SCHED
}
}
constexpr int NWAVES = 8;
#ifndef REP_MASK
#define REP_MASK 0
#endif
#define REP(k) (1 + (((REP_MASK) >> (k)) & 1))
enum { PH_PRO = 0, PH_INPROJ, PH_PREP, PH_SSD, PH_ATTN, PH_OPROJ, PH_WOUT, PH_ROUTE, PH_GATHER, PH_GU, PH_DOWN, PH_COMB, N_PHASES };
#ifndef SSD_SIMPLE
#define SSD_SIMPLE 0
#endif
#ifndef ATTN_SIMPLE
#define ATTN_SIMPLE 0
#endif
#ifndef MK_PER_PHASE
#define MK_PER_PHASE 0
#endif
constexpr int BATCH = 8, SEQ = 2048, D = 1024, M = BATCH * SEQ;
constexpr int NH = 16, HD = 64, MBLK = 256, NBLK = SEQ / MBLK, MOBA_TOPK = 3;
constexpr int D_INNER = 2048, SSD_H = 32, NGRP = 4, DSTATE = 128, D_XBC = 3072, CONVK = 4;
constexpr int N_IN = 10272, NPROJ = 10240;
constexpr int PQ = 0, PK = 1024, PV = 2048, PZ = 3072, PXBC = 5120, PGATE = 8192;
constexpr int COL_DT = 8192;
constexpr int NEXP = 32, TOPK = 4, EXPCAP = 16384, MAXROWS = M * TOPK + NEXP * 256, MAXTILES = MAXROWS / 256;
constexpr float NORM_EPS = 1e-6f;
constexpr float QSCALE = 0.125f * 1.4426950408889634f;

constexpr size_t MiB = 1u << 20;
constexpr size_t WS_CTL = 0, CTL_ZERO_BYTES = 2 * MiB;
constexpr size_t WS_KM = 1 * MiB;
constexpr size_t WS_WIN = 2 * MiB, WS_WOA = 22 * MiB, WS_WOS = 24 * MiB, WS_WOUT = 28 * MiB, WS_WGU = 30 * MiB, WS_WDN = 158 * MiB;
constexpr size_t WS_WDT = 222 * MiB, WS_WRT = 222 * MiB + 512 * 1024;
constexpr size_t WS_XN = 223 * MiB, WS_DT = 255 * MiB, WS_SSQ = 904 * MiB, WS_YG = 259 * MiB, WS_AO = 323 * MiB, WS_MIXF = 355 * MiB, WS_MIX = 419 * MiB, WS_H2 = 451 * MiB;
constexpr size_t WS_TOKL = 483 * MiB, WS_GATEW = 485 * MiB, WS_POS = 486 * MiB, WS_ROWW = 487 * MiB;
constexpr size_t WS_PROJ = 488 * MiB, WS_XC = 808 * MiB, WS_END = 908 * MiB;
constexpr size_t WS_XG = WS_PROJ, WS_ACT = WS_PROJ + 144 * MiB, WS_Y = WS_XG;
static_assert(WS_ACT + (size_t)MAXROWS * 1024 * 2 <= WS_END, "MoE overlay");
constexpr int CW_TMO = 0, CW_CODE = 1, CW_BAR = 4096, CW_CNT = 16384;

constexpr int RING_OFF = 0, RING_BYTES = 131072;
constexpr int LDSCTL_OFF = RING_BYTES, MISC_OFF = LDSCTL_OFF + 320, TILEE_OFF = LDSCTL_OFF + 1024, ROWB_OFF = LDSCTL_OFF + 2560, CNTL_OFF = LDSCTL_OFF + 2816;
constexpr int LDS_BYTES = 147456;

#define GAS __attribute__((address_space(1)))
#define LAS __attribute__((address_space(3)))
typedef unsigned short bf16;
typedef unsigned v4u __attribute__((ext_vector_type(4)));
typedef unsigned v2u __attribute__((ext_vector_type(2)));
typedef float f32x4 __attribute__((ext_vector_type(4)));
typedef GAS unsigned gu32;
#define RLX_AGENT __ATOMIC_RELAXED, __HIP_MEMORY_SCOPE_AGENT
#define LDS_WAIT() asm volatile("s_waitcnt lgkmcnt(0)" ::: "memory")
#define VM_WAIT() asm volatile("s_waitcnt vmcnt(0)" ::: "memory")
__device__ __forceinline__ unsigned f2bf(float f) { unsigned u = __builtin_bit_cast(unsigned, f); return (u + 0x7fffu + ((u >> 16) & 1u)) >> 16; }
__device__ __forceinline__ unsigned pk2(float lo, float hi) { return f2bf(lo) | (f2bf(hi) << 16); }
__device__ __forceinline__ float bf2f(bf16 b) { return __uint_as_float((unsigned)b << 16); }
__device__ __forceinline__ void unpk8(const v4u w, float (&f)[8]) {
#pragma unroll
    for (int i = 0; i < 4; ++i) { f[2 * i] = __uint_as_float(w[i] << 16); f[2 * i + 1] = __uint_as_float(w[i] & 0xffff0000u); }
}
__device__ __forceinline__ v4u pack8(const float (&f)[8]) { v4u w; w.x = pk2(f[0], f[1]); w.y = pk2(f[2], f[3]); w.z = pk2(f[4], f[5]); w.w = pk2(f[6], f[7]); return w; }
__device__ __forceinline__ float wave_sum(float v) {
#pragma unroll
    for (int o = 1; o < 64; o <<= 1) v += __shfl_xor(v, o);
    return v;
}
__device__ __forceinline__ float wave_max(float v) {
#pragma unroll
    for (int o = 1; o < 64; o <<= 1) v = fmaxf(v, __shfl_xor(v, o));
    return v;
}
__device__ __forceinline__ float silu_f(float x) { return x / (1.f + __expf(-x)); }
#define XB_TMO      128
#define XB_XCNT(j)  (256  + 64 * (j))
#define XB_XSUB(j)  (1280 + 64 * (j))
#define XB_XGEN(j)  (2304 + 64 * (j))
#define XB_TOP      3328
#define XB_TOPGEN   3392
#define XCD_BAR_WORDS 3456
#define XB_SPIN_CAP (1u << 18)

__device__ __forceinline__ unsigned xb_ld(unsigned* p)              { return __hip_atomic_load(p, __ATOMIC_RELAXED, __HIP_MEMORY_SCOPE_AGENT); }
__device__ __forceinline__ unsigned xb_add(unsigned* p, unsigned v) { return __hip_atomic_fetch_add(p, v, __ATOMIC_RELAXED, __HIP_MEMORY_SCOPE_AGENT); }
__device__ __forceinline__ unsigned xb_xcc_id() { return (unsigned)__builtin_amdgcn_s_getreg((3 << 11) | 20) & 0xFu; }
#define XB_SPIN(cond, bar) do { unsigned _sp = 0; while (cond) { __builtin_amdgcn_s_sleep(1); \
    if ((++_sp & 255u) == 0u) { if (xb_ld(&(bar)[XB_TMO])) break; if (_sp > XB_SPIN_CAP) { atomicAdd(&(bar)[XB_TMO], 1u); break; } } } } while (0)

struct XcdBarrier {
    unsigned* bar; unsigned x;
    volatile LAS unsigned* st;
};

__device__ __forceinline__ XcdBarrier xcd_barrier_post(unsigned* bar, volatile LAS unsigned* st) {
    XcdBarrier b; b.bar = bar; b.x = xb_xcc_id(); b.st = st;
    if (threadIdx.x == 0) (void)xb_add(&bar[XB_XCNT(b.x)], 1u);
    return b;
}
__device__ __forceinline__ void xcd_barrier_complete(unsigned* bar, unsigned x, unsigned& nloc, unsigned& nx) {
    const unsigned G = gridDim.x * gridDim.y * gridDim.z;
    unsigned sum, cnt, mine, sp = 0u;
    for (;;) {
        sum = 0u; cnt = 0u; mine = 0u;
#pragma unroll
        for (unsigned j = 0; j < 16; ++j) { const unsigned c = xb_ld(&bar[XB_XCNT(j)]); sum += c; cnt += (c > 0u) ? 1u : 0u; mine = (j == x) ? c : mine; }
        if (sum == G) break;
        __builtin_amdgcn_s_sleep(1);
        if ((++sp & 255u) == 0u) { if (xb_ld(&bar[XB_TMO])) break; if (sp > XB_SPIN_CAP) { atomicAdd(&bar[XB_TMO], 1u); break; } }
    }
    nloc = mine > 0u ? mine : 1u; nx = cnt > 0u ? cnt : 1u;
}

__device__ __forceinline__ void xcd_barrier(const XcdBarrier& b) {
    asm volatile("s_waitcnt vmcnt(0)" ::: "memory");
    __syncthreads();
    if (threadIdx.x == 0) {
        unsigned* bar = b.bar;
        __builtin_amdgcn_s_waitcnt(0);
        unsigned nloc = b.st[0], nx = b.st[1];
        if (nloc == 0u) { xcd_barrier_complete(bar, b.x, nloc, nx); b.st[0] = nloc; b.st[1] = nx; }
        const unsigned old = xb_add(&bar[XB_XSUB(b.x)], 1u);
        const unsigned gen = old / nloc;
        if (old + 1u == (gen + 1u) * nloc) {
            __builtin_amdgcn_fence(__ATOMIC_RELEASE, "agent");
            asm volatile("s_waitcnt vmcnt(0)" ::: "memory");
            const unsigned og = xb_add(&bar[XB_TOP], 1u);
            const unsigned tg = og / nx;
            if (og + 1u == (tg + 1u) * nx) xb_add(&bar[XB_TOPGEN], 1u);
            else XB_SPIN(xb_ld(&bar[XB_TOPGEN]) == tg, bar);
            __builtin_amdgcn_fence(__ATOMIC_ACQUIRE, "agent");
            xb_add(&bar[XB_XGEN(b.x)], 1u);
            asm volatile("s_waitcnt vmcnt(0)" ::: "memory");
        } else {
            XB_SPIN(xb_ld(&bar[XB_XGEN(b.x)]) == gen, bar);
            __builtin_amdgcn_fence(__ATOMIC_ACQUIRE, "agent");
            asm volatile("s_waitcnt vmcnt(0)" ::: "memory");
        }
    }
    __syncthreads();
}
struct Args { const float* in[22]; float* out; unsigned char* ws; int ph_lo, ph_hi; };
struct Frame {
    LAS unsigned char* lds;
    volatile LAS unsigned* MISC;
    gu32* ctl;
    int tid, lane, wave, vcu, G;
};
#define IN_X(A)      ((A).in[0])
#define IN_LN1W(A)   ((A).in[1])
#define IN_WIN(A)    ((A).in[2])
#define IN_GATEB(A)  ((A).in[3])
#define IN_QNW(A)    ((A).in[4])
#define IN_KNW(A)    ((A).in[5])
#define IN_CONVW(A)  ((A).in[6])
#define IN_CONVB(A)  ((A).in[7])
#define IN_DTB(A)    ((A).in[8])
#define IN_ALOG(A)   ((A).in[9])
#define IN_DSKIP(A)  ((A).in[10])
#define IN_SSDNW(A)  ((A).in[11])
#define IN_WOA(A)    ((A).in[12])
#define IN_WOS(A)    ((A).in[13])
#define IN_WOUT(A)   ((A).in[14])
#define IN_LN2W(A)   ((A).in[15])
#define IN_WR(A)     ((A).in[16])
#define IN_BR(A)     ((A).in[17])
#define IN_WGU(A)    ((A).in[18])
#define IN_BGU(A)    ((A).in[19])
#define IN_WDN(A)    ((A).in[20])
#define IN_BDN(A)    ((A).in[21])
#define WSP(A, T, off) ((T*)((A).ws + (off)))

template <class Map>
__device__ __forceinline__ void transpose_item(const float* W, int K, int N, bf16* WT, LAS unsigned* scr, int kb, int nb, int lane, const Map& dest_row) {
    const int k0 = 64 * kb, n0 = 64 * nb, cc = lane & 15, kpl = lane >> 4;
    int col = n0 + 4 * cc; if (col > N - 4) col = N - 4;
    f32x4 a[8], b[8];
#pragma unroll
    for (int it = 0; it < 8; ++it) { const int kp = 4 * it + kpl; a[it] = *(const f32x4*)(W + (size_t)(k0 + 2 * kp) * N + col); b[it] = *(const f32x4*)(W + (size_t)(k0 + 2 * kp + 1) * N + col); }
#pragma unroll
    for (int it = 0; it < 8; ++it) { const int kp = 4 * it + kpl;
#pragma unroll
        for (int i = 0; i < 4; ++i) scr[(4 * cc + i) * 33 + kp] = pk2(a[it][i], b[it][i]); }
    LDS_WAIT(); asm volatile("" ::: "memory");
    const int rr = lane >> 3, ch = lane & 7;
#pragma unroll
    for (int j = 0; j < 8; ++j) { const int n = 8 * j + rr; const LAS unsigned* s = scr + n * 33 + 4 * ch; v4u o; o.x = s[0]; o.y = s[1]; o.z = s[2]; o.w = s[3];
        const int dr = dest_row(n0 + n); if (dr >= 0) *(v4u*)(WT + (size_t)dr * K + k0 + 8 * ch) = o; }
    LDS_WAIT(); asm volatile("" ::: "memory");
}
struct MapId { int N; __device__ __forceinline__ int operator()(int s) const { return s < N ? s : -1; } };
struct MapWin { __device__ __forceinline__ int operator()(int s) const { return s < COL_DT ? s : (s < COL_DT + SSD_H ? -1 : (s < N_IN ? s - SSD_H : -1)); } };
struct MapGu { __device__ __forceinline__ int operator()(int s) const { const int j = s >> 1, isu = s & 1; return (j >> 7) * 256 + (j & 127) + 128 * isu; } };

__device__ __forceinline__ void p0_prologue(Frame& F, const Args& A) {
    LAS unsigned* scr = (LAS unsigned*)(F.lds + RING_OFF + F.wave * 8704);
    const int gw = F.vcu * NWAVES + F.wave, NGW = F.G * NWAVES, lane = F.lane;
    constexpr int I_IN = 16 * 161, I_OA = 16 * 16, I_OS = 32 * 16, I_OUT = 16 * 16, I_GU1 = 16 * 32, I_GU = NEXP * I_GU1, I_DN1 = 16 * 16, I_DN = NEXP * I_DN1;
    constexpr int NITEMS = I_IN + I_OA + I_OS + I_OUT + I_GU + I_DN;
    for (int it = gw; it < NITEMS; it += NGW) {
        int r = it;
        if (r < I_IN) { transpose_item(IN_WIN(A), 1024, N_IN, WSP(A,bf16,WS_WIN), scr, r / 161, r % 161, lane, MapWin{}); continue; } r -= I_IN;
        if (r < I_OA) { transpose_item(IN_WOA(A), 1024, 1024, WSP(A,bf16,WS_WOA), scr, r / 16, r % 16, lane, MapId{1024}); continue; } r -= I_OA;
        if (r < I_OS) { transpose_item(IN_WOS(A), 2048, 1024, WSP(A,bf16,WS_WOS), scr, r / 16, r % 16, lane, MapId{1024}); continue; } r -= I_OS;
        if (r < I_OUT) { transpose_item(IN_WOUT(A), 1024, 1024, WSP(A,bf16,WS_WOUT), scr, r / 16, r % 16, lane, MapId{1024}); continue; } r -= I_OUT;
        if (r < I_GU) { const int e = r / I_GU1, q = r % I_GU1; transpose_item(IN_WGU(A) + (size_t)e * 1024 * 2048, 1024, 2048, WSP(A,bf16,WS_WGU) + (size_t)e * 2048 * 1024, scr, q / 32, q % 32, lane, MapGu{}); continue; } r -= I_GU;
        { const int e = r / I_DN1, q = r % I_DN1; transpose_item(IN_WDN(A) + (size_t)e * 1024 * 1024, 1024, 1024, WSP(A,bf16,WS_WDN) + (size_t)e * 1024 * 1024, scr, q / 16, q % 16, lane, MapId{1024}); }
    }
    { const int gt = F.vcu * 512 + F.tid, NGT = F.G * 512;
      for (int i = gt; i < 32 * 1024; i += NGT) { const int e = i >> 10, k = i & 1023; WSP(A,float,WS_WDT)[i] = IN_WIN(A)[(size_t)k * N_IN + COL_DT + e]; WSP(A,float,WS_WRT)[i] = IN_WR(A)[k * 32 + e]; } }
    for (int m = gw; m < M; m += NGW) {
        const f32x4* xr = (const f32x4*)(IN_X(A) + (size_t)m * D) + lane; const f32x4* wr = (const f32x4*)IN_LN1W(A) + lane;
        f32x4 v[4]; float s = 0.f;
#pragma unroll
        for (int j = 0; j < 4; ++j) { v[j] = xr[64 * j]; s += (v[j].x * v[j].x + v[j].y * v[j].y) + (v[j].z * v[j].z + v[j].w * v[j].w); }
        const float rs = 1.0f / sqrtf(wave_sum(s) * (1.f / D) + NORM_EPS);
        v2u* o8 = (v2u*)(WSP(A,bf16,WS_XN) + (size_t)m * D) + lane;
#pragma unroll
        for (int j = 0; j < 4; ++j) { const f32x4 w = wr[64 * j]; v2u o; o.x = pk2(v[j].x * rs * w.x, v[j].y * rs * w.y); o.y = pk2(v[j].z * rs * w.z, v[j].w * rs * w.w); o8[64 * j] = o; }
    }
}

__device__ __forceinline__ float rowdot32(const float (&h)[16], const LAS float* WT, int lane) {
    float mine = 0.f;
#pragma unroll 2
    for (int e = 0; e < 32; ++e) { float s = 0.f;
#pragma unroll
        for (int j = 0; j < 4; ++j) { const f32x4 w = *(const LAS f32x4*)(WT + e * 1024 + 256 * j + 4 * lane); s += (h[4 * j] * w.x + h[4 * j + 1] * w.y) + (h[4 * j + 2] * w.z + h[4 * j + 3] * w.w); }
        s = wave_sum(s); mine = (lane == e) ? s : mine; }
    return mine;
}
__device__ __forceinline__ void stage_wt(Frame& F, const float* src) {
    LAS f32x4* dst = (LAS f32x4*)(F.lds + RING_OFF); const f32x4* s4 = (const f32x4*)src;
    for (int i = F.tid; i < 8192; i += NWAVES * 64) dst[i] = s4[i];
    __syncthreads();
}

__device__ __forceinline__ void p2_prep(Frame& F, const Args& A) {
    stage_wt(F, WSP(A,float,WS_WDT));
    const LAS float* WT = (const LAS float*)(F.lds + RING_OFF);
    const int lane = F.lane, wave = F.wave;
    float qw[16], kw[16];
#pragma unroll
    for (int q = 0; q < 4; ++q) { const f32x4 a = *(const f32x4*)(IN_QNW(A) + 16 * (lane & 3) + 4 * q), b = *(const f32x4*)(IN_KNW(A) + 16 * (lane & 3) + 4 * q);
#pragma unroll
        for (int i = 0; i < 4; ++i) { qw[4 * q + i] = a[i] * QSCALE; kw[4 * q + i] = b[i]; } }
    for (int item = F.vcu; item < M / 32; item += F.G) {
        const int t0 = item * 32 + wave * 4, b = t0 / SEQ, blk = (t0 % SEQ) / MBLK;
        float km[16];
#pragma unroll
        for (int i = 0; i < 16; ++i) km[i] = 0.f;
        for (int tt = 0; tt < 4; ++tt) {
            const int t = t0 + tt, pos = t % SEQ;
            bf16* prow = WSP(A,bf16,WS_PROJ) + (size_t)t * NPROJ;
            {
                float v[16]; { float lo[8], hi[8]; unpk8(*(const v4u*)(prow + PQ + 16 * lane), lo); unpk8(*(const v4u*)(prow + PQ + 16 * lane + 8), hi);
#pragma unroll
                    for (int i = 0; i < 8; ++i) { v[i] = lo[i]; v[8 + i] = hi[i]; } }
                float ss = 0.f;
#pragma unroll
                for (int i = 0; i < 16; ++i) ss += v[i] * v[i];
                ss += __shfl_xor(ss, 1); ss += __shfl_xor(ss, 2);
                const float rs = 1.0f / sqrtf(ss * (1.f / 64.f) + NORM_EPS);
                float lo[8], hi[8];
#pragma unroll
                for (int i = 0; i < 8; ++i) { lo[i] = v[i] * rs * qw[i]; hi[i] = v[8 + i] * rs * qw[8 + i]; }
                *(v4u*)(prow + PQ + 16 * lane) = pack8(lo); *(v4u*)(prow + PQ + 16 * lane + 8) = pack8(hi);
            }
            {
                float v[16]; { float lo[8], hi[8]; unpk8(*(const v4u*)(prow + PK + 16 * lane), lo); unpk8(*(const v4u*)(prow + PK + 16 * lane + 8), hi);
#pragma unroll
                    for (int i = 0; i < 8; ++i) { v[i] = lo[i]; v[8 + i] = hi[i]; } }
                float ss = 0.f;
#pragma unroll
                for (int i = 0; i < 16; ++i) ss += v[i] * v[i];
                ss += __shfl_xor(ss, 1); ss += __shfl_xor(ss, 2);
                const float rs = 1.0f / sqrtf(ss * (1.f / 64.f) + NORM_EPS);
                float lo[8], hi[8];
#pragma unroll
                for (int i = 0; i < 8; ++i) { lo[i] = v[i] * rs * kw[i]; hi[i] = v[8 + i] * rs * kw[8 + i]; km[i] += lo[i]; km[8 + i] += hi[i]; }
                *(v4u*)(prow + PK + 16 * lane) = pack8(lo); *(v4u*)(prow + PK + 16 * lane + 8) = pack8(hi);
            }
#pragma unroll 1
            for (int g6 = 0; g6 < 6; ++g6) {
                const int c0 = g6 * 512 + 8 * lane; float acc[8];
                { const f32x4 b0 = *(const f32x4*)(IN_CONVB(A) + c0), b1 = *(const f32x4*)(IN_CONVB(A) + c0 + 4);
#pragma unroll
                  for (int i = 0; i < 4; ++i) { acc[i] = b0[i]; acc[4 + i] = b1[i]; } }
#pragma unroll
                for (int j = 0; j < CONVK; ++j) {
                    if (pos - (CONVK - 1) + j >= 0) {
                        float xv[8]; unpk8(*(const v4u*)(WSP(A,bf16,WS_PROJ) + (size_t)(t - (CONVK - 1) + j) * NPROJ + PXBC + c0), xv);
                        const f32x4 w0 = *(const f32x4*)(IN_CONVW(A) + j * D_XBC + c0), w1 = *(const f32x4*)(IN_CONVW(A) + j * D_XBC + c0 + 4);
#pragma unroll
                        for (int i = 0; i < 4; ++i) { acc[i] += w0[i] * xv[i]; acc[4 + i] += w1[i] * xv[4 + i]; }
                    }
                }
#pragma unroll
                for (int i = 0; i < 8; ++i) acc[i] = silu_f(acc[i]);
                *(v4u*)(WSP(A,bf16,WS_XC) + (size_t)t * D_XBC + c0) = pack8(acc);
            }
            {
                float h[16]; const v2u* xr = (const v2u*)(WSP(A,bf16,WS_XN) + (size_t)t * D) + lane;
#pragma unroll
                for (int j = 0; j < 4; ++j) { const v2u w = xr[64 * j]; h[4 * j] = __uint_as_float(w.x << 16); h[4 * j + 1] = __uint_as_float(w.x & 0xffff0000u); h[4 * j + 2] = __uint_as_float(w.y << 16); h[4 * j + 3] = __uint_as_float(w.y & 0xffff0000u); }
                const float mine = rowdot32(h, WT, lane);
                if (lane < 32) { const float z = mine + IN_DTB(A)[lane]; WSP(A,float,WS_DT)[(size_t)t * 32 + lane] = fmaxf(z, 0.f) + log1pf(__expf(-fabsf(z))); }
            }
        }
        float* kmp = WSP(A,float,WS_KM) + ((size_t)(b * NH + (lane >> 2)) * NBLK + blk) * HD + 16 * (lane & 3);
#pragma unroll
        for (int i = 0; i < 16; ++i) unsafeAtomicAdd(kmp + i, km[i] * (1.f / MBLK));
    }
    __syncthreads();
}

__device__ __forceinline__ void p3_ssd(Frame& F, const Args& A) {
    LAS float* xs = (LAS float*)(F.lds + RING_OFF);
    LAS float* Bc = (LAS float*)(F.lds + RING_OFF + 16384);
    LAS float* Cc = (LAS float*)(F.lds + RING_OFF + 49152);
    LAS float* dtv = (LAS float*)(F.lds + RING_OFF + 81920);
    LAS float* yb = (LAS float*)(F.lds + RING_OFF + 82944);
    const int tid = F.tid;
    for (int unit = F.vcu; unit < BATCH * SSD_H; unit += F.G) {
        const int b = unit / SSD_H, h = unit % SSD_H, g = h / (SSD_H / NGRP);
        const float Aneg = -__expf(IN_ALOG(A)[h]), Dh = IN_DSKIP(A)[h];
        const int p = tid >> 3, ng = tid & 7;
        float st[16];
#pragma unroll
        for (int i = 0; i < 16; ++i) st[i] = 0.f;
        for (int ch = 0; ch < SEQ / 64; ++ch) {
            const int tb = b * SEQ + ch * 64;
            {
                const int r = tid >> 3, c8 = tid & 7;
                float v[8]; unpk8(*(const v4u*)(WSP(A,bf16,WS_XC) + (size_t)(tb + r) * D_XBC + h * 64 + 8 * c8), v);
#pragma unroll
                for (int i = 0; i < 8; ++i) xs[r * 64 + 8 * c8 + i] = v[i];
#pragma unroll
                for (int q = 0; q < 2; ++q) { const int idx = tid + 512 * q, rr = idx >> 4, c16 = idx & 15;
                    float bv[8], cv[8]; unpk8(*(const v4u*)(WSP(A,bf16,WS_XC) + (size_t)(tb + rr) * D_XBC + D_INNER + g * DSTATE + 8 * c16), bv); unpk8(*(const v4u*)(WSP(A,bf16,WS_XC) + (size_t)(tb + rr) * D_XBC + D_INNER + NGRP * DSTATE + g * DSTATE + 8 * c16), cv);
#pragma unroll
                    for (int i = 0; i < 8; ++i) { Bc[rr * 128 + 8 * c16 + i] = bv[i]; Cc[rr * 128 + 8 * c16 + i] = cv[i]; } }
                if (tid < 64) dtv[tid] = WSP(A,float,WS_DT)[(size_t)(tb + tid) * 32 + h];
            }
            __syncthreads();
            for (int tok = 0; tok < 64; ++tok) {
                const float dt = dtv[tok], decay = __expf(dt * Aneg), xdt = xs[tok * 64 + p] * dt;
                float yp = 0.f;
#pragma unroll
                for (int q = 0; q < 4; ++q) { const f32x4 bb = *(const LAS f32x4*)(Bc + tok * 128 + 16 * ng + 4 * q), cc = *(const LAS f32x4*)(Cc + tok * 128 + 16 * ng + 4 * q);
#pragma unroll
                    for (int i = 0; i < 4; ++i) { st[4 * q + i] = st[4 * q + i] * decay + bb[i] * xdt; yp += cc[i] * st[4 * q + i]; } }
                yp += __shfl_xor(yp, 1); yp += __shfl_xor(yp, 2); yp += __shfl_xor(yp, 4);
                if (ng == 0) yb[tok * 64 + p] = yp;
            }
            __syncthreads();
            {
                const int r = tid >> 3, c8 = tid & 7; const size_t t = (size_t)(tb + r);
                float z[8]; unpk8(*(const v4u*)(WSP(A,bf16,WS_PROJ) + t * NPROJ + PZ + h * 64 + 8 * c8), z);
                float o[8]; float ss = 0.f;
#pragma unroll
                for (int i = 0; i < 8; ++i) { const float y = yb[r * 64 + 8 * c8 + i] + Dh * xs[r * 64 + 8 * c8 + i]; o[i] = y * silu_f(z[i]); ss += o[i] * o[i]; }
                *(v4u*)(WSP(A,bf16,WS_YG) + t * D_INNER + h * 64 + 8 * c8) = pack8(o);
                ss += __shfl_xor(ss, 1); ss += __shfl_xor(ss, 2); ss += __shfl_xor(ss, 4);
                if (c8 == 0) { WSP(A,float,WS_SSQ)[t * 64 + 2 * h] = ss; WSP(A,float,WS_SSQ)[t * 64 + 2 * h + 1] = 0.f; }
            }
            __syncthreads();
        }
    }
}

typedef short bf16x8v __attribute__((ext_vector_type(8)));
typedef float f32x16 __attribute__((ext_vector_type(16)));
__device__ __forceinline__ int crow(int r, int hi) { return (r & 3) + 8 * (r >> 2) + 4 * hi; }

__device__ __forceinline__ void p3_ssd_mfma(Frame& F, const Args& A) {
    constexpr int RP = 272, TP = 144;
    constexpr int O_B = 0, O_C = 17408, O_BT = 34816, O_XT = 53248, O_S = 62464, O_CS = 97280, O_DT = 97536;
    LAS unsigned char* L = F.lds + RING_OFF;
    LAS float* csL = (LAS float*)(L + O_CS); LAS float* dtL = (LAS float*)(L + O_DT);
    const int tid = F.tid, lane = F.lane, wave = F.wave, r32 = lane & 31, hi = lane >> 5;
    for (int unit = F.vcu; unit < BATCH * SSD_H; unit += F.G) {
        const int b = unit / SSD_H, hd = unit % SSD_H, g = hd / (SSD_H / NGRP);
        const float Aneg = -__expf(IN_ALOG(A)[hd]), Dh = IN_DSKIP(A)[hd];
        const int ll = tid & 63, cc = tid >> 6;
        const bf16* xg = WSP(A,bf16,WS_XC) + (size_t)(b * SEQ + ll) * D_XBC + hd * 64 + 8 * cc;
        const bf16* bg = WSP(A,bf16,WS_XC) + (size_t)(b * SEQ + ll) * D_XBC + D_INNER + g * DSTATE + 16 * cc;
        const bf16* cg = bg + NGRP * DSTATE;
        const float* dg = WSP(A,float,WS_DT) + (size_t)(b * SEQ + ll) * 32 + hd;
        v4u xr, br0, br1, cr0, cr1; float dtr = 0.f;
#define SS_LOAD(c) do { const size_t o_ = (size_t)(c) * 64 * D_XBC; xr = *(const v4u*)(xg + o_); br0 = *(const v4u*)(bg + o_); br1 = *(const v4u*)(bg + o_ + 8); cr0 = *(const v4u*)(cg + o_); cr1 = *(const v4u*)(cg + o_ + 8); \
            if (tid < 64) dtr = dg[(size_t)(c) * 64 * 32]; } while (0)
#define SS_STORE() do { \
            *(LAS v4u*)(L + O_B + ll * RP + cc * 32) = br0; *(LAS v4u*)(L + O_B + ll * RP + cc * 32 + 16) = br1; \
            *(LAS v4u*)(L + O_C + ll * RP + cc * 32) = cr0; *(LAS v4u*)(L + O_C + ll * RP + cc * 32 + 16) = cr1; \
            _Pragma("unroll") for (int i_ = 0; i_ < 4; ++i_) { \
                *(LAS unsigned short*)(L + O_XT + (8 * cc + 2 * i_) * TP + ll * 2) = (unsigned short)(xr[i_] & 0xffffu); *(LAS unsigned short*)(L + O_XT + (8 * cc + 2 * i_ + 1) * TP + ll * 2) = (unsigned short)(xr[i_] >> 16); \
                *(LAS unsigned short*)(L + O_BT + (16 * cc + 2 * i_) * TP + ll * 2) = (unsigned short)(br0[i_] & 0xffffu); *(LAS unsigned short*)(L + O_BT + (16 * cc + 2 * i_ + 1) * TP + ll * 2) = (unsigned short)(br0[i_] >> 16); \
                *(LAS unsigned short*)(L + O_BT + (16 * cc + 8 + 2 * i_) * TP + ll * 2) = (unsigned short)(br1[i_] & 0xffffu); *(LAS unsigned short*)(L + O_BT + (16 * cc + 8 + 2 * i_ + 1) * TP + ll * 2) = (unsigned short)(br1[i_] >> 16); } \
            if (tid < 64) { float a_ = dtr * Aneg; \
                _Pragma("unroll") for (int o_ = 1; o_ < 64; o_ <<= 1) { const float v_ = __shfl_up(a_, o_); if (lane >= o_) a_ += v_; } \
                csL[tid] = a_; dtL[tid] = dtr; } } while (0)
        SS_LOAD(0); SS_STORE();
        f32x16 s0 = {}, s1 = {};
        __syncthreads();
        for (int c = 0; c < SEQ / 64; ++c) {
            if (c + 1 < SEQ / 64) SS_LOAD(c + 1);
            const int tb = b * SEQ + c * 64;
            if (wave < 4) {
                const int pt = wave & 1, lt = wave >> 1;
                const LAS unsigned char* Sb = L + O_S + (c & 1) * 17408;
                f32x16 acc = {};
                const float csl = csL[32 * lt + r32];
                if (c > 0) {
#pragma unroll
                    for (int ks = 0; ks < 8; ++ks) { const bf16x8v af = *(const LAS bf16x8v*)(Sb + (32 * pt + r32) * RP + ks * 32 + hi * 16), bf = *(const LAS bf16x8v*)(L + O_C + (32 * lt + r32) * RP + ks * 32 + hi * 16);
                        acc = __builtin_amdgcn_mfma_f32_32x32x16_bf16(af, bf, acc, 0, 0, 0); }
                    const float el = __expf(csl);
#pragma unroll
                    for (int r = 0; r < 16; ++r) acc[r] *= el;
                }
                for (int st = 0; st <= lt; ++st) {
                    f32x16 gt = {};
#pragma unroll
                    for (int ks = 0; ks < 8; ++ks) { const bf16x8v af = *(const LAS bf16x8v*)(L + O_B + (32 * st + r32) * RP + ks * 32 + hi * 16), bf = *(const LAS bf16x8v*)(L + O_C + (32 * lt + r32) * RP + ks * 32 + hi * 16);
                        gt = __builtin_amdgcn_mfma_f32_32x32x16_bf16(af, bf, gt, 0, 0, 0); }
                    const int lidx = 32 * lt + r32;
#pragma unroll
                    for (int r = 0; r < 16; ++r) { const int s = 32 * st + crow(r, hi); const float e = __expf(csl - csL[s]) * dtL[s]; gt[r] = (s <= lidx) ? gt[r] * e : 0.f; }
                    v4u m0, m1;
#pragma unroll
                    for (int q = 0; q < 4; ++q) { m0[q] = pk2(gt[2 * q], gt[2 * q + 1]); m1[q] = pk2(gt[8 + 2 * q], gt[8 + 2 * q + 1]); }
                    const LAS unsigned char* xrow = L + O_XT + (32 * pt + r32) * TP + (32 * st + 4 * hi) * 2;
                    { const v2u a0 = *(const LAS v2u*)(xrow), a1 = *(const LAS v2u*)(xrow + 16); v4u av; av.x = a0.x; av.y = a0.y; av.z = a1.x; av.w = a1.y;
                      acc = __builtin_amdgcn_mfma_f32_32x32x16_bf16(__builtin_bit_cast(bf16x8v, av), __builtin_bit_cast(bf16x8v, m0), acc, 0, 0, 0); }
                    { const v2u a0 = *(const LAS v2u*)(xrow + 32), a1 = *(const LAS v2u*)(xrow + 48); v4u av; av.x = a0.x; av.y = a0.y; av.z = a1.x; av.w = a1.y;
                      acc = __builtin_amdgcn_mfma_f32_32x32x16_bf16(__builtin_bit_cast(bf16x8v, av), __builtin_bit_cast(bf16x8v, m1), acc, 0, 0, 0); }
                }
                const size_t t = (size_t)(tb + 32 * lt + r32); float ss = 0.f;
#pragma unroll
                for (int g4 = 0; g4 < 4; ++g4) { const int pc = hd * 64 + 32 * pt + 8 * g4 + 4 * hi;
                    const v2u zz = *(const v2u*)(WSP(A,bf16,WS_PROJ) + t * NPROJ + PZ + pc), xx = *(const v2u*)(WSP(A,bf16,WS_XC) + t * D_XBC + pc);
                    const float z[4] = {__uint_as_float(zz.x << 16), __uint_as_float(zz.x & 0xffff0000u), __uint_as_float(zz.y << 16), __uint_as_float(zz.y & 0xffff0000u)};
                    const float x[4] = {__uint_as_float(xx.x << 16), __uint_as_float(xx.x & 0xffff0000u), __uint_as_float(xx.y << 16), __uint_as_float(xx.y & 0xffff0000u)};
                    float o[4];
#pragma unroll
                    for (int i = 0; i < 4; ++i) { const float y = acc[4 * g4 + i] + Dh * x[i]; o[i] = y * silu_f(z[i]); ss += o[i] * o[i]; }
                    v2u w; w.x = pk2(o[0], o[1]); w.y = pk2(o[2], o[3]); *(v2u*)(WSP(A,bf16,WS_YG) + t * D_INNER + pc) = w; }
                ss += __shfl_xor(ss, 32);
                if (hi == 0) WSP(A,float,WS_SSQ)[t * 64 + hd * 2 + pt] = ss;
            } else {
                const int w4 = wave - 4, pt = w4 & 1, nt0 = 2 * (w4 >> 1);
                const float cslast = csL[63]; const float dec = __expf(cslast);
#pragma unroll
                for (int r = 0; r < 16; ++r) { s0[r] *= dec; s1[r] *= dec; }
#pragma unroll
                for (int ks = 0; ks < 4; ++ks) {
                    float xv[8]; unpk8(*(const LAS v4u*)(L + O_XT + (32 * pt + r32) * TP + ks * 32 + hi * 16), xv);
                    const f32x4 c0 = *(const LAS f32x4*)(csL + 16 * ks + 8 * hi), c1 = *(const LAS f32x4*)(csL + 16 * ks + 8 * hi + 4), d0 = *(const LAS f32x4*)(dtL + 16 * ks + 8 * hi), d1 = *(const LAS f32x4*)(dtL + 16 * ks + 8 * hi + 4);
#pragma unroll
                    for (int i = 0; i < 4; ++i) { xv[i] *= d0[i] * __expf(cslast - c0[i]); xv[4 + i] *= d1[i] * __expf(cslast - c1[i]); }
                    const bf16x8v af = __builtin_bit_cast(bf16x8v, pack8(xv));
                    const bf16x8v b0 = *(const LAS bf16x8v*)(L + O_BT + (32 * nt0 + r32) * TP + ks * 32 + hi * 16), b1 = *(const LAS bf16x8v*)(L + O_BT + (32 * nt0 + 32 + r32) * TP + ks * 32 + hi * 16);
                    s0 = __builtin_amdgcn_mfma_f32_32x32x16_bf16(af, b0, s0, 0, 0, 0); s1 = __builtin_amdgcn_mfma_f32_32x32x16_bf16(af, b1, s1, 0, 0, 0);
                }
                LAS unsigned char* Sn = L + O_S + ((c + 1) & 1) * 17408;
#pragma unroll
                for (int r = 0; r < 16; ++r) { const int p = 32 * pt + crow(r, hi);
                    *(LAS unsigned short*)(Sn + p * RP + (32 * nt0 + r32) * 2) = (unsigned short)f2bf(s0[r]); *(LAS unsigned short*)(Sn + p * RP + (32 * nt0 + 32 + r32) * 2) = (unsigned short)f2bf(s1[r]); }
            }
            __syncthreads();
            if (c + 1 < SEQ / 64) SS_STORE();
            __syncthreads();
        }
#undef SS_LOAD
#undef SS_STORE
    }
}

__device__ __forceinline__ void p4_norm(Frame& F, const Args& A) {
    const int lane = F.lane, gw = F.vcu * NWAVES + F.wave, NGW = F.G * NWAVES;
    for (int t = gw; t < M; t += NGW) {
        bf16* row = WSP(A,bf16,WS_YG) + (size_t)t * D_INNER + 32 * lane; const int g = lane >> 4;
        float ss = 0.f;
#pragma unroll
        for (int hh = 0; hh < 16; ++hh) ss += WSP(A,float,WS_SSQ)[(size_t)t * 64 + 16 * g + hh];
        const float rs = 1.0f / sqrtf(ss * (1.f / 512.f) + NORM_EPS);
#pragma unroll
        for (int q = 0; q < 4; ++q) { float v[8]; unpk8(*(const v4u*)(row + 8 * q), v); const f32x4 w0 = *(const f32x4*)(IN_SSDNW(A) + 32 * lane + 8 * q), w1 = *(const f32x4*)(IN_SSDNW(A) + 32 * lane + 8 * q + 4);
#pragma unroll
            for (int i = 0; i < 4; ++i) { v[i] = v[i] * rs * w0[i]; v[4 + i] = v[4 + i] * rs * w1[i]; }
            *(v4u*)(row + 8 * q) = pack8(v); }
    }
}
__device__ __forceinline__ void attn_simple(Frame& F, const Args& A) {
    const int lane = F.lane, gw = F.vcu * NWAVES + F.wave, NGW = F.G * NWAVES;
    const float qwm = wave_max(fabsf(IN_QNW(A)[lane])), kwm = wave_max(fabsf(IN_KNW(A)[lane]));
    const float REF = 8.0f * qwm * kwm * 1.4426950408889634f + 0.25f;
    const bf16* QN = WSP(A,bf16,WS_PROJ) + PQ; const bf16* KN = WSP(A,bf16,WS_PROJ) + PK; const bf16* VV = WSP(A,bf16,WS_PROJ) + PV;
    for (int rep = 0; rep < REP(PH_ATTN); ++rep)
    for (long a = gw; a < (long)M * NH; a += NGW) {
        const int grp = (int)(a >> 7), within = (int)(a & 127), h = within >> 3, t = grp * 8 + (within & 7);
        const int b = t / SEQ, pos = t % SEQ, qb = pos >> 8;
        const bf16* qp = QN + (size_t)t * NPROJ + h * 64;
        float q[64];
#pragma unroll
        for (int c = 0; c < 8; ++c) { float v[8]; unpk8(*(const v4u*)(qp + 8 * c), v);
#pragma unroll
            for (int i = 0; i < 8; ++i) q[8 * c + i] = v[i]; }
        const float qd = bf2f(qp[lane]);
        float sc[7];
#pragma unroll
        for (int j = 0; j < 7; ++j) { sc[j] = -3.0e38f; if (j < qb) sc[j] = wave_sum(qd * WSP(A,float,WS_KM)[((size_t)(b * NH + h) * NBLK + j) * HD + lane]); }
        unsigned sel = 0u; const int nsel = qb < MOBA_TOPK ? qb : MOBA_TOPK;
#pragma unroll
        for (int k = 0; k < MOBA_TOPK; ++k) if (k < nsel) { float best = -3.0e38f; int bi = 0;
#pragma unroll
            for (int j = 0; j < 7; ++j) if (j < qb && !((sel >> j) & 1u) && sc[j] > best) { best = sc[j]; bi = j; }
            sel |= 1u << bi; }
        sel |= 1u << qb;
        float o = 0.f, lsum = 0.f;
        for (int j = 0; j <= qb; ++j) {
            if (!((sel >> j) & 1u)) continue;
            for (int tile = 0; tile < 4; ++tile) {
                const int kbase = j * MBLK + tile * 64; if (j == qb && kbase > pos) break;
                const int kk = kbase + lane; const bf16* kp = KN + (size_t)(b * SEQ + kk) * NPROJ + h * 64;
                float dot = 0.f;
#pragma unroll
                for (int c = 0; c < 8; ++c) { float v[8]; unpk8(*(const v4u*)(kp + 8 * c), v);
#pragma unroll
                    for (int i = 0; i < 8; ++i) dot += v[i] * q[8 * c + i]; }
                const bool valid = (j < qb) || (kk <= pos);
                const float pr = valid ? __builtin_amdgcn_exp2f(dot - REF) : 0.f; lsum += pr;
                const bf16* vp = VV + (size_t)(b * SEQ + kbase) * NPROJ + h * 64 + lane;
#pragma unroll 16
                for (int jj = 0; jj < 64; ++jj) { const float pj = __shfl(pr, jj); o += pj * bf2f(vp[(size_t)jj * NPROJ]); }
            }
        }
        const float l = wave_sum(lsum);
        WSP(A,bf16,WS_AO)[(size_t)t * D + h * 64 + lane] = (bf16)f2bf(o / l);
    }
}


__device__ __forceinline__ void attn_mfma(Frame& F, const Args& A) {
    const int tid = F.tid, lane = F.lane, wave = F.wave, r32 = lane & 31, hi = lane >> 5;
    constexpr int KP = 144, VP = 136, KBS = 9216, VB0 = 18432, VBS = 8704, KMOFF = 36864;
    LAS unsigned char* L = F.lds + RING_OFF;
    LAS float* KMs = (LAS float*)(L + KMOFF);
    const float qwm = wave_max(fabsf(IN_QNW(A)[lane])), kwm = wave_max(fabsf(IN_KNW(A)[lane]));
    const float REF = 8.0f * qwm * kwm * 1.4426950408889634f + 0.25f;
    const bf16* QN = WSP(A,bf16,WS_PROJ) + PQ; const bf16* KN = WSP(A,bf16,WS_PROJ) + PK; const bf16* VV = WSP(A,bf16,WS_PROJ) + PV;
    for (int slot = F.vcu; slot < 256; slot += F.G)
    for (int ui = 0; ui < 4; ++ui) {
        const int bh = slot >> 1, sp = slot & 1, b = bh >> 4, h = bh & 15;
        const int qb = (sp == 0) ? (ui == 0 ? 0 : ui == 1 ? 7 : ui == 2 ? 1 : 6) : (ui == 0 ? 2 : ui == 1 ? 5 : ui == 2 ? 3 : 4);
        const int tq0 = b * SEQ + qb * MBLK, NT = 4 * (qb + 1);
        const bf16* kg = KN + (size_t)(b * SEQ + (tid >> 3)) * NPROJ + h * 64 + 8 * (tid & 7);
        const bf16* vg = VV + (size_t)(b * SEQ + 2 * (tid >> 4)) * NPROJ + h * 64 + 4 * (tid & 15);
        v4u kreg; v2u vr0, vr1;
#define AT_LOAD(tt) do { kreg = *(const v4u*)(kg + (size_t)(tt) * 64 * NPROJ); vr0 = *(const v2u*)(vg + (size_t)(tt) * 64 * NPROJ); vr1 = *(const v2u*)(vg + (size_t)(tt) * 64 * NPROJ + NPROJ); } while (0)
#define AT_STORE(bufi) do { *(LAS v4u*)(L + (bufi) * KBS + (tid >> 3) * KP + (tid & 7) * 16) = kreg; \
            LAS unsigned char* vb_ = L + VB0 + (bufi) * VBS + (4 * (tid & 15)) * VP + (tid >> 4) * 4; \
            *(LAS unsigned*)(vb_) = (vr0.x & 0xffffu) | (vr1.x << 16); *(LAS unsigned*)(vb_ + VP) = (vr0.x >> 16) | (vr1.x & 0xffff0000u); \
            *(LAS unsigned*)(vb_ + 2 * VP) = (vr0.y & 0xffffu) | (vr1.y << 16); *(LAS unsigned*)(vb_ + 3 * VP) = (vr0.y >> 16) | (vr1.y & 0xffff0000u); } while (0)
        if (tid < 448) { const int j = tid >> 6; if (j < qb) KMs[tid] = WSP(A,float,WS_KM)[((size_t)(b * NH + h) * NBLK + j) * HD + (tid & 63)]; }
        AT_LOAD(0); AT_STORE(0);
        const bf16* qp = QN + (size_t)(tq0 + wave * 32 + r32) * NPROJ + h * 64;
        bf16x8v qr[4];
#pragma unroll
        for (int ds = 0; ds < 4; ++ds) qr[ds] = *(const bf16x8v*)(qp + 16 * ds + 8 * hi);
        __syncthreads();
        float sc[7];
#pragma unroll
        for (int j = 0; j < 7; ++j) { sc[j] = -3.0e38f;
            if (j < qb) { float s = 0.f;
#pragma unroll
                for (int ds = 0; ds < 4; ++ds) { float qv[8]; unpk8(__builtin_bit_cast(v4u, qr[ds]), qv);
                    const f32x4 k0 = *(const LAS f32x4*)(KMs + j * 64 + 16 * ds + 8 * hi), k1 = *(const LAS f32x4*)(KMs + j * 64 + 16 * ds + 8 * hi + 4);
                    s += (qv[0] * k0.x + qv[1] * k0.y) + (qv[2] * k0.z + qv[3] * k0.w) + (qv[4] * k1.x + qv[5] * k1.y) + (qv[6] * k1.z + qv[7] * k1.w); }
                s += __shfl_xor(s, 32); sc[j] = s; } }
        unsigned sel = 0u; const int nsel = qb < MOBA_TOPK ? qb : MOBA_TOPK;
#pragma unroll
        for (int k = 0; k < MOBA_TOPK; ++k) if (k < nsel) { float best = -3.0e38f; int bi = 0;
#pragma unroll
            for (int j = 0; j < 7; ++j) if (j < qb && !((sel >> j) & 1u) && sc[j] > best) { best = sc[j]; bi = j; }
            sel |= 1u << bi; }
        f32x16 o0 = {}, o1 = {}; float lsum = 0.f;
        const int qi = wave * 32 + r32;
        for (int tt = 0; tt < NT; ++tt) {
            const int cur = tt & 1;
            if (tt + 1 < NT) AT_LOAD(tt + 1);
            const int j = tt >> 2, tile = tt & 3; const bool own = (j == qb);
            if (!(own && tile * 64 > wave * 32 + 31)) {
                const LAS unsigned char* Kb = L + cur * KBS; const LAS unsigned char* Vb = L + VB0 + cur * VBS;
                f32x16 p0 = {}, p1 = {};
#pragma unroll
                for (int ds = 0; ds < 4; ++ds) {
                    const bf16x8v k0 = *(const LAS bf16x8v*)(Kb + r32 * KP + ds * 32 + hi * 16), k1 = *(const LAS bf16x8v*)(Kb + (32 + r32) * KP + ds * 32 + hi * 16);
                    p0 = __builtin_amdgcn_mfma_f32_32x32x16_bf16(k0, qr[ds], p0, 0, 0, 0); p1 = __builtin_amdgcn_mfma_f32_32x32x16_bf16(k1, qr[ds], p1, 0, 0, 0); }
                const bool selbit = ((sel >> j) & 1u) != 0u;
#pragma unroll
                for (int r = 0; r < 16; ++r) { const int kv0 = tile * 64 + crow(r, hi);
                    const bool v0 = own ? (kv0 <= qi) : selbit, v1 = own ? (kv0 + 32 <= qi) : selbit;
                    p0[r] = v0 ? __builtin_amdgcn_exp2f(p0[r] - REF) : 0.f; p1[r] = v1 ? __builtin_amdgcn_exp2f(p1[r] - REF) : 0.f; lsum += p0[r] + p1[r]; }
                v4u pf[4];
#pragma unroll
                for (int q = 0; q < 4; ++q) { pf[0][q] = pk2(p0[2 * q], p0[2 * q + 1]); pf[1][q] = pk2(p0[8 + 2 * q], p0[8 + 2 * q + 1]); pf[2][q] = pk2(p1[2 * q], p1[2 * q + 1]); pf[3][q] = pk2(p1[8 + 2 * q], p1[8 + 2 * q + 1]); }
#pragma unroll
                for (int ks = 0; ks < 4; ++ks) {
                    const bf16x8v pb = __builtin_bit_cast(bf16x8v, pf[ks]);
                    { const v2u a0 = *(const LAS v2u*)(Vb + r32 * VP + (16 * ks + 4 * hi) * 2), a1 = *(const LAS v2u*)(Vb + r32 * VP + (16 * ks + 8 + 4 * hi) * 2);
                      v4u av; av.x = a0.x; av.y = a0.y; av.z = a1.x; av.w = a1.y; o0 = __builtin_amdgcn_mfma_f32_32x32x16_bf16(__builtin_bit_cast(bf16x8v, av), pb, o0, 0, 0, 0); }
                    { const v2u a0 = *(const LAS v2u*)(Vb + (32 + r32) * VP + (16 * ks + 4 * hi) * 2), a1 = *(const LAS v2u*)(Vb + (32 + r32) * VP + (16 * ks + 8 + 4 * hi) * 2);
                      v4u av; av.x = a0.x; av.y = a0.y; av.z = a1.x; av.w = a1.y; o1 = __builtin_amdgcn_mfma_f32_32x32x16_bf16(__builtin_bit_cast(bf16x8v, av), pb, o1, 0, 0, 0); }
                }
            }
            if (tt + 1 < NT) AT_STORE(cur ^ 1);
            __syncthreads();
        }
#undef AT_LOAD
#undef AT_STORE
        const float l = lsum + __shfl_xor(lsum, 32), inv = 1.0f / l;
        bf16* op = WSP(A,bf16,WS_AO) + (size_t)(tq0 + qi) * D + h * 64 + 4 * hi;
#pragma unroll
        for (int g4 = 0; g4 < 4; ++g4) { v2u w0, w1; w0.x = pk2(o0[4 * g4] * inv, o0[4 * g4 + 1] * inv); w0.y = pk2(o0[4 * g4 + 2] * inv, o0[4 * g4 + 3] * inv);
            w1.x = pk2(o1[4 * g4] * inv, o1[4 * g4 + 1] * inv); w1.y = pk2(o1[4 * g4 + 2] * inv, o1[4 * g4 + 3] * inv);
            *(v2u*)(op + 8 * g4) = w0; *(v2u*)(op + 32 + 8 * g4) = w1; }
    }
    __syncthreads();
}
__device__ __forceinline__ void p7_route(Frame& F, const Args& A) {
    stage_wt(F, WSP(A,float,WS_WRT));
    const LAS float* WT = (const LAS float*)(F.lds + RING_OFF);
    const int lane = F.lane, gw = F.vcu * NWAVES + F.wave, NGW = F.G * NWAVES;
    for (int t = gw; t < M; t += NGW) {
        const f32x4* xr = (const f32x4*)((A).out + (size_t)t * D) + lane; const f32x4* wr = (const f32x4*)IN_LN2W(A) + lane;
        f32x4 v[4]; float s = 0.f;
#pragma unroll
        for (int j = 0; j < 4; ++j) { v[j] = xr[64 * j]; s += (v[j].x * v[j].x + v[j].y * v[j].y) + (v[j].z * v[j].z + v[j].w * v[j].w); }
        const float rs = 1.0f / sqrtf(wave_sum(s) * (1.f / D) + NORM_EPS);
        float h[16]; v2u* o8 = (v2u*)(WSP(A,bf16,WS_H2) + (size_t)t * D) + lane;
#pragma unroll
        for (int j = 0; j < 4; ++j) { const f32x4 w = wr[64 * j]; h[4 * j] = v[j].x * rs * w.x; h[4 * j + 1] = v[j].y * rs * w.y; h[4 * j + 2] = v[j].z * rs * w.z; h[4 * j + 3] = v[j].w * rs * w.w;
            v2u o; o.x = pk2(h[4 * j], h[4 * j + 1]); o.y = pk2(h[4 * j + 2], h[4 * j + 3]); o8[64 * j] = o; }
        float val = rowdot32(h, WT, lane); val = (lane < 32) ? val + IN_BR(A)[lane & 31] : -3.0e38f;
        float tv[4]; int ti[4];
#pragma unroll
        for (int k = 0; k < 4; ++k) { const float mx = wave_max(val); const unsigned long long bm = __ballot(val == mx); const int idx = __builtin_ctzll(bm);
            tv[k] = mx; ti[k] = idx; if (lane == idx) val = -3.0e38f; }
        float ex[4], es = 0.f;
#pragma unroll
        for (int k = 0; k < 4; ++k) { ex[k] = __expf(tv[k] - tv[0]); es += ex[k]; }
        if (lane == 0) {
#pragma unroll
            for (int k = 0; k < 4; ++k) { const unsigned j = __hip_atomic_fetch_add((WSP(A,unsigned,WS_CTL) + CW_CNT) + ti[k], 1u, RLX_AGENT); WSP(A,int,WS_TOKL)[ti[k] * EXPCAP + (int)j] = t * 4 + k; WSP(A,float,WS_GATEW)[t * 4 + k] = ex[k] / es; }
        }
    }
    __syncthreads();
}

__device__ __forceinline__ int moe_tables(Frame& F, const Args& A) {
    LAS int* tile_e = (LAS int*)(F.lds + TILEE_OFF); LAS int* rowb = (LAS int*)(F.lds + ROWB_OFF); LAS int* cntl = (LAS int*)(F.lds + CNTL_OFF);
    if (F.tid == 0) { int acc = 0, rt = 0;
        for (int e = 0; e < NEXP; ++e) { int c = (int)__hip_atomic_load((WSP(A,unsigned,WS_CTL) + CW_CNT) + e, RLX_AGENT); if (c > EXPCAP) c = EXPCAP; cntl[e] = c; rowb[e] = acc; const int n = (c + 255) >> 8; for (int i = 0; i < n; ++i) tile_e[rt++] = e; acc += n * 256; }
        rowb[NEXP] = acc; }
    __syncthreads();
    return rowb[NEXP] >> 8;
}
__device__ __forceinline__ void p8_gather(Frame& F, const Args& A) {
    const int NT = moe_tables(F, A);
    const LAS int* rowb = (const LAS int*)(F.lds + ROWB_OFF); const LAS int* cntl = (const LAS int*)(F.lds + CNTL_OFF);
    const int lane = F.lane, gw = F.vcu * NWAVES + F.wave, NGW = F.G * NWAVES, total = NT * 256;
    for (int r = gw; r < total; r += NGW) {
        int e = 0;
#pragma unroll
        for (int q = 1; q < NEXP; ++q) e += (rowb[q] <= r) ? 1 : 0;
        const int j = r - rowb[e];
        if (j < cntl[e]) { const int a = WSP(A,int,WS_TOKL)[e * EXPCAP + j], t = a >> 2;
            const v4u x0 = *(const v4u*)(WSP(A,bf16,WS_H2) + (size_t)t * D + 16 * lane), x1 = *(const v4u*)(WSP(A,bf16,WS_H2) + (size_t)t * D + 16 * lane + 8);
            *(v4u*)(WSP(A,bf16,WS_XG) + (size_t)r * D + 16 * lane) = x0; *(v4u*)(WSP(A,bf16,WS_XG) + (size_t)r * D + 16 * lane + 8) = x1;
            if (lane == 0) { WSP(A,float,WS_ROWW)[r] = WSP(A,float,WS_GATEW)[a]; WSP(A,int,WS_POS)[a] = r; } }
        else if (lane == 0) WSP(A,float,WS_ROWW)[r] = 0.f;
    }
    __syncthreads();
}
__device__ __forceinline__ void p11_combine(Frame& F, const Args& A) {
    const int lane = F.lane, gw = F.vcu * NWAVES + F.wave, NGW = F.G * NWAVES;
    for (int t = gw; t < M; t += NGW) {
        f32x4* xr = (f32x4*)((A).out + (size_t)t * D) + lane; f32x4 v[4];
#pragma unroll
        for (int j = 0; j < 4; ++j) v[j] = xr[64 * j];
#pragma unroll
        for (int k = 0; k < 4; ++k) { const int r = WSP(A,int,WS_POS)[t * 4 + k]; const v2u* yr = (const v2u*)(WSP(A,bf16,WS_Y) + (size_t)r * D) + lane;
#pragma unroll
            for (int j = 0; j < 4; ++j) { const v2u w = yr[64 * j]; v[j].x += __uint_as_float(w.x << 16); v[j].y += __uint_as_float(w.x & 0xffff0000u); v[j].z += __uint_as_float(w.y << 16); v[j].w += __uint_as_float(w.y & 0xffff0000u); } }
#pragma unroll
        for (int j = 0; j < 4; ++j) xr[64 * j] = v[j];
    }
}
__global__ void __launch_bounds__(NWAVES * 64, 2) mk_fwd(Args args) {
    extern __shared__ __attribute__((aligned(16))) unsigned char lds[];
    Frame F;
    F.lds = (LAS unsigned char*)lds;
    F.MISC = (volatile LAS unsigned*)(F.lds + MISC_OFF);
    F.tid = threadIdx.x; F.lane = F.tid & 63; F.wave = __builtin_amdgcn_readfirstlane(F.tid >> 6);
    F.G = gridDim.x; { const int bx = blockIdx.x; F.vcu = (F.G % 8 == 0) ? (bx % 8) * (F.G / 8) + bx / 8 : bx; }
    const Args& A = args;
    F.ctl = (gu32*)(args.ws + WS_CTL);
    for (int u = F.tid; u < (LDS_BYTES - LDSCTL_OFF) / 4; u += NWAVES * 64) ((LAS unsigned*)(F.lds + LDSCTL_OFF))[u] = 0u;
    __syncthreads();
    XcdBarrier bar; bar.bar = (unsigned*)(F.ctl + CW_BAR); bar.x = 0; bar.st = nullptr;
    if (!MK_PER_PHASE) bar = xcd_barrier_post((unsigned*)(F.ctl + CW_BAR), F.MISC + 8);
    const int lo = args.ph_lo, hi = args.ph_hi;
#ifndef PH_MASK
#define PH_MASK 0xFFF
#endif
#define IN(k) ((((PH_MASK) >> (k)) & 1) && lo <= (k) && (k) < hi)
#define SEAM(k) do { if (!MK_PER_PHASE && IN(k) && IN((k) + 1)) xcd_barrier(bar); } while (0)

    if (IN(PH_PRO)) { for (int rep = 0; rep < (1 + (((REP_MASK) >> PH_PRO) & 1)); ++rep) p0_prologue(F, A); SEAM(PH_PRO); }
    if (IN(PH_INPROJ)) for (int rep = 0; rep < REP(PH_INPROJ); ++rep) {
        pg8::Gemm g{WSP(A,bf16,WS_XN), WSP(A,bf16,WS_WIN), M, NPROJ, D}; pg8::StaticOrder S; S.init(M, NPROJ, F.G, (int)blockIdx.x);
        pg8::EpiPlain E{WSP(A,bf16,WS_PROJ), NPROJ};
        pg8::gemm_phase<pg8::EpiPlain, pg8::StaticOrder, true, true>(F.lds + RING_OFF, g, S, E);
        if (rep == REP(PH_INPROJ) - 1) SEAM(PH_INPROJ);
    }
    if (IN(PH_PREP)) { p2_prep(F, A); SEAM(PH_PREP); }
    if (IN(PH_SSD)) {
#if SSD_SIMPLE
        p3_ssd(F, A);
#else
        for (int rep = 0; rep < REP(PH_SSD); ++rep) p3_ssd_mfma(F, A);
#endif
        SEAM(PH_SSD); }
    if (IN(PH_ATTN)) { p4_norm(F, A);
#if ATTN_SIMPLE
        attn_simple(F, A);
#else
        for (int rep = 0; rep < REP(PH_ATTN); ++rep) attn_mfma(F, A);
#endif
        SEAM(PH_ATTN); }
    if (IN(PH_OPROJ)) for (int rep = 0; rep < REP(PH_OPROJ); ++rep) {
        { pg8::Gemm g{WSP(A,bf16,WS_AO), WSP(A,bf16,WS_WOA), M, D, D}; pg8::StaticOrder S; S.init(M, D, F.G, (int)blockIdx.x);
          pg8::EpiGate1 E{WSP(A,bf16,WS_PROJ) + PGATE, NPROJ, IN_GATEB(A), WSP(A,float,WS_MIXF)};
          pg8::gemm_phase<pg8::EpiGate1, pg8::StaticOrder, true, true>(F.lds + RING_OFF, g, S, E); }
        { pg8::Gemm g{WSP(A,bf16,WS_YG), WSP(A,bf16,WS_WOS), M, D, D_INNER}; pg8::StaticOrder S; S.init(M, D, F.G, (int)blockIdx.x);
          pg8::EpiGate2 E{WSP(A,bf16,WS_PROJ) + PGATE + D, NPROJ, IN_GATEB(A) + D, WSP(A,float,WS_MIXF), WSP(A,bf16,WS_MIX)};
          pg8::gemm_phase<pg8::EpiGate2, pg8::StaticOrder, true, true>(F.lds + RING_OFF, g, S, E); }
        if (rep == REP(PH_OPROJ) - 1) SEAM(PH_OPROJ);
    }
    if (IN(PH_WOUT)) for (int rep = 0; rep < REP(PH_WOUT); ++rep) {
        pg8::Gemm g{WSP(A,bf16,WS_MIX), WSP(A,bf16,WS_WOUT), M, D, D}; pg8::StaticOrder S; S.init(M, D, F.G, (int)blockIdx.x);
        pg8::EpiResid E{IN_X(A), (A).out};
        pg8::gemm_phase<pg8::EpiResid, pg8::StaticOrder, true, true>(F.lds + RING_OFF, g, S, E);
        if (rep == REP(PH_WOUT) - 1) SEAM(PH_WOUT);
    }
    if (IN(PH_ROUTE)) { p7_route(F, A); SEAM(PH_ROUTE); }
    if (IN(PH_GATHER)) { for (int rep = 0; rep < REP(PH_GATHER); ++rep) p8_gather(F, A); SEAM(PH_GATHER); }
    if (IN(PH_GU)) for (int rep = 0; rep < REP(PH_GU); ++rep) {
        const int NT = moe_tables(F, A);
        pg8::Gemm g{WSP(A,bf16,WS_XG), WSP(A,bf16,WS_WGU), NT * 256, 2048, D}; pg8::GroupedOrder S{8, NT, F.G, (int)blockIdx.x, (const LAS int*)(F.lds + TILEE_OFF)};
        pg8::EpiSwiglu E{WSP(A,bf16,WS_ACT), IN_BGU(A)};
        pg8::gemm_phase<pg8::EpiSwiglu, pg8::GroupedOrder, true, true>(F.lds + RING_OFF, g, S, E);
        if (rep == REP(PH_GU) - 1) SEAM(PH_GU);
    }
    if (IN(PH_DOWN)) for (int rep = 0; rep < REP(PH_DOWN); ++rep) {
        const int NT = moe_tables(F, A);
        pg8::Gemm g{WSP(A,bf16,WS_ACT), WSP(A,bf16,WS_WDN), NT * 256, 1024, D}; pg8::GroupedOrder S{4, NT, F.G, (int)blockIdx.x, (const LAS int*)(F.lds + TILEE_OFF)};
        pg8::EpiDown E{WSP(A,bf16,WS_Y), IN_BDN(A), WSP(A,float,WS_ROWW)};
        pg8::gemm_phase<pg8::EpiDown, pg8::GroupedOrder, true, true>(F.lds + RING_OFF, g, S, E);
        if (rep == REP(PH_DOWN) - 1) SEAM(PH_DOWN);
    }
    if (IN(PH_COMB)) { p11_combine(F, A); }
#undef IN
#undef SEAM
}

extern "C" void kernel_launch(void* const* d_in, const int* in_sizes, int n_in, void* d_out, int out_size, void* d_ws, size_t ws_size, hipStream_t stream) {
    static int grid = 0;
    if (grid == 0) {
        if (n_in != 22 || in_sizes[0] != M * D || out_size != M * D || ws_size < WS_END) { fprintf(stderr, "kernel_launch: unexpected shapes / workspace (n_in %d, in0 %d, out %d, ws %zu, need %zu); nothing launched\n", n_in, n_in > 0 ? in_sizes[0] : -1, out_size, ws_size, (size_t)WS_END); grid = -1; return; }
        int dev = 0, cus = 0, per_cu = 0;
        if (hipGetDevice(&dev) != hipSuccess || hipDeviceGetAttribute(&cus, hipDeviceAttributeMultiprocessorCount, dev) != hipSuccess) { fprintf(stderr, "kernel_launch: device query failed\n"); grid = -1; return; }
        if (hipFuncSetAttribute((const void*)mk_fwd, hipFuncAttributeMaxDynamicSharedMemorySize, LDS_BYTES) != hipSuccess) { fprintf(stderr, "kernel_launch: hipFuncSetAttribute failed\n"); grid = -1; return; }
        if (hipOccupancyMaxActiveBlocksPerMultiprocessor(&per_cu, (const void*)mk_fwd, NWAVES * 64, LDS_BYTES) != hipSuccess || per_cu < 1) fprintf(stderr, "kernel_launch: note: occupancy query reports %d blocks per CU\n", per_cu);
        (void)hipGetLastError();
        grid = cus;
    }
    if (grid < 0) return;
    if (hipMemsetAsync((char*)d_ws + WS_CTL, 0, CTL_ZERO_BYTES, stream) != hipSuccess) { fprintf(stderr, "kernel_launch: memset failed\n"); return; }
    Args a{};
    for (int i = 0; i < 22; ++i) a.in[i] = (const float*)d_in[i];
    a.out = (float*)d_out; a.ws = (unsigned char*)d_ws;
#if MK_PER_PHASE
    for (int p = 0; p < N_PHASES; ++p) { a.ph_lo = p; a.ph_hi = p + 1; hipLaunchKernelGGL(mk_fwd, dim3(grid), dim3(NWAVES * 64), LDS_BYTES, stream, a); }
#else
    a.ph_lo = 0; a.ph_hi = N_PHASES;
    hipLaunchKernelGGL(mk_fwd, dim3(grid), dim3(NWAVES * 64), LDS_BYTES, stream, a);
#endif
    const hipError_t le = hipPeekAtLastError();
    if (le != hipSuccess) fprintf(stderr, "kernel_launch: launch failed: %s\n", hipGetErrorName(le));
}
```

```cpp
#include <hip/hip_runtime.h>
#include <cstdio>
#include <cstdint>
namespace pg8 {
#define PG8_LAS __attribute__((address_space(3)))
typedef unsigned short bf16_t;
typedef short bf16x8 __attribute__((ext_vector_type(8)));
typedef float f32x4 __attribute__((ext_vector_type(4)));
typedef unsigned u32x4 __attribute__((ext_vector_type(4)));
constexpr int BM = 256, BK = 64, HALF = 128, HTB = HALF * BK * 2  , STAGE_BYTES = 8 * HTB, NXCD = 8, WGM = 8;

__host__ __device__ __forceinline__ int lds_byte(int r, int c) { const int st = (r >> 4) * 2 + (c >> 5), rr = r & 15, cc = c & 31, ob = rr * 64 + cc * 2; return st * 1024 + (ob ^ (((ob >> 9) & 1) << 5)); }
__host__ __device__ __forceinline__ void stage_rc(int b, int& R, int& C) { const int st = b / 1024, sb = b % 1024, swz = sb ^ (((sb >> 9) & 1) << 5); R = (st >> 1) * 16 + swz / 64; C = (st & 1) * 32 + (swz % 64) / 2; }
__host__ __device__ __forceinline__ int perm32(int rho) { const int n = rho >> 4, i = rho & 15; return 8 * (i >> 2) + 4 * n + (i & 3); }

struct Unit { int pm, pn; };
struct Gemm { const bf16_t* A; const bf16_t* Bt; int M, N, K; };

struct StaticOrder {
    int nM, nN, nwg, G, c;
    __host__ __device__ void init(int M, int N, int G_, int c_) { nM = M / BM; nN = N / BM; nwg = nM * nN; G = G_; c = c_; }
    __host__ __device__ bool next(int i, Unit& u) const {
        const long L = (long)i * G + c; if (L >= nwg) return false;
        int wgid = (int)L; { const int q = nwg / NXCD, r = nwg % NXCD, xcd = wgid % NXCD, off = wgid / NXCD; wgid = (xcd < r ? xcd * (q + 1) : r * (q + 1) + (xcd - r) * q) + off; }
        const int nig = WGM * nN, gid = wgid / nig, fm = gid * WGM, gsz = (nM - fm) < WGM ? (nM - fm) : WGM;
        u.pm = fm + ((wgid % nig) % gsz); u.pn = (wgid % nig) / gsz; return true;
    }
    __device__ __forceinline__ void a_ready(const Unit&) const {}
    __device__ __forceinline__ void done(const Unit&) const {}
};

struct GroupedOrder {
    int nN, NT, G, c; const PG8_LAS int* tile_e;
    __device__ __forceinline__ bool next(int i, Unit& u) const {
        const long L = (long)i * G + c; const int nwg = NT * nN; if (L >= nwg) return false;
        int wgid = (int)L; { const int q = nwg / NXCD, r = nwg % NXCD, xcd = wgid % NXCD, off = wgid / NXCD; wgid = (xcd < r ? xcd * (q + 1) : r * (q + 1) + (xcd - r) * q) + off; }
        const int rt = wgid / nN, pl = wgid % nN;
        u.pm = rt; u.pn = tile_e[rt] * nN + pl; return true;
    }
    __device__ __forceinline__ void a_ready(const Unit&) const {}
    __device__ __forceinline__ void done(const Unit&) const {}
};

__device__ __forceinline__ unsigned cvt_pk_bf16(float lo, float hi) { unsigned r; asm volatile("v_cvt_pk_bf16_f32 %0, %1, %2" : "=v"(r) : "v"(lo), "v"(hi)); return r; }
__device__ __forceinline__ float sigm(float x) { return __builtin_amdgcn_rcpf(1.f + __builtin_amdgcn_exp2f(-1.44269504f * x)); }
__device__ __forceinline__ void unpack8(const u32x4 w, float (&f)[8]) {
#pragma unroll
    for (int i = 0; i < 4; ++i) { f[2 * i] = __uint_as_float(w[i] << 16); f[2 * i + 1] = __uint_as_float(w[i] & 0xffff0000u); }
}
struct EpiPlain {
    static constexpr bool PERM = true, AFTER_DRAIN = false; bf16_t* O; int ldc;
    __device__ __forceinline__ void operator()(const f32x4 (&acc)[2][2][4][2], const Unit& u, int wr, int wc, int fr, int fq) const {
        const int row0 = u.pm * BM + wr * 64 + fr, col0 = u.pn * BM + wc * 32 + 8 * fq;
#pragma unroll
        for (int ai = 0; ai < 2; ++ai)
#pragma unroll
            for (int m = 0; m < 4; ++m) { bf16_t* rowp = O + (size_t)(row0 + ai * HALF + m * 16) * ldc + col0;
#pragma unroll
                for (int bj = 0; bj < 2; ++bj) { const f32x4 v0 = acc[ai][bj][m][0], v1 = acc[ai][bj][m][1]; u32x4 w;
                    w.x = cvt_pk_bf16(v0[0], v0[1]); w.y = cvt_pk_bf16(v0[2], v0[3]); w.z = cvt_pk_bf16(v1[0], v1[1]); w.w = cvt_pk_bf16(v1[2], v1[3]);
                    *(u32x4*)(rowp + bj * HALF) = w; } }
    }
};
struct EpiGate1 {
    static constexpr bool PERM = true, AFTER_DRAIN = false; const bf16_t* Gp; int ldg; const float* gb; float* MIXF;
    __device__ __forceinline__ void operator()(const f32x4 (&acc)[2][2][4][2], const Unit& u, int wr, int wc, int fr, int fq) const {
        const int row0 = u.pm * BM + wr * 64 + fr, col0 = u.pn * BM + wc * 32 + 8 * fq;
#pragma unroll
        for (int ai = 0; ai < 2; ++ai)
#pragma unroll
            for (int m = 0; m < 4; ++m) { const size_t row = (size_t)(row0 + ai * HALF + m * 16);
#pragma unroll
                for (int bj = 0; bj < 2; ++bj) { const int c = col0 + bj * HALF; float g[8]; unpack8(*(const u32x4*)(Gp + row * ldg + c), g);
                    const f32x4 b0 = *(const f32x4*)(gb + c), b1 = *(const f32x4*)(gb + c + 4); const f32x4 v0 = acc[ai][bj][m][0], v1 = acc[ai][bj][m][1]; f32x4 o0, o1;
#pragma unroll
                    for (int i = 0; i < 4; ++i) { o0[i] = sigm(g[i] + b0[i]) * v0[i]; o1[i] = sigm(g[4 + i] + b1[i]) * v1[i]; }
                    *(f32x4*)(MIXF + row * 1024 + c) = o0; *(f32x4*)(MIXF + row * 1024 + c + 4) = o1; } }
    }
};
struct EpiGate2 {
    static constexpr bool PERM = true, AFTER_DRAIN = false; const bf16_t* Gp; int ldg; const float* gb; const float* MIXF; bf16_t* MIX;
    __device__ __forceinline__ void operator()(const f32x4 (&acc)[2][2][4][2], const Unit& u, int wr, int wc, int fr, int fq) const {
        const int row0 = u.pm * BM + wr * 64 + fr, col0 = u.pn * BM + wc * 32 + 8 * fq;
#pragma unroll
        for (int ai = 0; ai < 2; ++ai)
#pragma unroll
            for (int m = 0; m < 4; ++m) { const size_t row = (size_t)(row0 + ai * HALF + m * 16);
#pragma unroll
                for (int bj = 0; bj < 2; ++bj) { const int c = col0 + bj * HALF; float g[8]; unpack8(*(const u32x4*)(Gp + row * ldg + c), g);
                    const f32x4 b0 = *(const f32x4*)(gb + c), b1 = *(const f32x4*)(gb + c + 4); const f32x4 v0 = acc[ai][bj][m][0], v1 = acc[ai][bj][m][1];
                    const f32x4 p0 = *(const f32x4*)(MIXF + row * 1024 + c), p1 = *(const f32x4*)(MIXF + row * 1024 + c + 4); f32x4 o0, o1;
#pragma unroll
                    for (int i = 0; i < 4; ++i) { o0[i] = p0[i] + sigm(g[i] + b0[i]) * v0[i]; o1[i] = p1[i] + sigm(g[4 + i] + b1[i]) * v1[i]; }
                    u32x4 w; w.x = cvt_pk_bf16(o0[0], o0[1]); w.y = cvt_pk_bf16(o0[2], o0[3]); w.z = cvt_pk_bf16(o1[0], o1[1]); w.w = cvt_pk_bf16(o1[2], o1[3]);
                    *(u32x4*)(MIX + row * 1024 + c) = w; } }
    }
};
struct EpiResid {
    static constexpr bool PERM = true, AFTER_DRAIN = false; const float* base; float* out;
    __device__ __forceinline__ void operator()(const f32x4 (&acc)[2][2][4][2], const Unit& u, int wr, int wc, int fr, int fq) const {
        const int row0 = u.pm * BM + wr * 64 + fr, col0 = u.pn * BM + wc * 32 + 8 * fq;
#pragma unroll
        for (int ai = 0; ai < 2; ++ai)
#pragma unroll
            for (int m = 0; m < 4; ++m) { const size_t row = (size_t)(row0 + ai * HALF + m * 16);
#pragma unroll
                for (int bj = 0; bj < 2; ++bj) { const size_t o = row * 1024 + col0 + bj * HALF;
                    const f32x4 p0 = *(const f32x4*)(base + o), p1 = *(const f32x4*)(base + o + 4);
                    *(f32x4*)(out + o) = p0 + acc[ai][bj][m][0]; *(f32x4*)(out + o + 4) = p1 + acc[ai][bj][m][1]; } }
    }
};
struct EpiSwiglu {
    static constexpr bool PERM = true, AFTER_DRAIN = false; bf16_t* ACT; const float* bgu;
    __device__ __forceinline__ void operator()(const f32x4 (&acc)[2][2][4][2], const Unit& u, int wr, int wc, int fr, int fq) const {
        const int e = u.pn >> 3, pl = u.pn & 7, j0 = 128 * pl + wc * 32 + 8 * fq; const int row0 = u.pm * BM + wr * 64 + fr;
        float bg[8], bu[8];
        { const float* bs = bgu + (size_t)e * 2048 + 2 * j0;
#pragma unroll
          for (int q = 0; q < 4; ++q) { const f32x4 t = *(const f32x4*)(bs + 4 * q); bg[2 * q] = t[0]; bu[2 * q] = t[1]; bg[2 * q + 1] = t[2]; bu[2 * q + 1] = t[3]; } }
#pragma unroll
        for (int ai = 0; ai < 2; ++ai)
#pragma unroll
            for (int m = 0; m < 4; ++m) { const size_t row = (size_t)(row0 + ai * HALF + m * 16); float a[8];
#pragma unroll
                for (int i = 0; i < 8; ++i) { const float gr = (i < 4 ? acc[ai][0][m][0][i & 3] : acc[ai][0][m][1][i & 3]) + bg[i], ur = (i < 4 ? acc[ai][1][m][0][i & 3] : acc[ai][1][m][1][i & 3]) + bu[i];
                    const float g = fminf(gr, 7.0f), uu = fminf(fmaxf(ur, -7.0f), 7.0f); a[i] = (uu + 1.0f) * (g * sigm(1.702f * g)); }
                u32x4 w; w.x = cvt_pk_bf16(a[0], a[1]); w.y = cvt_pk_bf16(a[2], a[3]); w.z = cvt_pk_bf16(a[4], a[5]); w.w = cvt_pk_bf16(a[6], a[7]);
                *(u32x4*)(ACT + row * 1024 + j0) = w; }
    }
};
struct EpiDown {
    static constexpr bool PERM = true, AFTER_DRAIN = false; bf16_t* Y; const float* bd; const float* roww;
    __device__ __forceinline__ void operator()(const f32x4 (&acc)[2][2][4][2], const Unit& u, int wr, int wc, int fr, int fq) const {
        const int e = u.pn >> 2, pl = u.pn & 3, col0 = pl * BM + wc * 32 + 8 * fq; const int row0 = u.pm * BM + wr * 64 + fr;
#pragma unroll
        for (int ai = 0; ai < 2; ++ai)
#pragma unroll
            for (int m = 0; m < 4; ++m) { const size_t row = (size_t)(row0 + ai * HALF + m * 16); const float rw = roww[row];
#pragma unroll
                for (int bj = 0; bj < 2; ++bj) { const int c = col0 + bj * HALF; const f32x4 b0 = *(const f32x4*)(bd + (size_t)e * 1024 + c), b1 = *(const f32x4*)(bd + (size_t)e * 1024 + c + 4);
                    const f32x4 v0 = (acc[ai][bj][m][0] + b0) * rw, v1 = (acc[ai][bj][m][1] + b1) * rw; u32x4 w;
                    w.x = cvt_pk_bf16(v0[0], v0[1]); w.y = cvt_pk_bf16(v0[2], v0[3]); w.z = cvt_pk_bf16(v1[0], v1[1]); w.w = cvt_pk_bf16(v1[2], v1[3]);
                    *(u32x4*)(Y + row * 1024 + c) = w; } }
    }
};
template <class Epi, class Sched, bool ALIGN_EPI = false, bool SP2 = false>
__device__ __forceinline__ void gemm_phase(PG8_LAS unsigned char* lds, const Gemm g, const Sched& S, const Epi& E) {
    const int tid = threadIdx.x, wid = __builtin_amdgcn_readfirstlane(tid >> 6), lane = tid & 63, wr = wid >> 2, wc = wid & 3, fr = lane & 15, fq = lane >> 4;
    const int K = g.K, nt = K / BK;
    unsigned voffA[2], voffB[2];
#pragma unroll
    for (int i = 0; i < 2; ++i) { int R, C; stage_rc(tid * 16 + i * 8192, R, C); const int Rb = Epi::PERM ? ((R & ~31) + perm32(R & 31)) : R;
        voffA[i] = (unsigned)(R * K + C) * 2u; voffB[i] = (unsigned)(Rb * K + C) * 2u; }
    const size_t kstep = (size_t)(BK * 2);
    const size_t hstep = (size_t)HALF * K * 2;
    const size_t tstep = 2 * hstep;
    const unsigned ldsw = (unsigned)wid * 1024u;
    const int aoff = lds_byte(wr * 64 + fr, fq * 8), boff = lds_byte(wc * 32 + fr, fq * 8);
#define PG8_SA(b, h) (((b) * 2 + (h)) * HTB)
#define PG8_SB(b, h) ((4 + (b) * 2 + (h)) * HTB)
#define PG8_STAGE(bufoff, gbase, voff) do { _Pragma("unroll") for (int _i = 0; _i < 2; ++_i) \
        __builtin_amdgcn_global_load_lds((const unsigned*)((const char*)(gbase) + (voff)[_i]), (PG8_LAS unsigned*)(lds + (bufoff) + ldsw + _i * 8192), 16, 0, 0); } while (0)
#define PG8_LDA(dst, b, h) do { _Pragma("unroll") for (int m = 0; m < 4; ++m) _Pragma("unroll") for (int k = 0; k < 2; ++k) dst[m][k] = *(const PG8_LAS bf16x8*)(lds + PG8_SA(b, h) + aoff + m * 2048 + k * 1024); } while (0)
#define PG8_LDB(dst, b, h) do { _Pragma("unroll") for (int n = 0; n < 2; ++n) _Pragma("unroll") for (int k = 0; k < 2; ++k) dst[n][k] = *(const PG8_LAS bf16x8*)(lds + PG8_SB(b, h) + boff + n * 2048 + k * 1024); } while (0)
#define PG8_MMA(ai, bj, At, Bt) do { __builtin_amdgcn_s_setprio(1); _Pragma("unroll") for (int m = 0; m < 4; ++m) _Pragma("unroll") for (int n = 0; n < 2; ++n) _Pragma("unroll") for (int k = 0; k < 2; ++k) \
        acc[ai][bj][m][n] = __builtin_amdgcn_mfma_f32_16x16x32_bf16(Bt[n][k], At[m][k], acc[ai][bj][m][n], 0, 0, 0); __builtin_amdgcn_s_setprio(0); } while (0)
#define PG8_WAIT_V(n) asm volatile("s_waitcnt vmcnt(" #n ")" ::: "memory")
#define PG8_WAIT_L(n) asm volatile("s_waitcnt lgkmcnt(" #n ")" ::: "memory")
#define PG8_BAR __builtin_amdgcn_s_barrier()
#define PG8_SCHED __builtin_amdgcn_sched_barrier(0)
    Unit cur, nxt; int ui = 0;
    if (!S.next(0, cur)) return;
    f32x4 acc[2][2][4][2];
#pragma unroll
    for (int a = 0; a < 2; ++a)
#pragma unroll
        for (int b = 0; b < 2; ++b)
#pragma unroll
            for (int m = 0; m < 4; ++m)
#pragma unroll
                for (int n = 0; n < 2; ++n) acc[a][b][m][n] = (f32x4){0.f, 0.f, 0.f, 0.f};
    bf16x8 At[4][2], B0[2][2], B1[2][2];
    const char* cA = (const char*)g.A + (size_t)cur.pm * tstep; const char* cB = (const char*)g.Bt + (size_t)cur.pn * tstep;
    S.a_ready(cur);
    if constexpr (SP2) {
        PG8_STAGE(PG8_SB(0, 0), cB, voffB); PG8_STAGE(PG8_SB(0, 1), cB + hstep, voffB); PG8_STAGE(PG8_SA(0, 0), cA, voffA); PG8_STAGE(PG8_SA(0, 1), cA + hstep, voffA);
        if (wr == 1) PG8_BAR;
        PG8_WAIT_V(2); PG8_BAR;
        PG8_STAGE(PG8_SB(1, 0), cB + kstep, voffB); PG8_STAGE(PG8_SA(1, 0), cA + kstep, voffA); PG8_STAGE(PG8_SB(1, 1), cB + hstep + kstep, voffB);
        PG8_WAIT_V(6); PG8_BAR;
    } else {
        PG8_STAGE(PG8_SB(0, 0), cB, voffB); PG8_STAGE(PG8_SA(0, 0), cA, voffA); PG8_STAGE(PG8_SB(0, 1), cB + hstep, voffB); PG8_STAGE(PG8_SA(0, 1), cA + hstep, voffA);
        if (wr == 1) PG8_BAR;
        PG8_WAIT_V(4); PG8_BAR;
        PG8_STAGE(PG8_SB(1, 0), cB + kstep, voffB); PG8_STAGE(PG8_SA(1, 0), cA + kstep, voffA); PG8_STAGE(PG8_SB(1, 1), cB + hstep + kstep, voffB);
        PG8_WAIT_V(6); PG8_BAR;
    }
    for (;;) {
        const bool has_next = S.next(ui + 1, nxt);
        const char* nA = has_next ? (const char*)g.A + (size_t)nxt.pm * tstep : cA; const char* nB = has_next ? (const char*)g.Bt + (size_t)nxt.pn * tstep : cB;
        for (int t = 0; t < nt; t += 2) {
            const bool last = (t == nt - 2);
            const char* a1 = cA + (size_t)(t + 1) * kstep;
            const char* a2 = last ? nA : cA + (size_t)(t + 2) * kstep; const char* b2 = last ? nB : cB + (size_t)(t + 2) * kstep;
            const char* a3 = a2 + kstep; const char* b3 = b2 + kstep;
            if (last && has_next) S.a_ready(nxt);
            if constexpr (SP2) {
            PG8_LDB(B0, 0, 0); PG8_LDB(B1, 0, 1); PG8_SCHED; PG8_LDA(At, 0, 0); PG8_STAGE(PG8_SA(1, 1), a1 + hstep, voffA);
            PG8_WAIT_V(8); PG8_WAIT_L(0); PG8_BAR; PG8_MMA(0, 0, At, B0); PG8_MMA(0, 1, At, B1); PG8_BAR; PG8_SCHED;
            PG8_LDA(At, 0, 1); PG8_STAGE(PG8_SB(0, 0), b2, voffB); PG8_STAGE(PG8_SB(0, 1), b2 + hstep, voffB); PG8_STAGE(PG8_SA(0, 0), a2, voffA);
            PG8_WAIT_V(8); PG8_WAIT_L(0); PG8_BAR; PG8_MMA(1, 0, At, B0); PG8_MMA(1, 1, At, B1); PG8_BAR; PG8_SCHED;
            PG8_LDB(B0, 1, 0); PG8_LDB(B1, 1, 1); PG8_SCHED; PG8_LDA(At, 1, 0); PG8_STAGE(PG8_SA(0, 1), a2 + hstep, voffA);
            PG8_WAIT_V(8); PG8_WAIT_L(0); PG8_BAR; PG8_MMA(0, 0, At, B0); PG8_MMA(0, 1, At, B1); PG8_BAR; PG8_SCHED;
            PG8_LDA(At, 1, 1); PG8_STAGE(PG8_SB(1, 0), b3, voffB); PG8_STAGE(PG8_SB(1, 1), b3 + hstep, voffB); PG8_STAGE(PG8_SA(1, 0), a3, voffA);
            PG8_WAIT_V(8); PG8_WAIT_L(0); PG8_BAR; PG8_MMA(1, 0, At, B0); PG8_MMA(1, 1, At, B1); PG8_BAR; PG8_SCHED;
            } else {
            PG8_LDB(B0, 0, 0); PG8_SCHED; PG8_LDA(At, 0, 0); PG8_STAGE(PG8_SA(1, 1), a1 + hstep, voffA);
            PG8_WAIT_L(8); PG8_BAR; PG8_WAIT_L(0); PG8_MMA(0, 0, At, B0); PG8_BAR; PG8_SCHED;
            PG8_LDB(B1, 0, 1); PG8_STAGE(PG8_SB(0, 0), b2, voffB);
            PG8_BAR; PG8_WAIT_L(0); PG8_MMA(0, 1, At, B1); PG8_BAR;
            PG8_LDA(At, 0, 1); PG8_STAGE(PG8_SA(0, 0), a2, voffA);
            PG8_BAR; PG8_WAIT_L(0); PG8_MMA(1, 0, At, B0); PG8_BAR; PG8_SCHED;
            PG8_STAGE(PG8_SB(0, 1), b2 + hstep, voffB);
            PG8_WAIT_V(6); PG8_BAR; PG8_MMA(1, 1, At, B1); PG8_BAR;
            PG8_LDB(B0, 1, 0); PG8_SCHED; PG8_LDA(At, 1, 0); PG8_STAGE(PG8_SA(0, 1), a2 + hstep, voffA);
            PG8_WAIT_L(8); PG8_BAR; PG8_WAIT_L(0); PG8_MMA(0, 0, At, B0); PG8_BAR; PG8_SCHED;
            PG8_LDB(B1, 1, 1); PG8_STAGE(PG8_SB(1, 0), b3, voffB);
            PG8_BAR; PG8_WAIT_L(0); PG8_MMA(0, 1, At, B1); PG8_BAR;
            PG8_LDA(At, 1, 1); PG8_STAGE(PG8_SA(1, 0), a3, voffA);
            PG8_BAR; PG8_WAIT_L(0); PG8_MMA(1, 0, At, B0); PG8_BAR; PG8_SCHED;
            PG8_STAGE(PG8_SB(1, 1), b3 + hstep, voffB);
            PG8_WAIT_V(6); PG8_BAR; PG8_MMA(1, 1, At, B1); PG8_BAR;
            }
        }
        if constexpr (ALIGN_EPI) { if (wr == 0) PG8_BAR; }
        if constexpr (!Epi::AFTER_DRAIN) { E(acc, cur, wr, wc, fr, fq); S.done(cur); }
        if (!has_next) break;
#pragma unroll
        for (int a = 0; a < 2; ++a)
#pragma unroll
            for (int b = 0; b < 2; ++b)
#pragma unroll
                for (int m = 0; m < 4; ++m)
#pragma unroll
                    for (int n = 0; n < 2; ++n) acc[a][b][m][n] = (f32x4){0.f, 0.f, 0.f, 0.f};
        cur = nxt; cA = nA; cB = nB; ++ui;
        if constexpr (ALIGN_EPI) { if (wr == 1) PG8_BAR; }
    }
    PG8_WAIT_V(0);
    if constexpr (!ALIGN_EPI) { if (wr == 0) PG8_BAR; }
    PG8_BAR;
    if constexpr (Epi::AFTER_DRAIN) { E.fused(acc, cur, wr, wc, fr, fq, lds, wid, lane); S.done(cur); }
#undef PG8_SA
#undef PG8_SB
#undef PG8_STAGE
#undef PG8_LDA
#undef PG8_LDB
#undef PG8_MMA
#undef PG8_WAIT_V
#undef PG8_WAIT_L
#undef PG8_BAR
#undef PG8_SCHED
}
}
constexpr int NWAVES = 8;
#ifndef REP_MASK
#define REP_MASK 0
#endif
#define REP(k) (1 + (((REP_MASK) >> (k)) & 1))
enum { PH_PRO = 0, PH_INPROJ, PH_PREP, PH_SSD, PH_ATTN, PH_OPROJ, PH_WOUT, PH_ROUTE, PH_GATHER, PH_GU, PH_DOWN, PH_COMB, N_PHASES };
#ifndef SSD_SIMPLE
#define SSD_SIMPLE 0
#endif
#ifndef ATTN_SIMPLE
#define ATTN_SIMPLE 0
#endif
#ifndef MK_PER_PHASE
#define MK_PER_PHASE 0
#endif
constexpr int BATCH = 8, SEQ = 2048, D = 1024, M = BATCH * SEQ;
constexpr int NH = 16, HD = 64, MBLK = 256, NBLK = SEQ / MBLK, MOBA_TOPK = 3;
constexpr int D_INNER = 2048, SSD_H = 32, NGRP = 4, DSTATE = 128, D_XBC = 3072, CONVK = 4;
constexpr int N_IN = 10272, NPROJ = 10240;
constexpr int PQ = 0, PK = 1024, PV = 2048, PZ = 3072, PXBC = 5120, PGATE = 8192;
constexpr int COL_DT = 8192;
constexpr int NEXP = 32, TOPK = 4, EXPCAP = 16384, MAXROWS = M * TOPK + NEXP * 256, MAXTILES = MAXROWS / 256;
constexpr float NORM_EPS = 1e-6f;
constexpr float QSCALE = 0.125f * 1.4426950408889634f;

constexpr size_t MiB = 1u << 20;
constexpr size_t WS_CTL = 0, CTL_ZERO_BYTES = 2 * MiB;
constexpr size_t WS_KM = 1 * MiB;
constexpr size_t WS_WIN = 2 * MiB, WS_WOA = 22 * MiB, WS_WOS = 24 * MiB, WS_WOUT = 28 * MiB, WS_WGU = 30 * MiB, WS_WDN = 158 * MiB;
constexpr size_t WS_WDT = 222 * MiB, WS_WRT = 222 * MiB + 512 * 1024;
constexpr size_t WS_WDH = 222 * MiB, WS_WDL = 222 * MiB + 64 * 1024, WS_WRH = 222 * MiB + 128 * 1024, WS_WRL = 222 * MiB + 192 * 1024;
constexpr size_t WS_XN = 223 * MiB, WS_DT = 255 * MiB, WS_SSQ = 904 * MiB, WS_YG = 259 * MiB, WS_AO = 323 * MiB, WS_MIXF = 355 * MiB, WS_MIX = 419 * MiB, WS_H2 = 451 * MiB;
constexpr size_t WS_TOKL = 483 * MiB, WS_GATEW = 485 * MiB, WS_POS = 486 * MiB, WS_ROWW = 487 * MiB;
constexpr size_t WS_PROJ = 488 * MiB, WS_XC = 808 * MiB, WS_H2LO = 908 * MiB, WS_END = 940 * MiB;
constexpr size_t WS_XG = WS_PROJ, WS_ACT = WS_PROJ + 144 * MiB, WS_Y = WS_XG;
static_assert(WS_ACT + (size_t)MAXROWS * 1024 * 2 <= WS_END, "MoE overlay");
constexpr int CW_TMO = 0, CW_CODE = 1, CW_BAR = 4096, CW_CNT = 16384;

constexpr int RING_OFF = 0, RING_BYTES = 131072;
constexpr int LDSCTL_OFF = RING_BYTES, MISC_OFF = LDSCTL_OFF + 320, TILEE_OFF = LDSCTL_OFF + 1024, ROWB_OFF = LDSCTL_OFF + 2560, CNTL_OFF = LDSCTL_OFF + 2816;
constexpr int LDS_BYTES = 147456;

#define GAS __attribute__((address_space(1)))
#define LAS __attribute__((address_space(3)))
typedef unsigned short bf16;
typedef unsigned v4u __attribute__((ext_vector_type(4)));
typedef unsigned v2u __attribute__((ext_vector_type(2)));
typedef float f32x4 __attribute__((ext_vector_type(4)));
typedef GAS unsigned gu32;
#define RLX_AGENT __ATOMIC_RELAXED, __HIP_MEMORY_SCOPE_AGENT
#define LDS_WAIT() asm volatile("s_waitcnt lgkmcnt(0)" ::: "memory")
#define VM_WAIT() asm volatile("s_waitcnt vmcnt(0)" ::: "memory")
__device__ __forceinline__ unsigned f2bf(float f) { unsigned u = __builtin_bit_cast(unsigned, f); return (u + 0x7fffu + ((u >> 16) & 1u)) >> 16; }
__device__ __forceinline__ unsigned pk2(float lo, float hi) { return f2bf(lo) | (f2bf(hi) << 16); }
__device__ __forceinline__ float bf2f(bf16 b) { return __uint_as_float((unsigned)b << 16); }
__device__ __forceinline__ void unpk8(const v4u w, float (&f)[8]) {
#pragma unroll
    for (int i = 0; i < 4; ++i) { f[2 * i] = __uint_as_float(w[i] << 16); f[2 * i + 1] = __uint_as_float(w[i] & 0xffff0000u); }
}
__device__ __forceinline__ v4u pack8(const float (&f)[8]) { v4u w; w.x = pk2(f[0], f[1]); w.y = pk2(f[2], f[3]); w.z = pk2(f[4], f[5]); w.w = pk2(f[6], f[7]); return w; }
__device__ __forceinline__ float wave_sum(float v) {
#pragma unroll
    for (int o = 1; o < 64; o <<= 1) v += __shfl_xor(v, o);
    return v;
}
__device__ __forceinline__ float wave_max(float v) {
#pragma unroll
    for (int o = 1; o < 64; o <<= 1) v = fmaxf(v, __shfl_xor(v, o));
    return v;
}
__device__ __forceinline__ float silu_f(float x) { return x / (1.f + __expf(-x)); }
#define XB_TMO      128
#define XB_XCNT(j)  (256  + 64 * (j))
#define XB_XSUB(j)  (1280 + 64 * (j))
#define XB_XGEN(j)  (2304 + 64 * (j))
#define XB_TOP      3328
#define XB_TOPGEN   3392
#define XCD_BAR_WORDS 3456
#define XB_SPIN_CAP (1u << 18)

__device__ __forceinline__ unsigned xb_ld(unsigned* p)              { return __hip_atomic_load(p, __ATOMIC_RELAXED, __HIP_MEMORY_SCOPE_AGENT); }
__device__ __forceinline__ unsigned xb_add(unsigned* p, unsigned v) { return __hip_atomic_fetch_add(p, v, __ATOMIC_RELAXED, __HIP_MEMORY_SCOPE_AGENT); }
__device__ __forceinline__ unsigned xb_xcc_id() { return (unsigned)__builtin_amdgcn_s_getreg((3 << 11) | 20) & 0xFu; }
#define XB_SPIN(cond, bar) do { unsigned _sp = 0; while (cond) { __builtin_amdgcn_s_sleep(1); \
    if ((++_sp & 255u) == 0u) { if (xb_ld(&(bar)[XB_TMO])) break; if (_sp > XB_SPIN_CAP) { atomicAdd(&(bar)[XB_TMO], 1u); break; } } } } while (0)

struct XcdBarrier {
    unsigned* bar; unsigned x;
    volatile LAS unsigned* st;
};

__device__ __forceinline__ XcdBarrier xcd_barrier_post(unsigned* bar, volatile LAS unsigned* st) {
    XcdBarrier b; b.bar = bar; b.x = xb_xcc_id(); b.st = st;
    if (threadIdx.x == 0) (void)xb_add(&bar[XB_XCNT(b.x)], 1u);
    return b;
}
__device__ __forceinline__ void xcd_barrier_complete(unsigned* bar, unsigned x, unsigned& nloc, unsigned& nx) {
    const unsigned G = gridDim.x * gridDim.y * gridDim.z;
    unsigned sum, cnt, mine, sp = 0u;
    for (;;) {
        sum = 0u; cnt = 0u; mine = 0u;
#pragma unroll
        for (unsigned j = 0; j < 16; ++j) { const unsigned c = xb_ld(&bar[XB_XCNT(j)]); sum += c; cnt += (c > 0u) ? 1u : 0u; mine = (j == x) ? c : mine; }
        if (sum == G) break;
        __builtin_amdgcn_s_sleep(1);
        if ((++sp & 255u) == 0u) { if (xb_ld(&bar[XB_TMO])) break; if (sp > XB_SPIN_CAP) { atomicAdd(&bar[XB_TMO], 1u); break; } }
    }
    nloc = mine > 0u ? mine : 1u; nx = cnt > 0u ? cnt : 1u;
}

__device__ __forceinline__ void xcd_barrier(const XcdBarrier& b) {
    asm volatile("s_waitcnt vmcnt(0)" ::: "memory");
    __syncthreads();
    if (threadIdx.x == 0) {
        unsigned* bar = b.bar;
        __builtin_amdgcn_s_waitcnt(0);
        unsigned nloc = b.st[0], nx = b.st[1];
        if (nloc == 0u) { xcd_barrier_complete(bar, b.x, nloc, nx); b.st[0] = nloc; b.st[1] = nx; }
        const unsigned old = xb_add(&bar[XB_XSUB(b.x)], 1u);
        const unsigned gen = old / nloc;
        if (old + 1u == (gen + 1u) * nloc) {
            __builtin_amdgcn_fence(__ATOMIC_RELEASE, "agent");
            asm volatile("s_waitcnt vmcnt(0)" ::: "memory");
            const unsigned og = xb_add(&bar[XB_TOP], 1u);
            const unsigned tg = og / nx;
            if (og + 1u == (tg + 1u) * nx) xb_add(&bar[XB_TOPGEN], 1u);
            else XB_SPIN(xb_ld(&bar[XB_TOPGEN]) == tg, bar);
            __builtin_amdgcn_fence(__ATOMIC_ACQUIRE, "agent");
            xb_add(&bar[XB_XGEN(b.x)], 1u);
            asm volatile("s_waitcnt vmcnt(0)" ::: "memory");
        } else {
            XB_SPIN(xb_ld(&bar[XB_XGEN(b.x)]) == gen, bar);
            __builtin_amdgcn_fence(__ATOMIC_ACQUIRE, "agent");
            asm volatile("s_waitcnt vmcnt(0)" ::: "memory");
        }
    }
    __syncthreads();
}
struct Args { const float* in[22]; float* out; unsigned char* ws; int ph_lo, ph_hi; };
struct Frame {
    LAS unsigned char* lds;
    volatile LAS unsigned* MISC;
    gu32* ctl;
    int tid, lane, wave, vcu, G;
};
#define IN_X(A)      ((A).in[0])
#define IN_LN1W(A)   ((A).in[1])
#define IN_WIN(A)    ((A).in[2])
#define IN_GATEB(A)  ((A).in[3])
#define IN_QNW(A)    ((A).in[4])
#define IN_KNW(A)    ((A).in[5])
#define IN_CONVW(A)  ((A).in[6])
#define IN_CONVB(A)  ((A).in[7])
#define IN_DTB(A)    ((A).in[8])
#define IN_ALOG(A)   ((A).in[9])
#define IN_DSKIP(A)  ((A).in[10])
#define IN_SSDNW(A)  ((A).in[11])
#define IN_WOA(A)    ((A).in[12])
#define IN_WOS(A)    ((A).in[13])
#define IN_WOUT(A)   ((A).in[14])
#define IN_LN2W(A)   ((A).in[15])
#define IN_WR(A)     ((A).in[16])
#define IN_BR(A)     ((A).in[17])
#define IN_WGU(A)    ((A).in[18])
#define IN_BGU(A)    ((A).in[19])
#define IN_WDN(A)    ((A).in[20])
#define IN_BDN(A)    ((A).in[21])
#define WSP(A, T, off) ((T*)((A).ws + (off)))

template <class Map>
__device__ __forceinline__ void transpose_item(const float* W, int K, int N, bf16* WT, LAS unsigned* scr, int kb, int nb, int lane, const Map& dest_row) {
    const int k0 = 64 * kb, n0 = 64 * nb, cc = lane & 15, kpl = lane >> 4;
    int col = n0 + 4 * cc; if (col > N - 4) col = N - 4;
    f32x4 a[8], b[8];
#pragma unroll
    for (int it = 0; it < 8; ++it) { const int kp = 4 * it + kpl; a[it] = *(const f32x4*)(W + (size_t)(k0 + 2 * kp) * N + col); b[it] = *(const f32x4*)(W + (size_t)(k0 + 2 * kp + 1) * N + col); }
#pragma unroll
    for (int it = 0; it < 8; ++it) { const int kp = 4 * it + kpl;
#pragma unroll
        for (int i = 0; i < 4; ++i) scr[(4 * cc + i) * 33 + kp] = pk2(a[it][i], b[it][i]); }
    LDS_WAIT(); asm volatile("" ::: "memory");
    const int rr = lane >> 3, ch = lane & 7;
#pragma unroll
    for (int j = 0; j < 8; ++j) { const int n = 8 * j + rr; const LAS unsigned* s = scr + n * 33 + 4 * ch; v4u o; o.x = s[0]; o.y = s[1]; o.z = s[2]; o.w = s[3];
        const int dr = dest_row(n0 + n); if (dr >= 0) *(v4u*)(WT + (size_t)dr * K + k0 + 8 * ch) = o; }
    LDS_WAIT(); asm volatile("" ::: "memory");
}
struct MapId { int N; __device__ __forceinline__ int operator()(int s) const { return s < N ? s : -1; } };
struct MapWin { __device__ __forceinline__ int operator()(int s) const { return s < COL_DT ? s : (s < COL_DT + SSD_H ? -1 : (s < N_IN ? s - SSD_H : -1)); } };
struct MapGu { __device__ __forceinline__ int operator()(int s) const { const int j = s >> 1, isu = s & 1; return (j >> 7) * 256 + (j & 127) + 128 * isu; } };

__device__ __forceinline__ void p0_prologue(Frame& F, const Args& A) {
    LAS unsigned* scr = (LAS unsigned*)(F.lds + RING_OFF + F.wave * 8704);
    const int gw = F.vcu * NWAVES + F.wave, NGW = F.G * NWAVES, lane = F.lane;
    constexpr int I_IN = 16 * 161, I_OA = 16 * 16, I_OS = 32 * 16, I_OUT = 16 * 16, I_GU1 = 16 * 32, I_GU = NEXP * I_GU1, I_DN1 = 16 * 16, I_DN = NEXP * I_DN1;
    constexpr int NITEMS = I_IN + I_OA + I_OS + I_OUT + I_GU + I_DN;
    for (int it = gw; it < NITEMS; it += NGW) {
        int r = it;
        if (r < I_IN) { transpose_item(IN_WIN(A), 1024, N_IN, WSP(A,bf16,WS_WIN), scr, r / 161, r % 161, lane, MapWin{}); continue; } r -= I_IN;
        if (r < I_OA) { transpose_item(IN_WOA(A), 1024, 1024, WSP(A,bf16,WS_WOA), scr, r / 16, r % 16, lane, MapId{1024}); continue; } r -= I_OA;
        if (r < I_OS) { transpose_item(IN_WOS(A), 2048, 1024, WSP(A,bf16,WS_WOS), scr, r / 16, r % 16, lane, MapId{1024}); continue; } r -= I_OS;
        if (r < I_OUT) { transpose_item(IN_WOUT(A), 1024, 1024, WSP(A,bf16,WS_WOUT), scr, r / 16, r % 16, lane, MapId{1024}); continue; } r -= I_OUT;
        if (r < I_GU) { const int e = r / I_GU1, q = r % I_GU1; transpose_item(IN_WGU(A) + (size_t)e * 1024 * 2048, 1024, 2048, WSP(A,bf16,WS_WGU) + (size_t)e * 2048 * 1024, scr, q / 32, q % 32, lane, MapGu{}); continue; } r -= I_GU;
        { const int e = r / I_DN1, q = r % I_DN1; transpose_item(IN_WDN(A) + (size_t)e * 1024 * 1024, 1024, 1024, WSP(A,bf16,WS_WDN) + (size_t)e * 1024 * 1024, scr, q / 16, q % 16, lane, MapId{1024}); }
    }
}

__device__ __forceinline__ float rowdot32(const float (&h)[16], const LAS float* WT, int lane) {
    float mine = 0.f;
#pragma unroll 2
    for (int e = 0; e < 32; ++e) { float s = 0.f;
#pragma unroll
        for (int j = 0; j < 4; ++j) { const f32x4 w = *(const LAS f32x4*)(WT + e * 1024 + 256 * j + 4 * lane); s += (h[4 * j] * w.x + h[4 * j + 1] * w.y) + (h[4 * j + 2] * w.z + h[4 * j + 3] * w.w); }
        s = wave_sum(s); mine = (lane == e) ? s : mine; }
    return mine;
}
__device__ __forceinline__ void stage_wt(Frame& F, const float* src) {
    LAS f32x4* dst = (LAS f32x4*)(F.lds + RING_OFF); const f32x4* s4 = (const f32x4*)src;
    for (int i = F.tid; i < 8192; i += NWAVES * 64) dst[i] = s4[i];
    __syncthreads();
}

__device__ __forceinline__ void p2_prep(Frame& F, const Args& A) {
    stage_wt(F, WSP(A,float,WS_WDT));
    const LAS float* WT = (const LAS float*)(F.lds + RING_OFF);
    const int lane = F.lane, wave = F.wave;
    float qw[16], kw[16];
#pragma unroll
    for (int q = 0; q < 4; ++q) { const f32x4 a = *(const f32x4*)(IN_QNW(A) + 16 * (lane & 3) + 4 * q), b = *(const f32x4*)(IN_KNW(A) + 16 * (lane & 3) + 4 * q);
#pragma unroll
        for (int i = 0; i < 4; ++i) { qw[4 * q + i] = a[i] * QSCALE; kw[4 * q + i] = b[i]; } }
    for (int item = F.vcu; item < M / 32; item += F.G) {
        const int t0 = item * 32 + wave * 4, b = t0 / SEQ, blk = (t0 % SEQ) / MBLK;
        float km[16];
#pragma unroll
        for (int i = 0; i < 16; ++i) km[i] = 0.f;
        for (int tt = 0; tt < 4; ++tt) {
            const int t = t0 + tt, pos = t % SEQ;
            bf16* prow = WSP(A,bf16,WS_PROJ) + (size_t)t * NPROJ;
            {
                float v[16]; { float lo[8], hi[8]; unpk8(*(const v4u*)(prow + PQ + 16 * lane), lo); unpk8(*(const v4u*)(prow + PQ + 16 * lane + 8), hi);
#pragma unroll
                    for (int i = 0; i < 8; ++i) { v[i] = lo[i]; v[8 + i] = hi[i]; } }
                float ss = 0.f;
#pragma unroll
                for (int i = 0; i < 16; ++i) ss += v[i] * v[i];
                ss += __shfl_xor(ss, 1); ss += __shfl_xor(ss, 2);
                const float rs = 1.0f / sqrtf(ss * (1.f / 64.f) + NORM_EPS);
                float lo[8], hi[8];
#pragma unroll
                for (int i = 0; i < 8; ++i) { lo[i] = v[i] * rs * qw[i]; hi[i] = v[8 + i] * rs * qw[8 + i]; }
                *(v4u*)(prow + PQ + 16 * lane) = pack8(lo); *(v4u*)(prow + PQ + 16 * lane + 8) = pack8(hi);
            }
            {
                float v[16]; { float lo[8], hi[8]; unpk8(*(const v4u*)(prow + PK + 16 * lane), lo); unpk8(*(const v4u*)(prow + PK + 16 * lane + 8), hi);
#pragma unroll
                    for (int i = 0; i < 8; ++i) { v[i] = lo[i]; v[8 + i] = hi[i]; } }
                float ss = 0.f;
#pragma unroll
                for (int i = 0; i < 16; ++i) ss += v[i] * v[i];
                ss += __shfl_xor(ss, 1); ss += __shfl_xor(ss, 2);
                const float rs = 1.0f / sqrtf(ss * (1.f / 64.f) + NORM_EPS);
                float lo[8], hi[8];
#pragma unroll
                for (int i = 0; i < 8; ++i) { lo[i] = v[i] * rs * kw[i]; hi[i] = v[8 + i] * rs * kw[8 + i]; km[i] += lo[i]; km[8 + i] += hi[i]; }
                *(v4u*)(prow + PK + 16 * lane) = pack8(lo); *(v4u*)(prow + PK + 16 * lane + 8) = pack8(hi);
            }
#pragma unroll 1
            for (int g6 = 0; g6 < 6; ++g6) {
                const int c0 = g6 * 512 + 8 * lane; float acc[8];
                { const f32x4 b0 = *(const f32x4*)(IN_CONVB(A) + c0), b1 = *(const f32x4*)(IN_CONVB(A) + c0 + 4);
#pragma unroll
                  for (int i = 0; i < 4; ++i) { acc[i] = b0[i]; acc[4 + i] = b1[i]; } }
#pragma unroll
                for (int j = 0; j < CONVK; ++j) {
                    if (pos - (CONVK - 1) + j >= 0) {
                        float xv[8]; unpk8(*(const v4u*)(WSP(A,bf16,WS_PROJ) + (size_t)(t - (CONVK - 1) + j) * NPROJ + PXBC + c0), xv);
                        const f32x4 w0 = *(const f32x4*)(IN_CONVW(A) + j * D_XBC + c0), w1 = *(const f32x4*)(IN_CONVW(A) + j * D_XBC + c0 + 4);
#pragma unroll
                        for (int i = 0; i < 4; ++i) { acc[i] += w0[i] * xv[i]; acc[4 + i] += w1[i] * xv[4 + i]; }
                    }
                }
#pragma unroll
                for (int i = 0; i < 8; ++i) acc[i] = silu_f(acc[i]);
                *(v4u*)(WSP(A,bf16,WS_XC) + (size_t)t * D_XBC + c0) = pack8(acc);
            }
            {
                float h[16]; const v2u* xr = (const v2u*)(WSP(A,bf16,WS_XN) + (size_t)t * D) + lane;
#pragma unroll
                for (int j = 0; j < 4; ++j) { const v2u w = xr[64 * j]; h[4 * j] = __uint_as_float(w.x << 16); h[4 * j + 1] = __uint_as_float(w.x & 0xffff0000u); h[4 * j + 2] = __uint_as_float(w.y << 16); h[4 * j + 3] = __uint_as_float(w.y & 0xffff0000u); }
                const float mine = rowdot32(h, WT, lane);
                if (lane < 32) { const float z = mine + IN_DTB(A)[lane]; WSP(A,float,WS_DT)[(size_t)t * 32 + lane] = fmaxf(z, 0.f) + log1pf(__expf(-fabsf(z))); }
            }
        }
        float* kmp = WSP(A,float,WS_KM) + ((size_t)(b * NH + (lane >> 2)) * NBLK + blk) * HD + 16 * (lane & 3);
#pragma unroll
        for (int i = 0; i < 16; ++i) unsafeAtomicAdd(kmp + i, km[i] * (1.f / MBLK));
    }
    __syncthreads();
}

__device__ __forceinline__ void p3_ssd(Frame& F, const Args& A) {
    LAS float* xs = (LAS float*)(F.lds + RING_OFF);
    LAS float* Bc = (LAS float*)(F.lds + RING_OFF + 16384);
    LAS float* Cc = (LAS float*)(F.lds + RING_OFF + 49152);
    LAS float* dtv = (LAS float*)(F.lds + RING_OFF + 81920);
    LAS float* yb = (LAS float*)(F.lds + RING_OFF + 82944);
    const int tid = F.tid;
    for (int unit = F.vcu; unit < BATCH * SSD_H; unit += F.G) {
        const int b = unit / SSD_H, h = unit % SSD_H, g = h / (SSD_H / NGRP);
        const float Aneg = -__expf(IN_ALOG(A)[h]), Dh = IN_DSKIP(A)[h];
        const int p = tid >> 3, ng = tid & 7;
        float st[16];
#pragma unroll
        for (int i = 0; i < 16; ++i) st[i] = 0.f;
        for (int ch = 0; ch < SEQ / 64; ++ch) {
            const int tb = b * SEQ + ch * 64;
            {
                const int r = tid >> 3, c8 = tid & 7;
                float v[8]; unpk8(*(const v4u*)(WSP(A,bf16,WS_XC) + (size_t)(tb + r) * D_XBC + h * 64 + 8 * c8), v);
#pragma unroll
                for (int i = 0; i < 8; ++i) xs[r * 64 + 8 * c8 + i] = v[i];
#pragma unroll
                for (int q = 0; q < 2; ++q) { const int idx = tid + 512 * q, rr = idx >> 4, c16 = idx & 15;
                    float bv[8], cv[8]; unpk8(*(const v4u*)(WSP(A,bf16,WS_XC) + (size_t)(tb + rr) * D_XBC + D_INNER + g * DSTATE + 8 * c16), bv); unpk8(*(const v4u*)(WSP(A,bf16,WS_XC) + (size_t)(tb + rr) * D_XBC + D_INNER + NGRP * DSTATE + g * DSTATE + 8 * c16), cv);
#pragma unroll
                    for (int i = 0; i < 8; ++i) { Bc[rr * 128 + 8 * c16 + i] = bv[i]; Cc[rr * 128 + 8 * c16 + i] = cv[i]; } }
                if (tid < 64) dtv[tid] = WSP(A,float,WS_DT)[(size_t)(tb + tid) * 32 + h];
            }
            __syncthreads();
            for (int tok = 0; tok < 64; ++tok) {
                const float dt = dtv[tok], decay = __expf(dt * Aneg), xdt = xs[tok * 64 + p] * dt;
                float yp = 0.f;
#pragma unroll
                for (int q = 0; q < 4; ++q) { const f32x4 bb = *(const LAS f32x4*)(Bc + tok * 128 + 16 * ng + 4 * q), cc = *(const LAS f32x4*)(Cc + tok * 128 + 16 * ng + 4 * q);
#pragma unroll
                    for (int i = 0; i < 4; ++i) { st[4 * q + i] = st[4 * q + i] * decay + bb[i] * xdt; yp += cc[i] * st[4 * q + i]; } }
                yp += __shfl_xor(yp, 1); yp += __shfl_xor(yp, 2); yp += __shfl_xor(yp, 4);
                if (ng == 0) yb[tok * 64 + p] = yp;
            }
            __syncthreads();
            {
                const int r = tid >> 3, c8 = tid & 7; const size_t t = (size_t)(tb + r);
                float z[8]; unpk8(*(const v4u*)(WSP(A,bf16,WS_PROJ) + t * NPROJ + PZ + h * 64 + 8 * c8), z);
                float o[8]; float ss = 0.f;
#pragma unroll
                for (int i = 0; i < 8; ++i) { const float y = yb[r * 64 + 8 * c8 + i] + Dh * xs[r * 64 + 8 * c8 + i]; o[i] = y * silu_f(z[i]); ss += o[i] * o[i]; }
                *(v4u*)(WSP(A,bf16,WS_YG) + t * D_INNER + h * 64 + 8 * c8) = pack8(o);
                ss += __shfl_xor(ss, 1); ss += __shfl_xor(ss, 2); ss += __shfl_xor(ss, 4);
                if (c8 == 0) { WSP(A,float,WS_SSQ)[t * 64 + 2 * h] = ss; WSP(A,float,WS_SSQ)[t * 64 + 2 * h + 1] = 0.f; }
            }
            __syncthreads();
        }
    }
}

typedef short bf16x8v __attribute__((ext_vector_type(8)));
typedef float f32x16 __attribute__((ext_vector_type(16)));
__device__ __forceinline__ int crow(int r, int hi) { return (r & 3) + 8 * (r >> 2) + 4 * hi; }

__device__ __forceinline__ void p3_ssd_mfma(Frame& F, const Args& A) {
    constexpr int RP = 272, TP = 144;
    constexpr int O_B = 0, O_C = 17408, O_BT = 34816, O_XT = 53248, O_S = 62464, O_CS = 97280, O_DT = 97536;
    LAS unsigned char* L = F.lds + RING_OFF;
    LAS float* csL = (LAS float*)(L + O_CS); LAS float* dtL = (LAS float*)(L + O_DT);
    const int tid = F.tid, lane = F.lane, wave = F.wave, r32 = lane & 31, hi = lane >> 5;
    for (int unit = F.vcu; unit < BATCH * SSD_H; unit += F.G) {
        const int b = unit / SSD_H, hd = unit % SSD_H, g = hd / (SSD_H / NGRP);
        const float Aneg = -__expf(IN_ALOG(A)[hd]), Dh = IN_DSKIP(A)[hd];
        const int ll = tid & 63, cc = tid >> 6;
        const bf16* xg = WSP(A,bf16,WS_XC) + (size_t)(b * SEQ + ll) * D_XBC + hd * 64 + 8 * cc;
        const bf16* bg = WSP(A,bf16,WS_XC) + (size_t)(b * SEQ + ll) * D_XBC + D_INNER + g * DSTATE + 16 * cc;
        const bf16* cg = bg + NGRP * DSTATE;
        const float* dg = WSP(A,float,WS_DT) + (size_t)(b * SEQ + ll) * 32 + hd;
        v4u xr, br0, br1, cr0, cr1; float dtr = 0.f;
#define SS_LOAD(c) do { const size_t o_ = (size_t)(c) * 64 * D_XBC; xr = *(const v4u*)(xg + o_); br0 = *(const v4u*)(bg + o_); br1 = *(const v4u*)(bg + o_ + 8); cr0 = *(const v4u*)(cg + o_); cr1 = *(const v4u*)(cg + o_ + 8); \
            if (tid < 64) dtr = dg[(size_t)(c) * 64 * 32]; } while (0)
#define SS_STORE() do { \
            *(LAS v4u*)(L + O_B + ll * RP + cc * 32) = br0; *(LAS v4u*)(L + O_B + ll * RP + cc * 32 + 16) = br1; \
            *(LAS v4u*)(L + O_C + ll * RP + cc * 32) = cr0; *(LAS v4u*)(L + O_C + ll * RP + cc * 32 + 16) = cr1; \
            _Pragma("unroll") for (int i_ = 0; i_ < 4; ++i_) { \
                *(LAS unsigned short*)(L + O_XT + (8 * cc + 2 * i_) * TP + ll * 2) = (unsigned short)(xr[i_] & 0xffffu); *(LAS unsigned short*)(L + O_XT + (8 * cc + 2 * i_ + 1) * TP + ll * 2) = (unsigned short)(xr[i_] >> 16); \
                *(LAS unsigned short*)(L + O_BT + (16 * cc + 2 * i_) * TP + ll * 2) = (unsigned short)(br0[i_] & 0xffffu); *(LAS unsigned short*)(L + O_BT + (16 * cc + 2 * i_ + 1) * TP + ll * 2) = (unsigned short)(br0[i_] >> 16); \
                *(LAS unsigned short*)(L + O_BT + (16 * cc + 8 + 2 * i_) * TP + ll * 2) = (unsigned short)(br1[i_] & 0xffffu); *(LAS unsigned short*)(L + O_BT + (16 * cc + 8 + 2 * i_ + 1) * TP + ll * 2) = (unsigned short)(br1[i_] >> 16); } \
            if (tid < 64) { float a_ = dtr * Aneg; \
                _Pragma("unroll") for (int o_ = 1; o_ < 64; o_ <<= 1) { const float v_ = __shfl_up(a_, o_); if (lane >= o_) a_ += v_; } \
                csL[tid] = a_; dtL[tid] = dtr; } } while (0)
        SS_LOAD(0); SS_STORE();
        f32x16 s0 = {}, s1 = {};
        __syncthreads();
        for (int c = 0; c < SEQ / 64; ++c) {
            if (c + 1 < SEQ / 64) SS_LOAD(c + 1);
            const int tb = b * SEQ + c * 64;
            if (wave < 4) {
                const int pt = wave & 1, lt = wave >> 1;
                const LAS unsigned char* Sb = L + O_S + (c & 1) * 17408;
                f32x16 acc = {};
                const float csl = csL[32 * lt + r32];
                if (c > 0) {
#pragma unroll
                    for (int ks = 0; ks < 8; ++ks) { const bf16x8v af = *(const LAS bf16x8v*)(Sb + (32 * pt + r32) * RP + ks * 32 + hi * 16), bf = *(const LAS bf16x8v*)(L + O_C + (32 * lt + r32) * RP + ks * 32 + hi * 16);
                        acc = __builtin_amdgcn_mfma_f32_32x32x16_bf16(af, bf, acc, 0, 0, 0); }
                    const float el = __expf(csl);
#pragma unroll
                    for (int r = 0; r < 16; ++r) acc[r] *= el;
                }
                for (int st = 0; st <= lt; ++st) {
                    f32x16 gt = {};
#pragma unroll
                    for (int ks = 0; ks < 8; ++ks) { const bf16x8v af = *(const LAS bf16x8v*)(L + O_B + (32 * st + r32) * RP + ks * 32 + hi * 16), bf = *(const LAS bf16x8v*)(L + O_C + (32 * lt + r32) * RP + ks * 32 + hi * 16);
                        gt = __builtin_amdgcn_mfma_f32_32x32x16_bf16(af, bf, gt, 0, 0, 0); }
                    const int lidx = 32 * lt + r32;
#pragma unroll
                    for (int r = 0; r < 16; ++r) { const int s = 32 * st + crow(r, hi); const float e = __expf(csl - csL[s]) * dtL[s]; gt[r] = (s <= lidx) ? gt[r] * e : 0.f; }
                    v4u m0, m1;
#pragma unroll
                    for (int q = 0; q < 4; ++q) { m0[q] = pk2(gt[2 * q], gt[2 * q + 1]); m1[q] = pk2(gt[8 + 2 * q], gt[8 + 2 * q + 1]); }
                    const LAS unsigned char* xrow = L + O_XT + (32 * pt + r32) * TP + (32 * st + 4 * hi) * 2;
                    { const v2u a0 = *(const LAS v2u*)(xrow), a1 = *(const LAS v2u*)(xrow + 16); v4u av; av.x = a0.x; av.y = a0.y; av.z = a1.x; av.w = a1.y;
                      acc = __builtin_amdgcn_mfma_f32_32x32x16_bf16(__builtin_bit_cast(bf16x8v, av), __builtin_bit_cast(bf16x8v, m0), acc, 0, 0, 0); }
                    { const v2u a0 = *(const LAS v2u*)(xrow + 32), a1 = *(const LAS v2u*)(xrow + 48); v4u av; av.x = a0.x; av.y = a0.y; av.z = a1.x; av.w = a1.y;
                      acc = __builtin_amdgcn_mfma_f32_32x32x16_bf16(__builtin_bit_cast(bf16x8v, av), __builtin_bit_cast(bf16x8v, m1), acc, 0, 0, 0); }
                }
                const size_t t = (size_t)(tb + 32 * lt + r32); float ss = 0.f;
#pragma unroll
                for (int g4 = 0; g4 < 4; ++g4) { const int pc = hd * 64 + 32 * pt + 8 * g4 + 4 * hi;
                    const v2u zz = *(const v2u*)(WSP(A,bf16,WS_PROJ) + t * NPROJ + PZ + pc), xx = *(const v2u*)(WSP(A,bf16,WS_XC) + t * D_XBC + pc);
                    const float z[4] = {__uint_as_float(zz.x << 16), __uint_as_float(zz.x & 0xffff0000u), __uint_as_float(zz.y << 16), __uint_as_float(zz.y & 0xffff0000u)};
                    const float x[4] = {__uint_as_float(xx.x << 16), __uint_as_float(xx.x & 0xffff0000u), __uint_as_float(xx.y << 16), __uint_as_float(xx.y & 0xffff0000u)};
                    float o[4];
#pragma unroll
                    for (int i = 0; i < 4; ++i) { const float y = acc[4 * g4 + i] + Dh * x[i]; o[i] = y * silu_f(z[i]); ss += o[i] * o[i]; }
                    v2u w; w.x = pk2(o[0], o[1]); w.y = pk2(o[2], o[3]); *(v2u*)(WSP(A,bf16,WS_YG) + t * D_INNER + pc) = w; }
                ss += __shfl_xor(ss, 32);
                if (hi == 0) WSP(A,float,WS_SSQ)[t * 64 + hd * 2 + pt] = ss;
            } else {
                const int w4 = wave - 4, pt = w4 & 1, nt0 = 2 * (w4 >> 1);
                const float cslast = csL[63]; const float dec = __expf(cslast);
#pragma unroll
                for (int r = 0; r < 16; ++r) { s0[r] *= dec; s1[r] *= dec; }
#pragma unroll
                for (int ks = 0; ks < 4; ++ks) {
                    float xv[8]; unpk8(*(const LAS v4u*)(L + O_XT + (32 * pt + r32) * TP + ks * 32 + hi * 16), xv);
                    const f32x4 c0 = *(const LAS f32x4*)(csL + 16 * ks + 8 * hi), c1 = *(const LAS f32x4*)(csL + 16 * ks + 8 * hi + 4), d0 = *(const LAS f32x4*)(dtL + 16 * ks + 8 * hi), d1 = *(const LAS f32x4*)(dtL + 16 * ks + 8 * hi + 4);
#pragma unroll
                    for (int i = 0; i < 4; ++i) { xv[i] *= d0[i] * __expf(cslast - c0[i]); xv[4 + i] *= d1[i] * __expf(cslast - c1[i]); }
                    const bf16x8v af = __builtin_bit_cast(bf16x8v, pack8(xv));
                    const bf16x8v b0 = *(const LAS bf16x8v*)(L + O_BT + (32 * nt0 + r32) * TP + ks * 32 + hi * 16), b1 = *(const LAS bf16x8v*)(L + O_BT + (32 * nt0 + 32 + r32) * TP + ks * 32 + hi * 16);
                    s0 = __builtin_amdgcn_mfma_f32_32x32x16_bf16(af, b0, s0, 0, 0, 0); s1 = __builtin_amdgcn_mfma_f32_32x32x16_bf16(af, b1, s1, 0, 0, 0);
                }
                LAS unsigned char* Sn = L + O_S + ((c + 1) & 1) * 17408;
#pragma unroll
                for (int r = 0; r < 16; ++r) { const int p = 32 * pt + crow(r, hi);
                    *(LAS unsigned short*)(Sn + p * RP + (32 * nt0 + r32) * 2) = (unsigned short)f2bf(s0[r]); *(LAS unsigned short*)(Sn + p * RP + (32 * nt0 + 32 + r32) * 2) = (unsigned short)f2bf(s1[r]); }
            }
            __syncthreads();
            if (c + 1 < SEQ / 64) SS_STORE();
            __syncthreads();
        }
#undef SS_LOAD
#undef SS_STORE
    }
}

__device__ __forceinline__ void p4_norm(Frame& F, const Args& A) {
    const int lane = F.lane, gw = F.vcu * NWAVES + F.wave, NGW = F.G * NWAVES;
    for (int t = gw; t < M; t += NGW) {
        bf16* row = WSP(A,bf16,WS_YG) + (size_t)t * D_INNER + 32 * lane; const int g = lane >> 4;
        float ss = 0.f;
#pragma unroll
        for (int hh = 0; hh < 16; ++hh) ss += WSP(A,float,WS_SSQ)[(size_t)t * 64 + 16 * g + hh];
        const float rs = 1.0f / sqrtf(ss * (1.f / 512.f) + NORM_EPS);
#pragma unroll
        for (int q = 0; q < 4; ++q) { float v[8]; unpk8(*(const v4u*)(row + 8 * q), v); const f32x4 w0 = *(const f32x4*)(IN_SSDNW(A) + 32 * lane + 8 * q), w1 = *(const f32x4*)(IN_SSDNW(A) + 32 * lane + 8 * q + 4);
#pragma unroll
            for (int i = 0; i < 4; ++i) { v[i] = v[i] * rs * w0[i]; v[4 + i] = v[4 + i] * rs * w1[i]; }
            *(v4u*)(row + 8 * q) = pack8(v); }
    }
}
__device__ __forceinline__ void attn_simple(Frame& F, const Args& A) {
    const int lane = F.lane, gw = F.vcu * NWAVES + F.wave, NGW = F.G * NWAVES;
    const float qwm = wave_max(fabsf(IN_QNW(A)[lane])), kwm = wave_max(fabsf(IN_KNW(A)[lane]));
    const float REF = 8.0f * qwm * kwm * 1.4426950408889634f + 0.25f;
    const bf16* QN = WSP(A,bf16,WS_PROJ) + PQ; const bf16* KN = WSP(A,bf16,WS_PROJ) + PK; const bf16* VV = WSP(A,bf16,WS_PROJ) + PV;
    for (int rep = 0; rep < REP(PH_ATTN); ++rep)
    for (long a = gw; a < (long)M * NH; a += NGW) {
        const int grp = (int)(a >> 7), within = (int)(a & 127), h = within >> 3, t = grp * 8 + (within & 7);
        const int b = t / SEQ, pos = t % SEQ, qb = pos >> 8;
        const bf16* qp = QN + (size_t)t * NPROJ + h * 64;
        float q[64];
#pragma unroll
        for (int c = 0; c < 8; ++c) { float v[8]; unpk8(*(const v4u*)(qp + 8 * c), v);
#pragma unroll
            for (int i = 0; i < 8; ++i) q[8 * c + i] = v[i]; }
        const float qd = bf2f(qp[lane]);
        float sc[7];
#pragma unroll
        for (int j = 0; j < 7; ++j) { sc[j] = -3.0e38f; if (j < qb) sc[j] = wave_sum(qd * WSP(A,float,WS_KM)[((size_t)(b * NH + h) * NBLK + j) * HD + lane]); }
        unsigned sel = 0u; const int nsel = qb < MOBA_TOPK ? qb : MOBA_TOPK;
#pragma unroll
        for (int k = 0; k < MOBA_TOPK; ++k) if (k < nsel) { float best = -3.0e38f; int bi = 0;
#pragma unroll
            for (int j = 0; j < 7; ++j) if (j < qb && !((sel >> j) & 1u) && sc[j] > best) { best = sc[j]; bi = j; }
            sel |= 1u << bi; }
        sel |= 1u << qb;
        float o = 0.f, lsum = 0.f;
        for (int j = 0; j <= qb; ++j) {
            if (!((sel >> j) & 1u)) continue;
            for (int tile = 0; tile < 4; ++tile) {
                const int kbase = j * MBLK + tile * 64; if (j == qb && kbase > pos) break;
                const int kk = kbase + lane; const bf16* kp = KN + (size_t)(b * SEQ + kk) * NPROJ + h * 64;
                float dot = 0.f;
#pragma unroll
                for (int c = 0; c < 8; ++c) { float v[8]; unpk8(*(const v4u*)(kp + 8 * c), v);
#pragma unroll
                    for (int i = 0; i < 8; ++i) dot += v[i] * q[8 * c + i]; }
                const bool valid = (j < qb) || (kk <= pos);
                const float pr = valid ? __builtin_amdgcn_exp2f(dot - REF) : 0.f; lsum += pr;
                const bf16* vp = VV + (size_t)(b * SEQ + kbase) * NPROJ + h * 64 + lane;
#pragma unroll 16
                for (int jj = 0; jj < 64; ++jj) { const float pj = __shfl(pr, jj); o += pj * bf2f(vp[(size_t)jj * NPROJ]); }
            }
        }
        const float l = wave_sum(lsum);
        WSP(A,bf16,WS_AO)[(size_t)t * D + h * 64 + lane] = (bf16)f2bf(o / l);
    }
}


__device__ __forceinline__ void attn_mfma(Frame& F, const Args& A) {
    const int tid = F.tid, lane = F.lane, wave = F.wave, r32 = lane & 31, hi = lane >> 5;
    constexpr int KP = 144, VP = 136, KBS = 9216, VB0 = 18432, VBS = 8704, KMOFF = 36864;
    LAS unsigned char* L = F.lds + RING_OFF;
    LAS float* KMs = (LAS float*)(L + KMOFF);
    const float qwm = wave_max(fabsf(IN_QNW(A)[lane])), kwm = wave_max(fabsf(IN_KNW(A)[lane]));
    const float REF = 8.0f * qwm * kwm * 1.4426950408889634f + 0.25f;
    const bf16* QN = WSP(A,bf16,WS_PROJ) + PQ; const bf16* KN = WSP(A,bf16,WS_PROJ) + PK; const bf16* VV = WSP(A,bf16,WS_PROJ) + PV;
    for (int slot = F.vcu; slot < 256; slot += F.G)
    for (int ui = 0; ui < 4; ++ui) {
        const int bh = slot >> 1, sp = slot & 1, b = bh >> 4, h = bh & 15;
        const int qb = (sp == 0) ? (ui == 0 ? 0 : ui == 1 ? 7 : ui == 2 ? 1 : 6) : (ui == 0 ? 2 : ui == 1 ? 5 : ui == 2 ? 3 : 4);
        const int tq0 = b * SEQ + qb * MBLK, NT = 4 * (qb + 1);
        const bf16* kg = KN + (size_t)(b * SEQ + (tid >> 3)) * NPROJ + h * 64 + 8 * (tid & 7);
        const bf16* vg = VV + (size_t)(b * SEQ + 2 * (tid >> 4)) * NPROJ + h * 64 + 4 * (tid & 15);
        v4u kreg; v2u vr0, vr1;
#define AT_LOAD(tt) do { kreg = *(const v4u*)(kg + (size_t)(tt) * 64 * NPROJ); vr0 = *(const v2u*)(vg + (size_t)(tt) * 64 * NPROJ); vr1 = *(const v2u*)(vg + (size_t)(tt) * 64 * NPROJ + NPROJ); } while (0)
#define AT_STORE(bufi) do { *(LAS v4u*)(L + (bufi) * KBS + (tid >> 3) * KP + (tid & 7) * 16) = kreg; \
            LAS unsigned char* vb_ = L + VB0 + (bufi) * VBS + (4 * (tid & 15)) * VP + (tid >> 4) * 4; \
            *(LAS unsigned*)(vb_) = (vr0.x & 0xffffu) | (vr1.x << 16); *(LAS unsigned*)(vb_ + VP) = (vr0.x >> 16) | (vr1.x & 0xffff0000u); \
            *(LAS unsigned*)(vb_ + 2 * VP) = (vr0.y & 0xffffu) | (vr1.y << 16); *(LAS unsigned*)(vb_ + 3 * VP) = (vr0.y >> 16) | (vr1.y & 0xffff0000u); } while (0)
        if (tid < 448) { const int j = tid >> 6; if (j < qb) KMs[tid] = WSP(A,float,WS_KM)[((size_t)(b * NH + h) * NBLK + j) * HD + (tid & 63)]; }
        AT_LOAD(0); AT_STORE(0);
        const bf16* qp = QN + (size_t)(tq0 + wave * 32 + r32) * NPROJ + h * 64;
        bf16x8v qr[4];
#pragma unroll
        for (int ds = 0; ds < 4; ++ds) qr[ds] = *(const bf16x8v*)(qp + 16 * ds + 8 * hi);
        __syncthreads();
        float sc[7];
#pragma unroll
        for (int j = 0; j < 7; ++j) { sc[j] = -3.0e38f;
            if (j < qb) { float s = 0.f;
#pragma unroll
                for (int ds = 0; ds < 4; ++ds) { float qv[8]; unpk8(__builtin_bit_cast(v4u, qr[ds]), qv);
                    const f32x4 k0 = *(const LAS f32x4*)(KMs + j * 64 + 16 * ds + 8 * hi), k1 = *(const LAS f32x4*)(KMs + j * 64 + 16 * ds + 8 * hi + 4);
                    s += (qv[0] * k0.x + qv[1] * k0.y) + (qv[2] * k0.z + qv[3] * k0.w) + (qv[4] * k1.x + qv[5] * k1.y) + (qv[6] * k1.z + qv[7] * k1.w); }
                s += __shfl_xor(s, 32); sc[j] = s; } }
        unsigned sel = 0u; const int nsel = qb < MOBA_TOPK ? qb : MOBA_TOPK;
#pragma unroll
        for (int k = 0; k < MOBA_TOPK; ++k) if (k < nsel) { float best = -3.0e38f; int bi = 0;
#pragma unroll
            for (int j = 0; j < 7; ++j) if (j < qb && !((sel >> j) & 1u) && sc[j] > best) { best = sc[j]; bi = j; }
            sel |= 1u << bi; }
        f32x16 o0 = {}, o1 = {}; float lsum = 0.f;
        const int qi = wave * 32 + r32;
        for (int tt = 0; tt < NT; ++tt) {
            const int cur = tt & 1;
            if (tt + 1 < NT) AT_LOAD(tt + 1);
            const int j = tt >> 2, tile = tt & 3; const bool own = (j == qb);
            if (!(own && tile * 64 > wave * 32 + 31)) {
                const LAS unsigned char* Kb = L + cur * KBS; const LAS unsigned char* Vb = L + VB0 + cur * VBS;
                f32x16 p0 = {}, p1 = {};
#pragma unroll
                for (int ds = 0; ds < 4; ++ds) {
                    const bf16x8v k0 = *(const LAS bf16x8v*)(Kb + r32 * KP + ds * 32 + hi * 16), k1 = *(const LAS bf16x8v*)(Kb + (32 + r32) * KP + ds * 32 + hi * 16);
                    p0 = __builtin_amdgcn_mfma_f32_32x32x16_bf16(k0, qr[ds], p0, 0, 0, 0); p1 = __builtin_amdgcn_mfma_f32_32x32x16_bf16(k1, qr[ds], p1, 0, 0, 0); }
                const bool selbit = ((sel >> j) & 1u) != 0u;
#pragma unroll
                for (int r = 0; r < 16; ++r) { const int kv0 = tile * 64 + crow(r, hi);
                    const bool v0 = own ? (kv0 <= qi) : selbit, v1 = own ? (kv0 + 32 <= qi) : selbit;
                    p0[r] = v0 ? __builtin_amdgcn_exp2f(p0[r] - REF) : 0.f; p1[r] = v1 ? __builtin_amdgcn_exp2f(p1[r] - REF) : 0.f; lsum += p0[r] + p1[r]; }
                v4u pf[4];
#pragma unroll
                for (int q = 0; q < 4; ++q) { pf[0][q] = pk2(p0[2 * q], p0[2 * q + 1]); pf[1][q] = pk2(p0[8 + 2 * q], p0[8 + 2 * q + 1]); pf[2][q] = pk2(p1[2 * q], p1[2 * q + 1]); pf[3][q] = pk2(p1[8 + 2 * q], p1[8 + 2 * q + 1]); }
#pragma unroll
                for (int ks = 0; ks < 4; ++ks) {
                    const bf16x8v pb = __builtin_bit_cast(bf16x8v, pf[ks]);
                    { const v2u a0 = *(const LAS v2u*)(Vb + r32 * VP + (16 * ks + 4 * hi) * 2), a1 = *(const LAS v2u*)(Vb + r32 * VP + (16 * ks + 8 + 4 * hi) * 2);
                      v4u av; av.x = a0.x; av.y = a0.y; av.z = a1.x; av.w = a1.y; o0 = __builtin_amdgcn_mfma_f32_32x32x16_bf16(__builtin_bit_cast(bf16x8v, av), pb, o0, 0, 0, 0); }
                    { const v2u a0 = *(const LAS v2u*)(Vb + (32 + r32) * VP + (16 * ks + 4 * hi) * 2), a1 = *(const LAS v2u*)(Vb + (32 + r32) * VP + (16 * ks + 8 + 4 * hi) * 2);
                      v4u av; av.x = a0.x; av.y = a0.y; av.z = a1.x; av.w = a1.y; o1 = __builtin_amdgcn_mfma_f32_32x32x16_bf16(__builtin_bit_cast(bf16x8v, av), pb, o1, 0, 0, 0); }
                }
            }
            if (tt + 1 < NT) AT_STORE(cur ^ 1);
            __syncthreads();
        }
#undef AT_LOAD
#undef AT_STORE
        const float l = lsum + __shfl_xor(lsum, 32), inv = 1.0f / l;
        bf16* op = WSP(A,bf16,WS_AO) + (size_t)(tq0 + qi) * D + h * 64 + 4 * hi;
#pragma unroll
        for (int g4 = 0; g4 < 4; ++g4) { v2u w0, w1; w0.x = pk2(o0[4 * g4] * inv, o0[4 * g4 + 1] * inv); w0.y = pk2(o0[4 * g4 + 2] * inv, o0[4 * g4 + 3] * inv);
            w1.x = pk2(o1[4 * g4] * inv, o1[4 * g4 + 1] * inv); w1.y = pk2(o1[4 * g4 + 2] * inv, o1[4 * g4 + 3] * inv);
            *(v2u*)(op + 8 * g4) = w0; *(v2u*)(op + 32 + 8 * g4) = w1; }
    }
    __syncthreads();
}
__device__ __forceinline__ void p7_route(Frame& F, const Args& A) {
    stage_wt(F, WSP(A,float,WS_WRT));
    const LAS float* WT = (const LAS float*)(F.lds + RING_OFF);
    const int lane = F.lane, gw = F.vcu * NWAVES + F.wave, NGW = F.G * NWAVES;
    for (int t = gw; t < M; t += NGW) {
        const f32x4* xr = (const f32x4*)((A).out + (size_t)t * D) + lane; const f32x4* wr = (const f32x4*)IN_LN2W(A) + lane;
        f32x4 v[4]; float s = 0.f;
#pragma unroll
        for (int j = 0; j < 4; ++j) { v[j] = xr[64 * j]; s += (v[j].x * v[j].x + v[j].y * v[j].y) + (v[j].z * v[j].z + v[j].w * v[j].w); }
        const float rs = 1.0f / sqrtf(wave_sum(s) * (1.f / D) + NORM_EPS);
        float h[16]; v2u* o8 = (v2u*)(WSP(A,bf16,WS_H2) + (size_t)t * D) + lane;
#pragma unroll
        for (int j = 0; j < 4; ++j) { const f32x4 w = wr[64 * j]; h[4 * j] = v[j].x * rs * w.x; h[4 * j + 1] = v[j].y * rs * w.y; h[4 * j + 2] = v[j].z * rs * w.z; h[4 * j + 3] = v[j].w * rs * w.w;
            v2u o; o.x = pk2(h[4 * j], h[4 * j + 1]); o.y = pk2(h[4 * j + 2], h[4 * j + 3]); o8[64 * j] = o; }
        float val = rowdot32(h, WT, lane); val = (lane < 32) ? val + IN_BR(A)[lane & 31] : -3.0e38f;
        float tv[4]; int ti[4];
#pragma unroll
        for (int k = 0; k < 4; ++k) { const float mx = wave_max(val); const unsigned long long bm = __ballot(val == mx); const int idx = __builtin_ctzll(bm);
            tv[k] = mx; ti[k] = idx; if (lane == idx) val = -3.0e38f; }
        float ex[4], es = 0.f;
#pragma unroll
        for (int k = 0; k < 4; ++k) { ex[k] = __expf(tv[k] - tv[0]); es += ex[k]; }
        if (lane == 0) {
#pragma unroll
            for (int k = 0; k < 4; ++k) { const unsigned j = __hip_atomic_fetch_add((WSP(A,unsigned,WS_CTL) + CW_CNT) + ti[k], 1u, RLX_AGENT); WSP(A,int,WS_TOKL)[ti[k] * EXPCAP + (int)j] = t * 4 + k; WSP(A,float,WS_GATEW)[t * 4 + k] = ex[k] / es; }
        }
    }
    __syncthreads();
}

__device__ __forceinline__ int moe_tables(Frame& F, const Args& A) {
    LAS int* tile_e = (LAS int*)(F.lds + TILEE_OFF); LAS int* rowb = (LAS int*)(F.lds + ROWB_OFF); LAS int* cntl = (LAS int*)(F.lds + CNTL_OFF);
    if (F.tid == 0) { int acc = 0, rt = 0;
        for (int e = 0; e < NEXP; ++e) { int c = (int)__hip_atomic_load((WSP(A,unsigned,WS_CTL) + CW_CNT) + e, RLX_AGENT); if (c > EXPCAP) c = EXPCAP; cntl[e] = c; rowb[e] = acc; const int n = (c + 255) >> 8; for (int i = 0; i < n; ++i) tile_e[rt++] = e; acc += n * 256; }
        rowb[NEXP] = acc; }
    __syncthreads();
    return rowb[NEXP] >> 8;
}
__device__ __forceinline__ void p8_gather(Frame& F, const Args& A) {
    const int NT = moe_tables(F, A);
    const LAS int* rowb = (const LAS int*)(F.lds + ROWB_OFF); const LAS int* cntl = (const LAS int*)(F.lds + CNTL_OFF);
    const int lane = F.lane, gw = F.vcu * NWAVES + F.wave, NGW = F.G * NWAVES, total = NT * 256;
    for (int r = gw; r < total; r += NGW) {
        int e = 0;
#pragma unroll
        for (int q = 1; q < NEXP; ++q) e += (rowb[q] <= r) ? 1 : 0;
        const int j = r - rowb[e];
        if (j < cntl[e]) { const int a = WSP(A,int,WS_TOKL)[e * EXPCAP + j], t = a >> 2;
            const v4u x0 = *(const v4u*)(WSP(A,bf16,WS_H2) + (size_t)t * D + 16 * lane), x1 = *(const v4u*)(WSP(A,bf16,WS_H2) + (size_t)t * D + 16 * lane + 8);
            *(v4u*)(WSP(A,bf16,WS_XG) + (size_t)r * D + 16 * lane) = x0; *(v4u*)(WSP(A,bf16,WS_XG) + (size_t)r * D + 16 * lane + 8) = x1;
            if (lane == 0) { WSP(A,float,WS_ROWW)[r] = WSP(A,float,WS_GATEW)[a]; WSP(A,int,WS_POS)[a] = r; } }
        else if (lane == 0) WSP(A,float,WS_ROWW)[r] = 0.f;
    }
    __syncthreads();
}
__device__ __forceinline__ void p11_combine(Frame& F, const Args& A) {
    const int lane = F.lane, gw = F.vcu * NWAVES + F.wave, NGW = F.G * NWAVES;
    for (int t = gw; t < M; t += NGW) {
        f32x4* xr = (f32x4*)((A).out + (size_t)t * D) + lane; f32x4 v[4];
#pragma unroll
        for (int j = 0; j < 4; ++j) v[j] = xr[64 * j];
#pragma unroll
        for (int k = 0; k < 4; ++k) { const int r = WSP(A,int,WS_POS)[t * 4 + k]; const v2u* yr = (const v2u*)(WSP(A,bf16,WS_Y) + (size_t)r * D) + lane;
#pragma unroll
            for (int j = 0; j < 4; ++j) { const v2u w = yr[64 * j]; v[j].x += __uint_as_float(w.x << 16); v[j].y += __uint_as_float(w.x & 0xffff0000u); v[j].z += __uint_as_float(w.y << 16); v[j].w += __uint_as_float(w.y & 0xffff0000u); } }
#pragma unroll
        for (int j = 0; j < 4; ++j) xr[64 * j] = v[j];
    }
}

template <bool XLO, bool WLO>
__device__ __forceinline__ void tile_dot32(Frame& F, const bf16* Xhi, const bf16* Xlo, int ldx, const bf16* Whi, const bf16* Wlo, LAS float* PART, LAS float* LOG) {
    const int lane = F.lane, wave = F.wave, r32 = lane & 31, hi = lane >> 5, tile = wave >> 2, kq = wave & 3;
    const size_t xo = (size_t)(tile * 32 + r32) * ldx + kq * 256 + 8 * hi; const int wo = r32 * 1024 + kq * 256 + 8 * hi;
    f32x16 acc = {};
#pragma unroll 4
    for (int ks = 0; ks < 16; ++ks) {
        const bf16x8v a = *(const bf16x8v*)(Xhi + xo + 16 * ks), b = *(const bf16x8v*)(Whi + wo + 16 * ks);
        acc = __builtin_amdgcn_mfma_f32_32x32x16_bf16(a, b, acc, 0, 0, 0);
        if (WLO) { const bf16x8v bl = *(const bf16x8v*)(Wlo + wo + 16 * ks); acc = __builtin_amdgcn_mfma_f32_32x32x16_bf16(a, bl, acc, 0, 0, 0); }
        if (XLO) { const bf16x8v al = *(const bf16x8v*)(Xlo + xo + 16 * ks); acc = __builtin_amdgcn_mfma_f32_32x32x16_bf16(al, b, acc, 0, 0, 0); }
    }
#pragma unroll
    for (int r = 0; r < 16; ++r) PART[(wave * 32 + crow(r, hi)) * 33 + r32] = acc[r];
    __syncthreads();
#pragma unroll
    for (int q = 0; q < 4; ++q) { const int idx = F.tid + 512 * q, tok = idx >> 5, e = idx & 31; const LAS float* pp = PART + ((tok >> 5) * 4 * 32 + (tok & 31)) * 33 + e;
        LOG[tok * 33 + e] = (pp[0] + pp[32 * 33]) + (pp[2 * 32 * 33] + pp[3 * 32 * 33]); }
    __syncthreads();
}

__device__ __forceinline__ void p0_tail(Frame& F, const Args& A) {
    const int lane = F.lane, gw = F.vcu * NWAVES + F.wave, NGW = F.G * NWAVES;
    { const int gt = F.vcu * 512 + F.tid, NGT = F.G * 512;
      for (int i = gt; i < 32 * 1024; i += NGT) { const int e = i >> 10, k = i & 1023; const float wd = IN_WIN(A)[(size_t)k * N_IN + COL_DT + e], wr = IN_WR(A)[k * 32 + e];
          const unsigned dh = f2bf(wd), rh = f2bf(wr);
          WSP(A,bf16,WS_WDH)[i] = (bf16)dh; WSP(A,bf16,WS_WDL)[i] = (bf16)f2bf(wd - __uint_as_float(dh << 16)); WSP(A,bf16,WS_WRH)[i] = (bf16)rh; WSP(A,bf16,WS_WRL)[i] = (bf16)f2bf(wr - __uint_as_float(rh << 16)); } }
    f32x4 w[4];
#pragma unroll
    for (int j = 0; j < 4; ++j) w[j] = ((const f32x4*)IN_LN1W(A))[lane + 64 * j];
    for (int m0 = gw * 4; m0 < M; m0 += NGW * 4) {
        f32x4 v[4][4];
#pragma unroll
        for (int i = 0; i < 4; ++i)
#pragma unroll
            for (int j = 0; j < 4; ++j) v[i][j] = ((const f32x4*)(IN_X(A) + (size_t)(m0 + i) * D))[lane + 64 * j];
#pragma unroll
        for (int i = 0; i < 4; ++i) { float s = 0.f;
#pragma unroll
            for (int j = 0; j < 4; ++j) s += (v[i][j].x * v[i][j].x + v[i][j].y * v[i][j].y) + (v[i][j].z * v[i][j].z + v[i][j].w * v[i][j].w);
            const float rs = 1.0f / sqrtf(wave_sum(s) * (1.f / D) + NORM_EPS);
            v2u* o8 = (v2u*)(WSP(A,bf16,WS_XN) + (size_t)(m0 + i) * D) + lane;
#pragma unroll
            for (int j = 0; j < 4; ++j) { v2u o; o.x = pk2(v[i][j].x * rs * w[j].x, v[i][j].y * rs * w[j].y); o.y = pk2(v[i][j].z * rs * w[j].z, v[i][j].w * rs * w[j].w); o8[64 * j] = o; } }
    }
}

__device__ __forceinline__ void p2_prep2(Frame& F, const Args& A) {
    LAS float* PART = (LAS float*)(F.lds + RING_OFF); LAS float* LOG = (LAS float*)(F.lds + RING_OFF + 33792);
    const int lane = F.lane, wave = F.wave, tid = F.tid;
    float qw[16], kw[16];
#pragma unroll
    for (int q = 0; q < 4; ++q) { const f32x4 a = *(const f32x4*)(IN_QNW(A) + 16 * (lane & 3) + 4 * q), b = *(const f32x4*)(IN_KNW(A) + 16 * (lane & 3) + 4 * q);
#pragma unroll
        for (int i = 0; i < 4; ++i) { qw[4 * q + i] = a[i] * QSCALE; kw[4 * q + i] = b[i]; } }
    for (int blk = F.vcu; blk < M / 64; blk += F.G) {
        tile_dot32<false, true>(F, WSP(A,bf16,WS_XN) + (size_t)blk * 64 * D, nullptr, D, WSP(A,bf16,WS_WDH), WSP(A,bf16,WS_WDL), PART, LOG);
#pragma unroll
        for (int q = 0; q < 4; ++q) { const int idx = tid + 512 * q, tok = idx >> 5, e = idx & 31; const float z = LOG[tok * 33 + e] + IN_DTB(A)[e];
            WSP(A,float,WS_DT)[(size_t)(blk * 64 + tok) * 32 + e] = fmaxf(z, 0.f) + log1pf(__expf(-fabsf(z))); }
        const int t0 = blk * 64 + wave * 8, b = t0 / SEQ, mb = (t0 % SEQ) / MBLK, pos0 = t0 % SEQ;
        float km[16];
#pragma unroll
        for (int i = 0; i < 16; ++i) km[i] = 0.f;
#pragma unroll 1
        for (int bt = 0; bt < 2; ++bt) {
            v4u qa[4][2], ka[4][2];
#pragma unroll
            for (int i = 0; i < 4; ++i) { bf16* prow = WSP(A,bf16,WS_PROJ) + (size_t)(t0 + 4 * bt + i) * NPROJ + 16 * lane;
                qa[i][0] = *(const v4u*)(prow + PQ); qa[i][1] = *(const v4u*)(prow + PQ + 8); ka[i][0] = *(const v4u*)(prow + PK); ka[i][1] = *(const v4u*)(prow + PK + 8); }
#pragma unroll
            for (int i = 0; i < 4; ++i) { bf16* prow = WSP(A,bf16,WS_PROJ) + (size_t)(t0 + 4 * bt + i) * NPROJ + 16 * lane;
                { float lo[8], hi[8]; unpk8(qa[i][0], lo); unpk8(qa[i][1], hi); float ss = 0.f;
#pragma unroll
                  for (int c = 0; c < 8; ++c) ss += lo[c] * lo[c] + hi[c] * hi[c];
                  ss += __shfl_xor(ss, 1); ss += __shfl_xor(ss, 2); const float rs = 1.0f / sqrtf(ss * (1.f / 64.f) + NORM_EPS);
#pragma unroll
                  for (int c = 0; c < 8; ++c) { lo[c] = lo[c] * rs * qw[c]; hi[c] = hi[c] * rs * qw[8 + c]; }
                  *(v4u*)(prow + PQ) = pack8(lo); *(v4u*)(prow + PQ + 8) = pack8(hi); }
                { float lo[8], hi[8]; unpk8(ka[i][0], lo); unpk8(ka[i][1], hi); float ss = 0.f;
#pragma unroll
                  for (int c = 0; c < 8; ++c) ss += lo[c] * lo[c] + hi[c] * hi[c];
                  ss += __shfl_xor(ss, 1); ss += __shfl_xor(ss, 2); const float rs = 1.0f / sqrtf(ss * (1.f / 64.f) + NORM_EPS);
#pragma unroll
                  for (int c = 0; c < 8; ++c) { lo[c] = lo[c] * rs * kw[c]; hi[c] = hi[c] * rs * kw[8 + c]; km[c] += lo[c]; km[8 + c] += hi[c]; }
                  *(v4u*)(prow + PK) = pack8(lo); *(v4u*)(prow + PK + 8) = pack8(hi); } }
        }
        { float* kmp = WSP(A,float,WS_KM) + ((size_t)(b * NH + (lane >> 2)) * NBLK + mb) * HD + 16 * (lane & 3);
#pragma unroll
          for (int i = 0; i < 16; ++i) unsafeAtomicAdd(kmp + i, km[i] * (1.f / MBLK)); }
#pragma unroll 1
        for (int g6 = 0; g6 < 6; ++g6) {
            const int c0 = g6 * 512 + 8 * lane;
            v4u rw[11];
#pragma unroll
            for (int i = 0; i < 11; ++i) { rw[i] = (v4u){0u, 0u, 0u, 0u}; if (pos0 - 3 + i >= 0) rw[i] = *(const v4u*)(WSP(A,bf16,WS_PROJ) + (size_t)(t0 - 3 + i) * NPROJ + PXBC + c0); }
            float wv[4][8], bv[8];
#pragma unroll
            for (int j = 0; j < 4; ++j) { const f32x4 w0 = *(const f32x4*)(IN_CONVW(A) + j * D_XBC + c0), w1 = *(const f32x4*)(IN_CONVW(A) + j * D_XBC + c0 + 4);
#pragma unroll
                for (int c = 0; c < 4; ++c) { wv[j][c] = w0[c]; wv[j][4 + c] = w1[c]; } }
            { const f32x4 b0 = *(const f32x4*)(IN_CONVB(A) + c0), b1 = *(const f32x4*)(IN_CONVB(A) + c0 + 4);
#pragma unroll
              for (int c = 0; c < 4; ++c) { bv[c] = b0[c]; bv[4 + c] = b1[c]; } }
            float acc[8][8];
#pragma unroll
            for (int o = 0; o < 8; ++o)
#pragma unroll
                for (int c = 0; c < 8; ++c) acc[o][c] = bv[c];
#pragma unroll
            for (int i = 0; i < 11; ++i) { float xv[8]; unpk8(rw[i], xv);
#pragma unroll
                for (int j = 0; j < 4; ++j) { const int o = i - j; if (o >= 0 && o < 8) {
#pragma unroll
                    for (int c = 0; c < 8; ++c) acc[o][c] += wv[j][c] * xv[c]; } } }
#pragma unroll
            for (int o = 0; o < 8; ++o) {
#pragma unroll
                for (int c = 0; c < 8; ++c) acc[o][c] = silu_f(acc[o][c]);
                *(v4u*)(WSP(A,bf16,WS_XC) + (size_t)(t0 + o) * D_XBC + c0) = pack8(acc[o]); }
        }
        __syncthreads();
    }
}

__device__ __forceinline__ void p4_norm2(Frame& F, const Args& A) {
    const int lane = F.lane, gw = F.vcu * NWAVES + F.wave, NGW = F.G * NWAVES;
    f32x4 nw[8];
#pragma unroll
    for (int q = 0; q < 8; ++q) nw[q] = *(const f32x4*)(IN_SSDNW(A) + 32 * lane + 4 * q);
    for (int t0 = gw * 4; t0 < M; t0 += NGW * 4) {
        float sq[4]; v4u rv[4][4];
#pragma unroll
        for (int i = 0; i < 4; ++i) { sq[i] = WSP(A,float,WS_SSQ)[(size_t)(t0 + i) * 64 + lane];
#pragma unroll
            for (int q = 0; q < 4; ++q) rv[i][q] = *(const v4u*)(WSP(A,bf16,WS_YG) + (size_t)(t0 + i) * D_INNER + 32 * lane + 8 * q); }
#pragma unroll
        for (int i = 0; i < 4; ++i) { float ss = sq[i]; ss += __shfl_xor(ss, 1); ss += __shfl_xor(ss, 2); ss += __shfl_xor(ss, 4); ss += __shfl_xor(ss, 8);
            const float rs = 1.0f / sqrtf(ss * (1.f / 512.f) + NORM_EPS);
#pragma unroll
            for (int q = 0; q < 4; ++q) { float v[8]; unpk8(rv[i][q], v);
#pragma unroll
                for (int c = 0; c < 4; ++c) { v[c] = v[c] * rs * nw[2 * q][c]; v[4 + c] = v[4 + c] * rs * nw[2 * q + 1][c]; }
                *(v4u*)(WSP(A,bf16,WS_YG) + (size_t)(t0 + i) * D_INNER + 32 * lane + 8 * q) = pack8(v); } }
    }
}

__device__ __forceinline__ void p7_route2(Frame& F, const Args& A) {
    LAS float* PART = (LAS float*)(F.lds + RING_OFF); LAS float* LOG = (LAS float*)(F.lds + RING_OFF + 33792);
    const int lane = F.lane, wave = F.wave;
    f32x4 w[4];
#pragma unroll
    for (int j = 0; j < 4; ++j) w[j] = ((const f32x4*)IN_LN2W(A))[lane + 64 * j];
    const float brl = IN_BR(A)[lane & 31];
    for (int blk = F.vcu; blk < M / 64; blk += F.G) {
        const int t0 = blk * 64 + wave * 8;
#pragma unroll 1
        for (int bt = 0; bt < 2; ++bt) {
            f32x4 v[4][4];
#pragma unroll
            for (int i = 0; i < 4; ++i)
#pragma unroll
                for (int j = 0; j < 4; ++j) v[i][j] = ((const f32x4*)((A).out + (size_t)(t0 + 4 * bt + i) * D))[lane + 64 * j];
#pragma unroll
            for (int i = 0; i < 4; ++i) { float s = 0.f;
#pragma unroll
                for (int j = 0; j < 4; ++j) s += (v[i][j].x * v[i][j].x + v[i][j].y * v[i][j].y) + (v[i][j].z * v[i][j].z + v[i][j].w * v[i][j].w);
                const float rs = 1.0f / sqrtf(wave_sum(s) * (1.f / D) + NORM_EPS);
                v2u* oh = (v2u*)(WSP(A,bf16,WS_H2) + (size_t)(t0 + 4 * bt + i) * D) + lane; v2u* ol = (v2u*)(WSP(A,bf16,WS_H2LO) + (size_t)(t0 + 4 * bt + i) * D) + lane;
#pragma unroll
                for (int j = 0; j < 4; ++j) { float h[4] = {v[i][j].x * rs * w[j].x, v[i][j].y * rs * w[j].y, v[i][j].z * rs * w[j].z, v[i][j].w * rs * w[j].w}; unsigned hb[4], lb[4];
#pragma unroll
                    for (int c = 0; c < 4; ++c) { hb[c] = f2bf(h[c]); lb[c] = f2bf(h[c] - __uint_as_float(hb[c] << 16)); }
                    v2u o; o.x = hb[0] | (hb[1] << 16); o.y = hb[2] | (hb[3] << 16); oh[64 * j] = o; o.x = lb[0] | (lb[1] << 16); o.y = lb[2] | (lb[3] << 16); ol[64 * j] = o; } }
        }
        VM_WAIT(); __syncthreads();
        tile_dot32<true, true>(F, WSP(A,bf16,WS_H2) + (size_t)blk * 64 * D, WSP(A,bf16,WS_H2LO) + (size_t)blk * 64 * D, D, WSP(A,bf16,WS_WRH), WSP(A,bf16,WS_WRL), PART, LOG);
        int my_e = 0, my_a = 0; float my_g = 0.f;
#pragma unroll
        for (int i = 0; i < 8; ++i) { const int tok = 8 * wave + i;
            float val = (lane < 32) ? LOG[tok * 33 + (lane & 31)] + brl : -3.0e38f;
            float tv[4]; int ti[4];
#pragma unroll
            for (int k = 0; k < 4; ++k) { const float mx = wave_max(val); const unsigned long long bm = __ballot(val == mx); const int idx = __builtin_ctzll(bm);
                tv[k] = mx; ti[k] = idx; if (lane == idx) val = -3.0e38f; }
            float ex[4], es = 0.f;
#pragma unroll
            for (int k = 0; k < 4; ++k) { ex[k] = __expf(tv[k] - tv[0]); es += ex[k]; }
            const float ies = 1.0f / es;
#pragma unroll
            for (int k = 0; k < 4; ++k) if (lane == 4 * i + k) { my_e = ti[k]; my_g = ex[k] * ies; my_a = (blk * 64 + tok) * 4 + k; } }
        if (lane < 32) { const unsigned j = __hip_atomic_fetch_add((WSP(A,unsigned,WS_CTL) + CW_CNT) + my_e, 1u, RLX_AGENT); WSP(A,int,WS_TOKL)[my_e * EXPCAP + (int)j] = my_a; WSP(A,float,WS_GATEW)[my_a] = my_g; }
        __syncthreads();
    }
}

__device__ __forceinline__ void p8_gather2(Frame& F, const Args& A) {
    const int NT = moe_tables(F, A);
    const LAS int* rowb = (const LAS int*)(F.lds + ROWB_OFF); const LAS int* cntl = (const LAS int*)(F.lds + CNTL_OFF);
    const int lane = F.lane, gw = F.vcu * NWAVES + F.wave, NGW = F.G * NWAVES, total = NT * 256;
    for (int r0 = gw * 4; r0 < total; r0 += NGW * 4) {
        int aa[4]; bool ok[4];
#pragma unroll
        for (int i = 0; i < 4; ++i) { const int r = r0 + i; int e = 0;
#pragma unroll
            for (int q = 1; q < NEXP; ++q) e += (rowb[q] <= r) ? 1 : 0;
            const int j = r - rowb[e]; ok[i] = j < cntl[e]; aa[i] = ok[i] ? WSP(A,int,WS_TOKL)[e * EXPCAP + j] : 0; }
        v4u x0[4], x1[4]; float gv[4];
#pragma unroll
        for (int i = 0; i < 4; ++i) { const bf16* src = WSP(A,bf16,WS_H2) + (size_t)(aa[i] >> 2) * D + 16 * lane; x0[i] = *(const v4u*)src; x1[i] = *(const v4u*)(src + 8); gv[i] = WSP(A,float,WS_GATEW)[aa[i]]; }
#pragma unroll
        for (int i = 0; i < 4; ++i) { const int r = r0 + i;
            if (ok[i]) { *(v4u*)(WSP(A,bf16,WS_XG) + (size_t)r * D + 16 * lane) = x0[i]; *(v4u*)(WSP(A,bf16,WS_XG) + (size_t)r * D + 16 * lane + 8) = x1[i];
                if (lane == 0) { WSP(A,float,WS_ROWW)[r] = gv[i]; WSP(A,int,WS_POS)[aa[i]] = r; } }
            else if (lane == 0) WSP(A,float,WS_ROWW)[r] = 0.f; }
    }
    __syncthreads();
}

__device__ __forceinline__ void p11_combine2(Frame& F, const Args& A) {
    const int lane = F.lane, gw = F.vcu * NWAVES + F.wave, NGW = F.G * NWAVES;
    for (int t0 = gw * 2; t0 < M; t0 += NGW * 2) {
        int rr[2][4]; f32x4 v[2][4]; v2u y[2][4][4];
#pragma unroll
        for (int i = 0; i < 2; ++i)
#pragma unroll
            for (int k = 0; k < 4; ++k) rr[i][k] = WSP(A,int,WS_POS)[(t0 + i) * 4 + k];
#pragma unroll
        for (int i = 0; i < 2; ++i) {
#pragma unroll
            for (int j = 0; j < 4; ++j) v[i][j] = ((const f32x4*)((A).out + (size_t)(t0 + i) * D))[lane + 64 * j];
#pragma unroll
            for (int k = 0; k < 4; ++k)
#pragma unroll
                for (int j = 0; j < 4; ++j) y[i][k][j] = ((const v2u*)(WSP(A,bf16,WS_Y) + (size_t)rr[i][k] * D))[lane + 64 * j]; }
#pragma unroll
        for (int i = 0; i < 2; ++i) {
#pragma unroll
            for (int j = 0; j < 4; ++j) { f32x4 s = v[i][j];
#pragma unroll
                for (int k = 0; k < 4; ++k) { const v2u w = y[i][k][j]; s.x += __uint_as_float(w.x << 16); s.y += __uint_as_float(w.x & 0xffff0000u); s.z += __uint_as_float(w.y << 16); s.w += __uint_as_float(w.y & 0xffff0000u); }
                ((f32x4*)((A).out + (size_t)(t0 + i) * D))[lane + 64 * j] = s; } }
    }
}
__global__ void __launch_bounds__(NWAVES * 64, 2) mk_fwd(Args args) {
    extern __shared__ __attribute__((aligned(16))) unsigned char lds[];
    Frame F;
    F.lds = (LAS unsigned char*)lds;
    F.MISC = (volatile LAS unsigned*)(F.lds + MISC_OFF);
    F.tid = threadIdx.x; F.lane = F.tid & 63; F.wave = __builtin_amdgcn_readfirstlane(F.tid >> 6);
    F.G = gridDim.x; { const int bx = blockIdx.x; F.vcu = (F.G % 8 == 0) ? (bx % 8) * (F.G / 8) + bx / 8 : bx; }
    const Args& A = args;
    F.ctl = (gu32*)(args.ws + WS_CTL);
    for (int u = F.tid; u < (LDS_BYTES - LDSCTL_OFF) / 4; u += NWAVES * 64) ((LAS unsigned*)(F.lds + LDSCTL_OFF))[u] = 0u;
    __syncthreads();
    XcdBarrier bar; bar.bar = (unsigned*)(F.ctl + CW_BAR); bar.x = 0; bar.st = nullptr;
    if (!MK_PER_PHASE) bar = xcd_barrier_post((unsigned*)(F.ctl + CW_BAR), F.MISC + 8);
    const int lo = args.ph_lo, hi = args.ph_hi;
#ifndef PH_MASK
#define PH_MASK 0xFFF
#endif
#define IN(k) ((((PH_MASK) >> (k)) & 1) && lo <= (k) && (k) < hi)
#define SEAM(k) do { if (!MK_PER_PHASE && IN(k) && IN((k) + 1)) xcd_barrier(bar); } while (0)

    if (IN(PH_PRO)) { for (int rep = 0; rep < (1 + (((REP_MASK) >> PH_PRO) & 1)); ++rep) p0_prologue(F, A); p0_tail(F, A); SEAM(PH_PRO); }
    if (IN(PH_INPROJ)) for (int rep = 0; rep < REP(PH_INPROJ); ++rep) {
        pg8::Gemm g{WSP(A,bf16,WS_XN), WSP(A,bf16,WS_WIN), M, NPROJ, D}; pg8::StaticOrder S; S.init(M, NPROJ, F.G, (int)blockIdx.x);
        pg8::EpiPlain E{WSP(A,bf16,WS_PROJ), NPROJ};
        pg8::gemm_phase<pg8::EpiPlain, pg8::StaticOrder, true, true>(F.lds + RING_OFF, g, S, E);
        if (rep == REP(PH_INPROJ) - 1) SEAM(PH_INPROJ);
    }
    if (IN(PH_PREP)) { p2_prep2(F, A); SEAM(PH_PREP); }
    if (IN(PH_SSD)) {
#if SSD_SIMPLE
        p3_ssd(F, A);
#else
        for (int rep = 0; rep < REP(PH_SSD); ++rep) p3_ssd_mfma(F, A);
#endif
        SEAM(PH_SSD); }
    if (IN(PH_ATTN)) { p4_norm2(F, A);
#if ATTN_SIMPLE
        attn_simple(F, A);
#else
        for (int rep = 0; rep < REP(PH_ATTN); ++rep) attn_mfma(F, A);
#endif
        SEAM(PH_ATTN); }
    if (IN(PH_OPROJ)) for (int rep = 0; rep < REP(PH_OPROJ); ++rep) {
        { pg8::Gemm g{WSP(A,bf16,WS_AO), WSP(A,bf16,WS_WOA), M, D, D}; pg8::StaticOrder S; S.init(M, D, F.G, (int)blockIdx.x);
          pg8::EpiGate1 E{WSP(A,bf16,WS_PROJ) + PGATE, NPROJ, IN_GATEB(A), WSP(A,float,WS_MIXF)};
          pg8::gemm_phase<pg8::EpiGate1, pg8::StaticOrder, true, true>(F.lds + RING_OFF, g, S, E); }
        { pg8::Gemm g{WSP(A,bf16,WS_YG), WSP(A,bf16,WS_WOS), M, D, D_INNER}; pg8::StaticOrder S; S.init(M, D, F.G, (int)blockIdx.x);
          pg8::EpiGate2 E{WSP(A,bf16,WS_PROJ) + PGATE + D, NPROJ, IN_GATEB(A) + D, WSP(A,float,WS_MIXF), WSP(A,bf16,WS_MIX)};
          pg8::gemm_phase<pg8::EpiGate2, pg8::StaticOrder, true, true>(F.lds + RING_OFF, g, S, E); }
        if (rep == REP(PH_OPROJ) - 1) SEAM(PH_OPROJ);
    }
    if (IN(PH_WOUT)) for (int rep = 0; rep < REP(PH_WOUT); ++rep) {
        pg8::Gemm g{WSP(A,bf16,WS_MIX), WSP(A,bf16,WS_WOUT), M, D, D}; pg8::StaticOrder S; S.init(M, D, F.G, (int)blockIdx.x);
        pg8::EpiResid E{IN_X(A), (A).out};
        pg8::gemm_phase<pg8::EpiResid, pg8::StaticOrder, true, true>(F.lds + RING_OFF, g, S, E);
        if (rep == REP(PH_WOUT) - 1) SEAM(PH_WOUT);
    }
    if (IN(PH_ROUTE)) { p7_route2(F, A); SEAM(PH_ROUTE); }
    if (IN(PH_GATHER)) { p8_gather2(F, A); SEAM(PH_GATHER); }
    if (IN(PH_GU)) for (int rep = 0; rep < REP(PH_GU); ++rep) {
        const int NT = moe_tables(F, A);
        pg8::Gemm g{WSP(A,bf16,WS_XG), WSP(A,bf16,WS_WGU), NT * 256, 2048, D}; pg8::GroupedOrder S{8, NT, F.G, (int)blockIdx.x, (const LAS int*)(F.lds + TILEE_OFF)};
        pg8::EpiSwiglu E{WSP(A,bf16,WS_ACT), IN_BGU(A)};
        pg8::gemm_phase<pg8::EpiSwiglu, pg8::GroupedOrder, true, true>(F.lds + RING_OFF, g, S, E);
        if (rep == REP(PH_GU) - 1) SEAM(PH_GU);
    }
    if (IN(PH_DOWN)) for (int rep = 0; rep < REP(PH_DOWN); ++rep) {
        const int NT = moe_tables(F, A);
        pg8::Gemm g{WSP(A,bf16,WS_ACT), WSP(A,bf16,WS_WDN), NT * 256, 1024, D}; pg8::GroupedOrder S{4, NT, F.G, (int)blockIdx.x, (const LAS int*)(F.lds + TILEE_OFF)};
        pg8::EpiDown E{WSP(A,bf16,WS_Y), IN_BDN(A), WSP(A,float,WS_ROWW)};
        pg8::gemm_phase<pg8::EpiDown, pg8::GroupedOrder, true, true>(F.lds + RING_OFF, g, S, E);
        if (rep == REP(PH_DOWN) - 1) SEAM(PH_DOWN);
    }
    if (IN(PH_COMB)) { p11_combine2(F, A); }
#undef IN
#undef SEAM
}

extern "C" void kernel_launch(void* const* d_in, const int* in_sizes, int n_in, void* d_out, int out_size, void* d_ws, size_t ws_size, hipStream_t stream) {
    static int grid = 0;
    if (grid == 0) {
        if (n_in != 22 || in_sizes[0] != M * D || out_size != M * D || ws_size < WS_END) { fprintf(stderr, "kernel_launch: unexpected shapes / workspace (n_in %d, in0 %d, out %d, ws %zu, need %zu); nothing launched\n", n_in, n_in > 0 ? in_sizes[0] : -1, out_size, ws_size, (size_t)WS_END); grid = -1; return; }
        int dev = 0, cus = 0, per_cu = 0;
        if (hipGetDevice(&dev) != hipSuccess || hipDeviceGetAttribute(&cus, hipDeviceAttributeMultiprocessorCount, dev) != hipSuccess) { fprintf(stderr, "kernel_launch: device query failed\n"); grid = -1; return; }
        if (hipFuncSetAttribute((const void*)mk_fwd, hipFuncAttributeMaxDynamicSharedMemorySize, LDS_BYTES) != hipSuccess) { fprintf(stderr, "kernel_launch: hipFuncSetAttribute failed\n"); grid = -1; return; }
        if (hipOccupancyMaxActiveBlocksPerMultiprocessor(&per_cu, (const void*)mk_fwd, NWAVES * 64, LDS_BYTES) != hipSuccess || per_cu < 1) fprintf(stderr, "kernel_launch: note: occupancy query reports %d blocks per CU\n", per_cu);
        (void)hipGetLastError();
        grid = cus;
    }
    if (grid < 0) return;
    if (hipMemsetAsync((char*)d_ws + WS_CTL, 0, CTL_ZERO_BYTES, stream) != hipSuccess) { fprintf(stderr, "kernel_launch: memset failed\n"); return; }
    Args a{};
    for (int i = 0; i < 22; ++i) a.in[i] = (const float*)d_in[i];
    a.out = (float*)d_out; a.ws = (unsigned char*)d_ws;
#if MK_PER_PHASE
    for (int p = 0; p < N_PHASES; ++p) { a.ph_lo = p; a.ph_hi = p + 1; hipLaunchKernelGGL(mk_fwd, dim3(grid), dim3(NWAVES * 64), LDS_BYTES, stream, a); }
#else
    a.ph_lo = 0; a.ph_hi = N_PHASES;
    hipLaunchKernelGGL(mk_fwd, dim3(grid), dim3(NWAVES * 64), LDS_BYTES, stream, a);
#endif
    const hipError_t le = hipPeekAtLastError();
    if (le != hipSuccess) fprintf(stderr, "kernel_launch: launch failed: %s\n", hipGetErrorName(le));
}
```

```cpp
#include <hip/hip_runtime.h>
#include <cstdio>
#include <cstdint>
namespace pg8 {
#define PG8_LAS __attribute__((address_space(3)))
typedef unsigned short bf16_t;
typedef short bf16x8 __attribute__((ext_vector_type(8)));
typedef float f32x4 __attribute__((ext_vector_type(4)));
typedef unsigned u32x4 __attribute__((ext_vector_type(4)));
constexpr int BM = 256, BK = 64, HALF = 128, HTB = HALF * BK * 2  , STAGE_BYTES = 8 * HTB, NXCD = 8, WGM = 4;

__host__ __device__ __forceinline__ int lds_byte(int r, int c) { const int st = (r >> 4) * 2 + (c >> 5), rr = r & 15, cc = c & 31, ob = rr * 64 + cc * 2; return st * 1024 + (ob ^ (((ob >> 9) & 1) << 5)); }
__host__ __device__ __forceinline__ void stage_rc(int b, int& R, int& C) { const int st = b / 1024, sb = b % 1024, swz = sb ^ (((sb >> 9) & 1) << 5); R = (st >> 1) * 16 + swz / 64; C = (st & 1) * 32 + (swz % 64) / 2; }
__host__ __device__ __forceinline__ int perm32(int rho) { const int n = rho >> 4, i = rho & 15; return 8 * (i >> 2) + 4 * n + (i & 3); }

struct Unit { int pm, pn; };
struct Gemm { const bf16_t* A; const bf16_t* Bt; int M, N, K; };

struct StaticOrder {
    int nM, nN, nwg, G, c;
    __host__ __device__ __forceinline__ void init(int M, int N, int G_, int c_) { nM = M / BM; nN = N / BM; nwg = nM * nN; G = G_; c = c_; }
    __host__ __device__ __forceinline__ bool next(int i, Unit& u) const {
        const long L = (long)i * G + c; if (L >= nwg) return false;
        int wgid = (int)L; { const int q = nwg / NXCD, r = nwg % NXCD, xcd = wgid % NXCD, off = wgid / NXCD; wgid = (xcd < r ? xcd * (q + 1) : r * (q + 1) + (xcd - r) * q) + off; }
        const int nig = WGM * nN, gid = wgid / nig, fm = gid * WGM, gsz = (nM - fm) < WGM ? (nM - fm) : WGM;
        u.pm = fm + ((wgid % nig) % gsz); u.pn = (wgid % nig) / gsz; return true;
    }
    __device__ __forceinline__ void a_ready(const Unit&) const {}
    __device__ __forceinline__ void done(const Unit&) const {}
};

struct GroupedOrder {
    int nN, NT, G, c; const PG8_LAS int* tile_e;
    __device__ __forceinline__ bool next(int i, Unit& u) const {
        const long L = (long)i * G + c; const int nwg = NT * nN; if (L >= nwg) return false;
        int wgid = (int)L; { const int q = nwg / NXCD, r = nwg % NXCD, xcd = wgid % NXCD, off = wgid / NXCD; wgid = (xcd < r ? xcd * (q + 1) : r * (q + 1) + (xcd - r) * q) + off; }
        const int rt = wgid / nN, pl = wgid % nN;
        u.pm = rt; u.pn = tile_e[rt] * nN + pl; return true;
    }
    __device__ __forceinline__ void a_ready(const Unit&) const {}
    __device__ __forceinline__ void done(const Unit&) const {}
};

struct TableOrder {
    int n; const PG8_LAS int* tab;
    __device__ __forceinline__ bool next(int i, Unit& u) const { if (i >= n) return false; u.pm = tab[2 * i]; u.pn = tab[2 * i + 1]; return true; }
    __device__ __forceinline__ void a_ready(const Unit&) const {}
    __device__ __forceinline__ void done(const Unit&) const {}
};

__device__ __forceinline__ unsigned cvt_pk_bf16(float lo, float hi) { unsigned r; asm volatile("v_cvt_pk_bf16_f32 %0, %1, %2" : "=v"(r) : "v"(lo), "v"(hi)); return r; }
__device__ __forceinline__ float sigm(float x) { return __builtin_amdgcn_rcpf(1.f + __builtin_amdgcn_exp2f(-1.44269504f * x)); }
__device__ __forceinline__ void unpack8(const u32x4 w, float (&f)[8]) {
#pragma unroll
    for (int i = 0; i < 4; ++i) { f[2 * i] = __uint_as_float(w[i] << 16); f[2 * i + 1] = __uint_as_float(w[i] & 0xffff0000u); }
}
struct EpiPlain {
    static constexpr bool PERM = true, AFTER_DRAIN = false, KHOOK = false; static constexpr int PID = 1; bf16_t* O; int ldc;
    __device__ __forceinline__ void operator()(const f32x4 (&acc)[2][2][4][2], const Unit& u, int wr, int wc, int fr, int fq) const {
        const int row0 = u.pm * BM + wr * 64 + fr, col0 = u.pn * BM + wc * 32 + 8 * fq;
#pragma unroll
        for (int ai = 0; ai < 2; ++ai)
#pragma unroll
            for (int m = 0; m < 4; ++m) { bf16_t* rowp = O + (size_t)(row0 + ai * HALF + m * 16) * ldc + col0;
#pragma unroll
                for (int bj = 0; bj < 2; ++bj) { const f32x4 v0 = acc[ai][bj][m][0], v1 = acc[ai][bj][m][1]; u32x4 w;
                    w.x = cvt_pk_bf16(v0[0], v0[1]); w.y = cvt_pk_bf16(v0[2], v0[3]); w.z = cvt_pk_bf16(v1[0], v1[1]); w.w = cvt_pk_bf16(v1[2], v1[3]);
                    *(u32x4*)(rowp + bj * HALF) = w; } }
    }
};
struct EpiGate1 {
    static constexpr bool PERM = true, AFTER_DRAIN = false, KHOOK = false; static constexpr int PID = 2; const bf16_t* Gp; int ldg; const float* gb; bf16_t* MIXF;
    __device__ __forceinline__ void operator()(const f32x4 (&acc)[2][2][4][2], const Unit& u, int wr, int wc, int fr, int fq) const {
        const int row0 = u.pm * BM + wr * 64 + fr, col0 = u.pn * BM + wc * 32 + 8 * fq;
        f32x4 bb[2][2];
#pragma unroll
        for (int bj = 0; bj < 2; ++bj) { bb[bj][0] = *(const f32x4*)(gb + col0 + bj * HALF); bb[bj][1] = *(const f32x4*)(gb + col0 + bj * HALF + 4); }
#pragma unroll
        for (int ai = 0; ai < 2; ++ai)
#pragma unroll
            for (int m = 0; m < 4; ++m) { const size_t row = (size_t)(row0 + ai * HALF + m * 16);
                u32x4 gl[2];
#pragma unroll
                for (int bj = 0; bj < 2; ++bj) gl[bj] = *(const u32x4*)(Gp + row * ldg + col0 + bj * HALF);
#pragma unroll
                for (int bj = 0; bj < 2; ++bj) { const int c = col0 + bj * HALF; float g[8]; unpack8(gl[bj], g);
                    const f32x4 v0 = acc[ai][bj][m][0], v1 = acc[ai][bj][m][1]; f32x4 o0, o1;
#pragma unroll
                    for (int i = 0; i < 4; ++i) { o0[i] = sigm(g[i] + bb[bj][0][i]) * v0[i]; o1[i] = sigm(g[4 + i] + bb[bj][1][i]) * v1[i]; }
                    u32x4 w; w.x = cvt_pk_bf16(o0[0], o0[1]); w.y = cvt_pk_bf16(o0[2], o0[3]); w.z = cvt_pk_bf16(o1[0], o1[1]); w.w = cvt_pk_bf16(o1[2], o1[3]); *(u32x4*)(MIXF + row * 1024 + c) = w; } }
    }
};
struct EpiGate2 {
    static constexpr bool PERM = true, AFTER_DRAIN = false, KHOOK = false; static constexpr int PID = 9; const bf16_t* Gp; int ldg; const float* gb; const float* MIXF; bf16_t* MIX;
    __device__ __forceinline__ void operator()(const f32x4 (&acc)[2][2][4][2], const Unit& u, int wr, int wc, int fr, int fq) const {
        const int row0 = u.pm * BM + wr * 64 + fr, col0 = u.pn * BM + wc * 32 + 8 * fq;
#pragma unroll
        for (int ai = 0; ai < 2; ++ai)
#pragma unroll
            for (int m = 0; m < 4; ++m) { const size_t row = (size_t)(row0 + ai * HALF + m * 16);
#pragma unroll
                for (int bj = 0; bj < 2; ++bj) { const int c = col0 + bj * HALF; float g[8]; unpack8(*(const u32x4*)(Gp + row * ldg + c), g);
                    const f32x4 b0 = *(const f32x4*)(gb + c), b1 = *(const f32x4*)(gb + c + 4); const f32x4 v0 = acc[ai][bj][m][0], v1 = acc[ai][bj][m][1];
                    const f32x4 p0 = *(const f32x4*)(MIXF + row * 1024 + c), p1 = *(const f32x4*)(MIXF + row * 1024 + c + 4); f32x4 o0, o1;
#pragma unroll
                    for (int i = 0; i < 4; ++i) { o0[i] = p0[i] + sigm(g[i] + b0[i]) * v0[i]; o1[i] = p1[i] + sigm(g[4 + i] + b1[i]) * v1[i]; }
                    u32x4 w; w.x = cvt_pk_bf16(o0[0], o0[1]); w.y = cvt_pk_bf16(o0[2], o0[3]); w.z = cvt_pk_bf16(o1[0], o1[1]); w.w = cvt_pk_bf16(o1[2], o1[3]);
                    *(u32x4*)(MIX + row * 1024 + c) = w; } }
    }
};
struct EpiResid {
    static constexpr bool PERM = true, AFTER_DRAIN = false, KHOOK = false; static constexpr int PID = 4; const float* base; float* out;
    __device__ __forceinline__ void operator()(const f32x4 (&acc)[2][2][4][2], const Unit& u, int wr, int wc, int fr, int fq) const {
        const int row0 = u.pm * BM + wr * 64 + fr, col0 = u.pn * BM + wc * 32 + 8 * fq;
#pragma unroll
        for (int ai = 0; ai < 2; ++ai)
#pragma unroll
            for (int mp = 0; mp < 2; ++mp) {
                f32x4 xl[2][2][2];
#pragma unroll
                for (int mm = 0; mm < 2; ++mm)
#pragma unroll
                    for (int bj = 0; bj < 2; ++bj) { const size_t o = (size_t)(row0 + ai * HALF + (2 * mp + mm) * 16) * 1024 + col0 + bj * HALF; xl[mm][bj][0] = *(const f32x4*)(base + o); xl[mm][bj][1] = *(const f32x4*)(base + o + 4); }
#pragma unroll
                for (int mm = 0; mm < 2; ++mm)
#pragma unroll
                    for (int bj = 0; bj < 2; ++bj) { const int m = 2 * mp + mm; const size_t o = (size_t)(row0 + ai * HALF + m * 16) * 1024 + col0 + bj * HALF;
                        *(f32x4*)(out + o) = xl[mm][bj][0] + acc[ai][bj][m][0]; *(f32x4*)(out + o + 4) = xl[mm][bj][1] + acc[ai][bj][m][1]; } }
    }
};
struct EpiSwiglu {
    static constexpr bool PERM = true, AFTER_DRAIN = false, KHOOK = false; static constexpr int PID = 7; bf16_t* ACT; const float* bgu;
    __device__ __forceinline__ void operator()(const f32x4 (&acc)[2][2][4][2], const Unit& u, int wr, int wc, int fr, int fq) const {
        const int e = u.pn >> 3, pl = u.pn & 7, j0 = 128 * pl + wc * 32 + 8 * fq; const int row0 = u.pm * BM + wr * 64 + fr;
        float bg[8], bu[8];
        { const float* bs = bgu + (size_t)e * 2048 + 2 * j0;
#pragma unroll
          for (int q = 0; q < 4; ++q) { const f32x4 t = *(const f32x4*)(bs + 4 * q); bg[2 * q] = t[0]; bu[2 * q] = t[1]; bg[2 * q + 1] = t[2]; bu[2 * q + 1] = t[3]; } }
#pragma unroll
        for (int ai = 0; ai < 2; ++ai)
#pragma unroll
            for (int m = 0; m < 4; ++m) { const size_t row = (size_t)(row0 + ai * HALF + m * 16); float a[8];
#pragma unroll
                for (int i = 0; i < 8; ++i) { const float gr = (i < 4 ? acc[ai][0][m][0][i & 3] : acc[ai][0][m][1][i & 3]) + bg[i], ur = (i < 4 ? acc[ai][1][m][0][i & 3] : acc[ai][1][m][1][i & 3]) + bu[i];
                    const float g = fminf(gr, 7.0f), uu = fminf(fmaxf(ur, -7.0f), 7.0f); a[i] = (uu + 1.0f) * (g * sigm(1.702f * g)); }
                u32x4 w; w.x = cvt_pk_bf16(a[0], a[1]); w.y = cvt_pk_bf16(a[2], a[3]); w.z = cvt_pk_bf16(a[4], a[5]); w.w = cvt_pk_bf16(a[6], a[7]);
                *(u32x4*)(ACT + row * 1024 + j0) = w; }
    }
};
struct EpiDown {
    static constexpr bool PERM = true, AFTER_DRAIN = false, KHOOK = false; static constexpr int PID = 8; bf16_t* Y; const float* bd; const float* roww;
    __device__ __forceinline__ void operator()(const f32x4 (&acc)[2][2][4][2], const Unit& u, int wr, int wc, int fr, int fq) const {
        const int e = u.pn >> 2, pl = u.pn & 3, col0 = pl * BM + wc * 32 + 8 * fq; const int row0 = u.pm * BM + wr * 64 + fr;
        f32x4 bb[2][2]; float rw[2][4];
#pragma unroll
        for (int bj = 0; bj < 2; ++bj) { bb[bj][0] = *(const f32x4*)(bd + (size_t)e * 1024 + col0 + bj * HALF); bb[bj][1] = *(const f32x4*)(bd + (size_t)e * 1024 + col0 + bj * HALF + 4); }
#pragma unroll
        for (int ai = 0; ai < 2; ++ai)
#pragma unroll
            for (int m = 0; m < 4; ++m) rw[ai][m] = roww[row0 + ai * HALF + m * 16];
#pragma unroll
        for (int ai = 0; ai < 2; ++ai)
#pragma unroll
            for (int m = 0; m < 4; ++m) { const size_t row = (size_t)(row0 + ai * HALF + m * 16);
#pragma unroll
                for (int bj = 0; bj < 2; ++bj) { const int c = col0 + bj * HALF;
                    const f32x4 v0 = (acc[ai][bj][m][0] + bb[bj][0]) * rw[ai][m], v1 = (acc[ai][bj][m][1] + bb[bj][1]) * rw[ai][m]; u32x4 w;
                    w.x = cvt_pk_bf16(v0[0], v0[1]); w.y = cvt_pk_bf16(v0[2], v0[3]); w.z = cvt_pk_bf16(v1[0], v1[1]); w.w = cvt_pk_bf16(v1[2], v1[3]);
                    *(u32x4*)(Y + row * 1024 + c) = w; } }
    }
};

constexpr float F8_SCALE_H = 16.f, F8_SCALE_W = 64.f, F8_SCALE_ACT = 4.f;
__device__ __forceinline__ unsigned cvt4_fp8(float a, float b, float c, float d) { int w = 0; w = __builtin_amdgcn_cvt_pk_fp8_f32(a, b, w, false); w = __builtin_amdgcn_cvt_pk_fp8_f32(c, d, w, true); return (unsigned)w; }
struct EpiSwiglu8 {
    static constexpr bool PERM = true, AFTER_DRAIN = false, KHOOK = false; static constexpr int PID = 5; unsigned char* ACT; const float* bgu;
    __device__ __forceinline__ void operator()(const f32x4 (&acc)[2][2][4][2], const Unit& u, int wr, int wc, int fr, int fq) const {
        const int e = u.pn >> 3, pl = u.pn & 7, j0 = 128 * pl + wc * 32 + 8 * fq; const int row0 = u.pm * BM + wr * 64 + fr;
        constexpr float DS = 1.0f / (F8_SCALE_H * F8_SCALE_W);
        float bg[8], bu[8];
        { const float* bs = bgu + (size_t)e * 2048 + 2 * j0;
#pragma unroll
          for (int q = 0; q < 4; ++q) { const f32x4 t = *(const f32x4*)(bs + 4 * q); bg[2 * q] = t[0]; bu[2 * q] = t[1]; bg[2 * q + 1] = t[2]; bu[2 * q + 1] = t[3]; } }
#pragma unroll
        for (int ai = 0; ai < 2; ++ai)
#pragma unroll
            for (int m = 0; m < 4; ++m) { const size_t row = (size_t)(row0 + ai * HALF + m * 16); float a[8];
#pragma unroll
                for (int i = 0; i < 8; ++i) { const float gr = (i < 4 ? acc[ai][0][m][0][i & 3] : acc[ai][0][m][1][i & 3]) * DS + bg[i], ur = (i < 4 ? acc[ai][1][m][0][i & 3] : acc[ai][1][m][1][i & 3]) * DS + bu[i];
                    const float g = fminf(gr, 7.0f), uu = fminf(fmaxf(ur, -7.0f), 7.0f); a[i] = fmaf(uu, F8_SCALE_ACT, F8_SCALE_ACT) * (g * __builtin_amdgcn_rcpf(1.f + __builtin_amdgcn_exp2f(g * (-1.702f * 1.44269504f)))); }
                uint2 w; w.x = cvt4_fp8(a[0], a[1], a[2], a[3]); w.y = cvt4_fp8(a[4], a[5], a[6], a[7]);
                *(uint2*)(ACT + row * 1024 + j0) = w; }
    }
};
constexpr float F8_SCALE_Y = 16.f;
__device__ __forceinline__ float f8_sat(float x) { return __builtin_amdgcn_fmed3f(x, -448.f, 448.f); }
struct EpiDown8 {
    static constexpr bool PERM = true, AFTER_DRAIN = false, KHOOK = false; static constexpr int PID = 6; unsigned char* Y; const float* bd; const float* roww;
    __device__ __forceinline__ void operator()(const f32x4 (&acc)[2][2][4][2], const Unit& u, int wr, int wc, int fr, int fq) const {
        const int e = u.pn >> 2, pl = u.pn & 3, col0 = pl * BM + wc * 32 + 8 * fq; const int row0 = u.pm * BM + wr * 64 + fr;
        constexpr float DS = 1.0f / (F8_SCALE_ACT * F8_SCALE_W);
        f32x4 bb[2][2]; float rw[2][4];
#pragma unroll
        for (int bj = 0; bj < 2; ++bj) { bb[bj][0] = *(const f32x4*)(bd + (size_t)e * 1024 + col0 + bj * HALF); bb[bj][1] = *(const f32x4*)(bd + (size_t)e * 1024 + col0 + bj * HALF + 4); }
#pragma unroll
        for (int ai = 0; ai < 2; ++ai)
#pragma unroll
            for (int m = 0; m < 4; ++m) rw[ai][m] = roww[row0 + ai * HALF + m * 16] * F8_SCALE_Y;
#pragma unroll
        for (int ai = 0; ai < 2; ++ai)
#pragma unroll
            for (int m = 0; m < 4; ++m) { const size_t row = (size_t)(row0 + ai * HALF + m * 16);
#pragma unroll
                for (int bj = 0; bj < 2; ++bj) { const int c = col0 + bj * HALF;
                    const f32x4 v0 = (acc[ai][bj][m][0] * DS + bb[bj][0]) * rw[ai][m], v1 = (acc[ai][bj][m][1] * DS + bb[bj][1]) * rw[ai][m];
                    uint2 w; w.x = cvt4_fp8(f8_sat(v0[0]), f8_sat(v0[1]), f8_sat(v0[2]), f8_sat(v0[3])); w.y = cvt4_fp8(f8_sat(v1[0]), f8_sat(v1[1]), f8_sat(v1[2]), f8_sat(v1[3]));
                    *(uint2*)(Y + row * 1024 + c) = w; } }
    }
};

struct EpiGate2H {
    static constexpr bool PERM = true, AFTER_DRAIN = false, KHOOK = true; static constexpr int PID = 3; const bf16_t* Gp; int ldg; const float* gb; const bf16_t* MIXF; bf16_t* MIX; const float* RS;
    __device__ __forceinline__ void khook(f32x4 (&acc)[2][2][4][2], const Unit& u, int t, int wr, int wc, int fr, int fq) const {
        if (t != 8 && t != 16 && t != 24) return;
        const float* rp = RS + (size_t)(u.pm * BM + wr * 64 + fr) * 4 + ((t >> 3) - 1);
#pragma unroll
        for (int ai = 0; ai < 2; ++ai) { float f[4];
#pragma unroll
            for (int m = 0; m < 4; ++m) f[m] = rp[(ai * HALF + m * 16) * 4];
#pragma unroll
            for (int m = 0; m < 4; ++m)
#pragma unroll
                for (int bj = 0; bj < 2; ++bj) { acc[ai][bj][m][0] *= f[m]; acc[ai][bj][m][1] *= f[m]; } }
    }
    __device__ __forceinline__ void operator()(const f32x4 (&acc)[2][2][4][2], const Unit& u, int wr, int wc, int fr, int fq) const {
        const int row0 = u.pm * BM + wr * 64 + fr, col0 = u.pn * BM + wc * 32 + 8 * fq;
        f32x4 bb[2][2];
#pragma unroll
        for (int bj = 0; bj < 2; ++bj) { bb[bj][0] = *(const f32x4*)(gb + col0 + bj * HALF); bb[bj][1] = *(const f32x4*)(gb + col0 + bj * HALF + 4); }
#pragma unroll
        for (int ai = 0; ai < 2; ++ai)
#pragma unroll
            for (int m = 0; m < 4; ++m) { const size_t row = (size_t)(row0 + ai * HALF + m * 16);
                u32x4 gl[2], ml[2];
#pragma unroll
                for (int bj = 0; bj < 2; ++bj) { gl[bj] = *(const u32x4*)(Gp + row * ldg + col0 + bj * HALF); ml[bj] = *(const u32x4*)(MIXF + row * 1024 + col0 + bj * HALF); }
                const float rs3 = RS[row * 4 + 3];
#pragma unroll
                for (int bj = 0; bj < 2; ++bj) { const int c = col0 + bj * HALF; float g[8], pm[8]; unpack8(gl[bj], g); unpack8(ml[bj], pm);
                    const f32x4 v0 = acc[ai][bj][m][0], v1 = acc[ai][bj][m][1]; f32x4 o0, o1;
#pragma unroll
                    for (int i = 0; i < 4; ++i) { o0[i] = pm[i] + sigm(g[i] + bb[bj][0][i]) * rs3 * v0[i]; o1[i] = pm[4 + i] + sigm(g[4 + i] + bb[bj][1][i]) * rs3 * v1[i]; }
                    u32x4 w; w.x = cvt_pk_bf16(o0[0], o0[1]); w.y = cvt_pk_bf16(o0[2], o0[3]); w.z = cvt_pk_bf16(o1[0], o1[1]); w.w = cvt_pk_bf16(o1[2], o1[3]);
                    *(u32x4*)(MIX + row * 1024 + c) = w; } }
    }
};
#ifndef PROBE_SEC
#define PROBE_SEC 0
#endif
#define PG8_T() ((PROBE_SEC) ? __builtin_amdgcn_s_memrealtime() : 0ull)
#define PG8_ADD(sec, t0) do { if (PROBE_SEC == 100 * Epi::PID + (sec)) pb += __builtin_amdgcn_s_memrealtime() - (t0); } while (0)
typedef int i32x8 __attribute__((ext_vector_type(8)));
typedef int i32x4 __attribute__((ext_vector_type(4)));
__device__ __forceinline__ i32x8 cat8(const bf16x8 a, const bf16x8 b) { const i32x4 x = __builtin_bit_cast(i32x4, a), y = __builtin_bit_cast(i32x4, b); return __builtin_shufflevector(x, y, 0, 1, 2, 3, 4, 5, 6, 7); }
template <class Epi, class Sched, bool ALIGN_EPI = false, bool SP2 = false, bool F8 = false>
__device__ __forceinline__ void gemm_phase(PG8_LAS unsigned char* lds, const Gemm g, const Sched& S, const Epi& E, int rot, unsigned long long& pb) {
    const unsigned long long tp_fn = PG8_T(); unsigned long long tp_c = 0ull;
    const int tid = threadIdx.x, wid = __builtin_amdgcn_readfirstlane(tid >> 6), lane = tid & 63, wr = wid >> 2, wc = wid & 3, fr = lane & 15, fq = lane >> 4;
    const int K = g.K, nt = K / BK;
    unsigned voffA[2], voffB[2];
#pragma unroll
    for (int i = 0; i < 2; ++i) { int R, C; stage_rc(tid * 16 + i * 8192, R, C); const int Rb = Epi::PERM ? ((R & ~31) + perm32(R & 31)) : R;
        voffA[i] = (unsigned)(R * K + C) * 2u; voffB[i] = (unsigned)(Rb * K + C) * 2u; }
    const size_t kstep = (size_t)(BK * 2);
    const int kmask = nt - 1;
    const size_t k0o = (size_t)(rot & kmask) * kstep, k1o = (size_t)((rot + 1) & kmask) * kstep;
#define PG8_KO(x) ((size_t)(((x) + rot) & kmask) * kstep)
    const size_t hstep = (size_t)HALF * K * 2;
    const size_t tstep = 2 * hstep;
    const unsigned ldsw = (unsigned)wid * 1024u;
    const int aoff = lds_byte(wr * 64 + fr, fq * 8), boff = lds_byte(wc * 32 + fr, fq * 8);
#define PG8_SA(b, h) (((b) * 2 + (h)) * HTB)
#define PG8_SB(b, h) ((4 + (b) * 2 + (h)) * HTB)
#define PG8_STAGE(bufoff, gbase, voff) do { _Pragma("unroll") for (int _i = 0; _i < 2; ++_i) \
        __builtin_amdgcn_global_load_lds((const unsigned*)((const char*)(gbase) + (voff)[_i]), (PG8_LAS unsigned*)(lds + (bufoff) + ldsw + _i * 8192), 16, 0, 0); } while (0)
#define PG8_LDA(dst, b, h) do { _Pragma("unroll") for (int m = 0; m < 4; ++m) { if constexpr (F8) dst##8[m] = cat8(*(const PG8_LAS bf16x8*)(lds + PG8_SA(b, h) + aoff + m * 2048), *(const PG8_LAS bf16x8*)(lds + PG8_SA(b, h) + aoff + m * 2048 + 1024)); \
        else { _Pragma("unroll") for (int k = 0; k < 2; ++k) dst[m][k] = *(const PG8_LAS bf16x8*)(lds + PG8_SA(b, h) + aoff + m * 2048 + k * 1024); } } } while (0)
#define PG8_LDB(dst, b, h) do { _Pragma("unroll") for (int n = 0; n < 2; ++n) { if constexpr (F8) dst##8[n] = cat8(*(const PG8_LAS bf16x8*)(lds + PG8_SB(b, h) + boff + n * 2048), *(const PG8_LAS bf16x8*)(lds + PG8_SB(b, h) + boff + n * 2048 + 1024)); \
        else { _Pragma("unroll") for (int k = 0; k < 2; ++k) dst[n][k] = *(const PG8_LAS bf16x8*)(lds + PG8_SB(b, h) + boff + n * 2048 + k * 1024); } } } while (0)
#define PG8_MMA(ai, bj, At, Bt) do { __builtin_amdgcn_s_setprio(1); _Pragma("unroll") for (int m = 0; m < 4; ++m) _Pragma("unroll") for (int n = 0; n < 2; ++n) { \
        if constexpr (F8) asm volatile("v_mfma_f32_16x16x128_f8f6f4 %0, %1, %2, %0" : "+v"(acc[ai][bj][m][n]) : "v"(Bt##8[n]), "v"(At##8[m])); \
        else { _Pragma("unroll") for (int k = 0; k < 2; ++k) acc[ai][bj][m][n] = __builtin_amdgcn_mfma_f32_16x16x32_bf16(Bt[n][k], At[m][k], acc[ai][bj][m][n], 0, 0, 0); } } __builtin_amdgcn_s_setprio(0); } while (0)
#define PG8_WAIT_V(n) asm volatile("s_waitcnt vmcnt(" #n ")" ::: "memory")
#define PG8_WAIT_L(n) asm volatile("s_waitcnt lgkmcnt(" #n ")" ::: "memory")
#define PG8_BAR __builtin_amdgcn_s_barrier()
#define PG8_SCHED __builtin_amdgcn_sched_barrier(0)
    Unit cur, nxt; int ui = 0;
    if (!S.next(0, cur)) return;
    f32x4 acc[2][2][4][2];
#pragma unroll
    for (int a = 0; a < 2; ++a)
#pragma unroll
        for (int b = 0; b < 2; ++b)
#pragma unroll
            for (int m = 0; m < 4; ++m)
#pragma unroll
                for (int n = 0; n < 2; ++n) acc[a][b][m][n] = (f32x4){0.f, 0.f, 0.f, 0.f};
    bf16x8 At[4][2], B0[2][2], B1[2][2]; i32x8 At8[4], B08[2], B18[2];
    const char* cA = (const char*)g.A + (size_t)cur.pm * tstep; const char* cB = (const char*)g.Bt + (size_t)cur.pn * tstep;
    S.a_ready(cur);
    if constexpr (SP2) {
        PG8_STAGE(PG8_SB(0, 0), cB + k0o, voffB); PG8_STAGE(PG8_SB(0, 1), cB + hstep + k0o, voffB); PG8_STAGE(PG8_SA(0, 0), cA + k0o, voffA); PG8_STAGE(PG8_SA(0, 1), cA + hstep + k0o, voffA);
        if (wr == 1) PG8_BAR;
        PG8_WAIT_V(2); PG8_BAR;
        PG8_STAGE(PG8_SB(1, 0), cB + k1o, voffB); PG8_STAGE(PG8_SA(1, 0), cA + k1o, voffA); PG8_STAGE(PG8_SB(1, 1), cB + hstep + k1o, voffB);
        PG8_WAIT_V(6); PG8_BAR;
    } else {
        PG8_STAGE(PG8_SB(0, 0), cB + k0o, voffB); PG8_STAGE(PG8_SA(0, 0), cA + k0o, voffA); PG8_STAGE(PG8_SB(0, 1), cB + hstep + k0o, voffB); PG8_STAGE(PG8_SA(0, 1), cA + hstep + k0o, voffA);
        if (wr == 1) PG8_BAR;
        PG8_WAIT_V(4); PG8_BAR;
        PG8_STAGE(PG8_SB(1, 0), cB + k1o, voffB); PG8_STAGE(PG8_SA(1, 0), cA + k1o, voffA); PG8_STAGE(PG8_SB(1, 1), cB + hstep + k1o, voffB);
        PG8_WAIT_V(6); PG8_BAR;
    }
    for (;;) {
        const bool has_next = S.next(ui + 1, nxt);
        const char* nA = has_next ? (const char*)g.A + (size_t)nxt.pm * tstep : cA; const char* nB = has_next ? (const char*)g.Bt + (size_t)nxt.pn * tstep : cB;
        const unsigned long long tp_k = PG8_T();
#pragma unroll 1
        for (int t = 0; t < nt; t += 2) {
            const bool last = (t == nt - 2);
            const char* a1 = cA + PG8_KO(t + 1);
            const char* a2 = last ? nA + k0o : cA + PG8_KO(t + 2); const char* b2 = last ? nB + k0o : cB + PG8_KO(t + 2);
            const char* a3 = last ? nA + k1o : cA + PG8_KO(t + 3); const char* b3 = last ? nB + k1o : cB + PG8_KO(t + 3);
            if (last && has_next) S.a_ready(nxt);
            if constexpr (Epi::KHOOK) E.khook(acc, cur, t, wr, wc, fr, fq);
            if constexpr (SP2) {
            PG8_LDB(B0, 0, 0); PG8_LDB(B1, 0, 1); PG8_SCHED; PG8_LDA(At, 0, 0); PG8_STAGE(PG8_SA(1, 1), a1 + hstep, voffA);
            PG8_WAIT_V(8); PG8_WAIT_L(0); PG8_BAR; if (t == 0 && ui > 0) PG8_ADD(3, tp_c); PG8_MMA(0, 0, At, B0); PG8_MMA(0, 1, At, B1); PG8_BAR; PG8_SCHED;
            PG8_LDA(At, 0, 1); PG8_STAGE(PG8_SB(0, 0), b2, voffB); PG8_STAGE(PG8_SB(0, 1), b2 + hstep, voffB); PG8_STAGE(PG8_SA(0, 0), a2, voffA);
            PG8_WAIT_V(8); PG8_WAIT_L(0); PG8_BAR; PG8_MMA(1, 0, At, B0); PG8_MMA(1, 1, At, B1); PG8_BAR; PG8_SCHED;
            PG8_LDB(B0, 1, 0); PG8_LDB(B1, 1, 1); PG8_SCHED; PG8_LDA(At, 1, 0); PG8_STAGE(PG8_SA(0, 1), a2 + hstep, voffA);
            PG8_WAIT_V(8); PG8_WAIT_L(0); PG8_BAR; PG8_MMA(0, 0, At, B0); PG8_MMA(0, 1, At, B1); PG8_BAR; PG8_SCHED;
            PG8_LDA(At, 1, 1); PG8_STAGE(PG8_SB(1, 0), b3, voffB); PG8_STAGE(PG8_SB(1, 1), b3 + hstep, voffB); PG8_STAGE(PG8_SA(1, 0), a3, voffA);
            PG8_WAIT_V(8); PG8_WAIT_L(0); PG8_BAR; PG8_MMA(1, 0, At, B0); PG8_MMA(1, 1, At, B1); PG8_BAR; PG8_SCHED;
            } else {
            PG8_LDB(B0, 0, 0); PG8_SCHED; PG8_LDA(At, 0, 0); PG8_STAGE(PG8_SA(1, 1), a1 + hstep, voffA);
            PG8_WAIT_L(8); PG8_BAR; PG8_WAIT_L(0); PG8_MMA(0, 0, At, B0); PG8_BAR; PG8_SCHED;
            PG8_LDB(B1, 0, 1); PG8_STAGE(PG8_SB(0, 0), b2, voffB);
            PG8_BAR; PG8_WAIT_L(0); PG8_MMA(0, 1, At, B1); PG8_BAR;
            PG8_LDA(At, 0, 1); PG8_STAGE(PG8_SA(0, 0), a2, voffA);
            PG8_BAR; PG8_WAIT_L(0); PG8_MMA(1, 0, At, B0); PG8_BAR; PG8_SCHED;
            PG8_STAGE(PG8_SB(0, 1), b2 + hstep, voffB);
            PG8_WAIT_V(6); PG8_BAR; PG8_MMA(1, 1, At, B1); PG8_BAR;
            PG8_LDB(B0, 1, 0); PG8_SCHED; PG8_LDA(At, 1, 0); PG8_STAGE(PG8_SA(0, 1), a2 + hstep, voffA);
            PG8_WAIT_L(8); PG8_BAR; PG8_WAIT_L(0); PG8_MMA(0, 0, At, B0); PG8_BAR; PG8_SCHED;
            PG8_LDB(B1, 1, 1); PG8_STAGE(PG8_SB(1, 0), b3, voffB);
            PG8_BAR; PG8_WAIT_L(0); PG8_MMA(0, 1, At, B1); PG8_BAR;
            PG8_LDA(At, 1, 1); PG8_STAGE(PG8_SA(1, 0), a3, voffA);
            PG8_BAR; PG8_WAIT_L(0); PG8_MMA(1, 0, At, B0); PG8_BAR; PG8_SCHED;
            PG8_STAGE(PG8_SB(1, 1), b3 + hstep, voffB);
            PG8_WAIT_V(6); PG8_BAR; PG8_MMA(1, 1, At, B1); PG8_BAR;
            }
        }
        if constexpr (F8) asm volatile("s_nop 15\n\ts_nop 15" ::: "memory");
        PG8_ADD(4, tp_k); const unsigned long long tp_a = PG8_T();
        if constexpr (ALIGN_EPI) { if (wr == 0) PG8_BAR; }
        PG8_ADD(1, tp_a); const unsigned long long tp_b = PG8_T();
        if constexpr (!Epi::AFTER_DRAIN) { E(acc, cur, wr, wc, fr, fq); S.done(cur); }
        PG8_ADD(2, tp_b); tp_c = PG8_T();
        if (!has_next) break;
#pragma unroll
        for (int a = 0; a < 2; ++a)
#pragma unroll
            for (int b = 0; b < 2; ++b)
#pragma unroll
                for (int m = 0; m < 4; ++m)
#pragma unroll
                    for (int n = 0; n < 2; ++n) acc[a][b][m][n] = (f32x4){0.f, 0.f, 0.f, 0.f};
        cur = nxt; cA = nA; cB = nB; ++ui;
        if constexpr (ALIGN_EPI) { if (wr == 1) PG8_BAR; }
    }
    PG8_WAIT_V(0);
    if constexpr (!ALIGN_EPI) { if (wr == 0) PG8_BAR; }
    PG8_BAR;
    if constexpr (Epi::AFTER_DRAIN) { E.fused(acc, cur, wr, wc, fr, fq, lds, wid, lane); S.done(cur); }
    PG8_ADD(5, tp_fn);
#undef PG8_SA
#undef PG8_SB
#undef PG8_STAGE
#undef PG8_LDA
#undef PG8_LDB
#undef PG8_MMA
#undef PG8_WAIT_V
#undef PG8_WAIT_L
#undef PG8_BAR
#undef PG8_SCHED
#undef PG8_KO
}

template <class Epi, class Sched, bool ALIGN_EPI = false, bool F8 = false>
__device__ __forceinline__ void gemm_phase_g(PG8_LAS unsigned char* lds, const Gemm g, const Sched& S, const Epi& E, const PG8_LAS unsigned* utok, int rot, unsigned long long& pb) {
    const unsigned long long tp_fn = PG8_T(); unsigned long long tp_c = 0ull;
    constexpr bool SP2 = true;
    const int tid = threadIdx.x, wid = __builtin_amdgcn_readfirstlane(tid >> 6), lane = tid & 63, wr = wid >> 2, wc = wid & 3, fr = lane & 15, fq = lane >> 4;
    const int K = g.K, nt = K / BK;
    unsigned voffA[2], voffB[2]; int rowA[2];
#pragma unroll
    for (int i = 0; i < 2; ++i) { int R, C; stage_rc(tid * 16 + i * 8192, R, C); const int Rb = Epi::PERM ? ((R & ~31) + perm32(R & 31)) : R;
        voffA[i] = (unsigned)C * 2u; rowA[i] = R; voffB[i] = (unsigned)(Rb * K + C) * 2u; }
    unsigned cv0[2], cv1[2], nv0[2], nv1[2];
#define PG8_GLOAD(dst0, dst1, ui_) do { _Pragma("unroll") for (int _i = 0; _i < 2; ++_i) { dst0[_i] = utok[(ui_) * 256 + rowA[_i]] + voffA[_i]; dst1[_i] = utok[(ui_) * 256 + 128 + rowA[_i]] + voffA[_i]; } } while (0)
    const size_t kstep = (size_t)(BK * 2);
    const int kmask = nt - 1;
    const size_t k0o = (size_t)(rot & kmask) * kstep, k1o = (size_t)((rot + 1) & kmask) * kstep;
#define PG8_KO(x) ((size_t)(((x) + rot) & kmask) * kstep)
    const size_t hstep = (size_t)HALF * K * 2;
    const size_t tstep = 2 * hstep;
    const unsigned ldsw = (unsigned)wid * 1024u;
    const int aoff = lds_byte(wr * 64 + fr, fq * 8), boff = lds_byte(wc * 32 + fr, fq * 8);
#define PG8_SA(b, h) (((b) * 2 + (h)) * HTB)
#define PG8_SB(b, h) ((4 + (b) * 2 + (h)) * HTB)
#define PG8_STAGE(bufoff, gbase, voff) do { _Pragma("unroll") for (int _i = 0; _i < 2; ++_i) \
        __builtin_amdgcn_global_load_lds((const unsigned*)((const char*)(gbase) + (voff)[_i]), (PG8_LAS unsigned*)(lds + (bufoff) + ldsw + _i * 8192), 16, 0, 0); } while (0)
#define PG8_LDA(dst, b, h) do { _Pragma("unroll") for (int m = 0; m < 4; ++m) { if constexpr (F8) dst##8[m] = cat8(*(const PG8_LAS bf16x8*)(lds + PG8_SA(b, h) + aoff + m * 2048), *(const PG8_LAS bf16x8*)(lds + PG8_SA(b, h) + aoff + m * 2048 + 1024)); \
        else { _Pragma("unroll") for (int k = 0; k < 2; ++k) dst[m][k] = *(const PG8_LAS bf16x8*)(lds + PG8_SA(b, h) + aoff + m * 2048 + k * 1024); } } } while (0)
#define PG8_LDB(dst, b, h) do { _Pragma("unroll") for (int n = 0; n < 2; ++n) { if constexpr (F8) dst##8[n] = cat8(*(const PG8_LAS bf16x8*)(lds + PG8_SB(b, h) + boff + n * 2048), *(const PG8_LAS bf16x8*)(lds + PG8_SB(b, h) + boff + n * 2048 + 1024)); \
        else { _Pragma("unroll") for (int k = 0; k < 2; ++k) dst[n][k] = *(const PG8_LAS bf16x8*)(lds + PG8_SB(b, h) + boff + n * 2048 + k * 1024); } } } while (0)
#define PG8_MMA(ai, bj, At, Bt) do { __builtin_amdgcn_s_setprio(1); _Pragma("unroll") for (int m = 0; m < 4; ++m) _Pragma("unroll") for (int n = 0; n < 2; ++n) { \
        if constexpr (F8) asm volatile("v_mfma_f32_16x16x128_f8f6f4 %0, %1, %2, %0" : "+v"(acc[ai][bj][m][n]) : "v"(Bt##8[n]), "v"(At##8[m])); \
        else { _Pragma("unroll") for (int k = 0; k < 2; ++k) acc[ai][bj][m][n] = __builtin_amdgcn_mfma_f32_16x16x32_bf16(Bt[n][k], At[m][k], acc[ai][bj][m][n], 0, 0, 0); } } __builtin_amdgcn_s_setprio(0); } while (0)
#define PG8_WAIT_V(n) asm volatile("s_waitcnt vmcnt(" #n ")" ::: "memory")
#define PG8_WAIT_L(n) asm volatile("s_waitcnt lgkmcnt(" #n ")" ::: "memory")
#define PG8_BAR __builtin_amdgcn_s_barrier()
#define PG8_SCHED __builtin_amdgcn_sched_barrier(0)
    Unit cur, nxt; int ui = 0;
    if (!S.next(0, cur)) return;
    f32x4 acc[2][2][4][2];
#pragma unroll
    for (int a = 0; a < 2; ++a)
#pragma unroll
        for (int b = 0; b < 2; ++b)
#pragma unroll
            for (int m = 0; m < 4; ++m)
#pragma unroll
                for (int n = 0; n < 2; ++n) acc[a][b][m][n] = (f32x4){0.f, 0.f, 0.f, 0.f};
    bf16x8 At[4][2], B0[2][2], B1[2][2]; i32x8 At8[4], B08[2], B18[2];
    const char* const gA = (const char*)g.A; const char* cB = (const char*)g.Bt + (size_t)cur.pn * tstep;
    PG8_GLOAD(cv0, cv1, 0);
    S.a_ready(cur);
    if constexpr (SP2) {
        PG8_STAGE(PG8_SB(0, 0), cB + k0o, voffB); PG8_STAGE(PG8_SB(0, 1), cB + hstep + k0o, voffB); PG8_STAGE(PG8_SA(0, 0), gA + k0o, cv0); PG8_STAGE(PG8_SA(0, 1), gA + k0o, cv1);
        if (wr == 1) PG8_BAR;
        PG8_WAIT_V(2); PG8_BAR;
        PG8_STAGE(PG8_SB(1, 0), cB + k1o, voffB); PG8_STAGE(PG8_SA(1, 0), gA + k1o, cv0); PG8_STAGE(PG8_SB(1, 1), cB + hstep + k1o, voffB);
        PG8_WAIT_V(6); PG8_BAR;
    }
    for (;;) {
        const bool has_next = S.next(ui + 1, nxt);
        const char* nB = has_next ? (const char*)g.Bt + (size_t)nxt.pn * tstep : cB;
        if (has_next) PG8_GLOAD(nv0, nv1, ui + 1); else { nv0[0] = cv0[0]; nv0[1] = cv0[1]; nv1[0] = cv1[0]; nv1[1] = cv1[1]; }
        const unsigned long long tp_k = PG8_T();
#pragma unroll 1
        for (int t = 0; t < nt; t += 2) {
            const bool last = (t == nt - 2);
            const char* a1 = gA + PG8_KO(t + 1);
            const char* a2 = last ? gA + k0o : gA + PG8_KO(t + 2); const char* b2 = last ? nB + k0o : cB + PG8_KO(t + 2);
            unsigned xv0[2], xv1[2];
#pragma unroll
            for (int _i = 0; _i < 2; ++_i) { xv0[_i] = last ? nv0[_i] : cv0[_i]; xv1[_i] = last ? nv1[_i] : cv1[_i]; }
            const char* a3 = last ? gA + k1o : gA + PG8_KO(t + 3); const char* b3 = last ? nB + k1o : cB + PG8_KO(t + 3);
            if (last && has_next) S.a_ready(nxt);
            if constexpr (SP2) {
            PG8_LDB(B0, 0, 0); PG8_LDB(B1, 0, 1); PG8_SCHED; PG8_LDA(At, 0, 0); PG8_STAGE(PG8_SA(1, 1), a1, cv1);
            PG8_WAIT_V(8); PG8_WAIT_L(0); PG8_BAR; if (t == 0 && ui > 0) PG8_ADD(3, tp_c); PG8_MMA(0, 0, At, B0); PG8_MMA(0, 1, At, B1); PG8_BAR; PG8_SCHED;
            PG8_LDA(At, 0, 1); PG8_STAGE(PG8_SB(0, 0), b2, voffB); PG8_STAGE(PG8_SB(0, 1), b2 + hstep, voffB); PG8_STAGE(PG8_SA(0, 0), a2, xv0);
            PG8_WAIT_V(8); PG8_WAIT_L(0); PG8_BAR; PG8_MMA(1, 0, At, B0); PG8_MMA(1, 1, At, B1); PG8_BAR; PG8_SCHED;
            PG8_LDB(B0, 1, 0); PG8_LDB(B1, 1, 1); PG8_SCHED; PG8_LDA(At, 1, 0); PG8_STAGE(PG8_SA(0, 1), a2, xv1);
            PG8_WAIT_V(8); PG8_WAIT_L(0); PG8_BAR; PG8_MMA(0, 0, At, B0); PG8_MMA(0, 1, At, B1); PG8_BAR; PG8_SCHED;
            PG8_LDA(At, 1, 1); PG8_STAGE(PG8_SB(1, 0), b3, voffB); PG8_STAGE(PG8_SB(1, 1), b3 + hstep, voffB); PG8_STAGE(PG8_SA(1, 0), a3, xv0);
            PG8_WAIT_V(8); PG8_WAIT_L(0); PG8_BAR; PG8_MMA(1, 0, At, B0); PG8_MMA(1, 1, At, B1); PG8_BAR; PG8_SCHED;
            }
        }
        if constexpr (F8) asm volatile("s_nop 15\n\ts_nop 15" ::: "memory");
        PG8_ADD(4, tp_k); const unsigned long long tp_a = PG8_T();
        if constexpr (ALIGN_EPI) { if (wr == 0) PG8_BAR; }
        PG8_ADD(1, tp_a); const unsigned long long tp_b = PG8_T();
        if constexpr (!Epi::AFTER_DRAIN) { E(acc, cur, wr, wc, fr, fq); S.done(cur); }
        PG8_ADD(2, tp_b); tp_c = PG8_T();
        if (!has_next) break;
#pragma unroll
        for (int a = 0; a < 2; ++a)
#pragma unroll
            for (int b = 0; b < 2; ++b)
#pragma unroll
                for (int m = 0; m < 4; ++m)
#pragma unroll
                    for (int n = 0; n < 2; ++n) acc[a][b][m][n] = (f32x4){0.f, 0.f, 0.f, 0.f};
        cur = nxt; cB = nB; ++ui; cv0[0] = nv0[0]; cv0[1] = nv0[1]; cv1[0] = nv1[0]; cv1[1] = nv1[1];
        if constexpr (ALIGN_EPI) { if (wr == 1) PG8_BAR; }
    }
    PG8_WAIT_V(0);
    if constexpr (!ALIGN_EPI) { if (wr == 0) PG8_BAR; }
    PG8_BAR;
    if constexpr (Epi::AFTER_DRAIN) { E.fused(acc, cur, wr, wc, fr, fq, lds, wid, lane); S.done(cur); }
    PG8_ADD(5, tp_fn);
#undef PG8_SA
#undef PG8_SB
#undef PG8_STAGE
#undef PG8_LDA
#undef PG8_LDB
#undef PG8_MMA
#undef PG8_WAIT_V
#undef PG8_WAIT_L
#undef PG8_BAR
#undef PG8_SCHED
#undef PG8_KO
#undef PG8_GLOAD
}
}

constexpr int NWAVES = 8;
#ifndef PROBE_SEC
#define PROBE_SEC 0
#endif
#ifndef PROBE_WAVE
#define PROBE_WAVE 0
#endif
#define SEC_T() ((PROBE_SEC) ? __builtin_amdgcn_s_memrealtime() : 0ull)
#define SEC_ADD(id, t0) do { if (PROBE_SEC == (id)) F.pb += __builtin_amdgcn_s_memrealtime() - (t0); } while (0)
#ifndef REP_MASK
#define REP_MASK 0
#endif
#define REP(k) (1 + (((REP_MASK) >> (k)) & 1))
enum { PH_PRO = 0, PH_INPROJ, PH_PREP, PH_SSD, PH_ATTN, PH_OPROJ, PH_WOUT, PH_ROUTE, PH_GATHER, PH_GU, PH_DOWN, PH_COMB, N_PHASES };
#ifndef SSD_SIMPLE
#define SSD_SIMPLE 0
#endif
#ifndef BG_MOE_CONVERT
#define BG_MOE_CONVERT 1
#endif
#ifndef BG_SSD
#define BG_SSD 8
#endif
#define BG_ATT (24 - BG_SSD)
#define BG_APER (72 / BG_ATT)
#ifndef ATTN_SIMPLE
#define ATTN_SIMPLE 0
#endif
#ifndef MK_PER_PHASE
#define MK_PER_PHASE 0
#endif
constexpr int BATCH = 8, SEQ = 2048, D = 1024, M = BATCH * SEQ;
constexpr int NH = 16, HD = 64, MBLK = 256, NBLK = SEQ / MBLK, MOBA_TOPK = 3;
constexpr int D_INNER = 2048, SSD_H = 32, NGRP = 4, DSTATE = 128, D_XBC = 3072, CONVK = 4;
constexpr int N_IN = 10272, NPROJ = 10240;
constexpr int PQ = 0, PK = 1024, PV = 2048, PZ = 3072, PXBC = 5120, PGATE = 8192;
constexpr int COL_DT = 8192;
constexpr int NEXP = 32, TOPK = 4, EXPCAP = 16384, MAXROWS = M * TOPK + NEXP * 256, MAXTILES = MAXROWS / 256;
constexpr float NORM_EPS = 1e-6f;
constexpr float QSCALE = 0.125f * 1.4426950408889634f;

constexpr size_t MiB = 1u << 20;
constexpr size_t WS_CTL = 0, CTL_ZERO_BYTES = 128 * 1024;
constexpr size_t WS_KM = 1 * MiB;
constexpr size_t WS_WIN = 2 * MiB, WS_WOA = 22 * MiB, WS_WOS = 24 * MiB, WS_WOUT = 28 * MiB, WS_WGU = 30 * MiB, WS_WDN = 158 * MiB;
constexpr size_t WS_WDT = 222 * MiB, WS_WRT = 222 * MiB + 512 * 1024;
constexpr size_t WS_WDH = 222 * MiB, WS_WDL = 222 * MiB + 64 * 1024, WS_WRH = 222 * MiB + 128 * 1024, WS_WRL = 222 * MiB + 192 * 1024;
constexpr size_t WS_XN = 223 * MiB, WS_DT = 255 * MiB, WS_SSQ = 904 * MiB, WS_YG = 259 * MiB, WS_AO = 323 * MiB, WS_MIXF = 355 * MiB, WS_MIX = 419 * MiB, WS_H2 = 451 * MiB;
constexpr size_t WS_TOKL = 483 * MiB, WS_GATEW = 192 * MiB  , WS_POS = 486 * MiB, WS_ROWW = 487 * MiB;
constexpr size_t WS_PROJ = 488 * MiB, WS_XC = 808 * MiB, WS_H2LO = 908 * MiB, WS_H2F8 = 94 * MiB  , WS_END = 940 * MiB;
constexpr size_t WS_AOYG = WS_YG, WS_WCAT = WS_WOA, WS_RS = WS_SSQ + 2 * MiB;
static_assert(WS_AO == WS_YG + 64 * MiB && WS_WOS == WS_WOA + 2 * MiB, "overlays");
constexpr size_t WS_XG = WS_PROJ, WS_ACT = WS_PROJ + 144 * MiB, WS_Y = WS_XG;
static_assert(WS_ACT + (size_t)MAXROWS * 1024 * 2 <= WS_END, "MoE overlay");
constexpr int CW_TMO = 0, CW_CODE = 1, CW_BAR = 4096, CW_CNT = 16384;

constexpr int RING_OFF = 0, RING_BYTES = 131072;
constexpr int LDSCTL_OFF = RING_BYTES, MISC_OFF = LDSCTL_OFF + 320, TILEE_OFF = LDSCTL_OFF + 1024, ROWB_OFF = LDSCTL_OFF + 2560, CNTL_OFF = LDSCTL_OFF + 2816, LCNT_OFF = LDSCTL_OFF + 3072, LBASE_OFF = LDSCTL_OFF + 3200, UTOK_OFF = LDSCTL_OFF + 3328, UTOK_UNITS = 12, UTAB_OFF = UTOK_OFF + UTOK_UNITS * 1024;
static_assert(UTAB_OFF + UTOK_UNITS * 8 <= 147456, "LDS map");
constexpr int LDS_BYTES = 147456;

#define GAS __attribute__((address_space(1)))
#define LAS __attribute__((address_space(3)))
typedef unsigned short bf16;
typedef unsigned v4u __attribute__((ext_vector_type(4)));
typedef unsigned v2u __attribute__((ext_vector_type(2)));
typedef float f32x4 __attribute__((ext_vector_type(4)));
typedef GAS unsigned gu32;
#define RLX_AGENT __ATOMIC_RELAXED, __HIP_MEMORY_SCOPE_AGENT
#define LDS_WAIT() asm volatile("s_waitcnt lgkmcnt(0)" ::: "memory")
#define VM_WAIT() asm volatile("s_waitcnt vmcnt(0)" ::: "memory")
__device__ __forceinline__ unsigned f2bf(float f) { unsigned u = __builtin_bit_cast(unsigned, f); return (u + 0x7fffu + ((u >> 16) & 1u)) >> 16; }
typedef float f32x2_t __attribute__((ext_vector_type(2))); typedef __bf16 bf16x2_t __attribute__((ext_vector_type(2)));
__device__ __forceinline__ unsigned pk2(float lo, float hi) { f32x2_t v = {lo, hi}; bf16x2_t b = __builtin_convertvector(v, bf16x2_t); return __builtin_bit_cast(unsigned, b); }
__device__ __forceinline__ float bf2f(bf16 b) { return __uint_as_float((unsigned)b << 16); }
__device__ __forceinline__ void unpk8(const v4u w, float (&f)[8]) {
#pragma unroll
    for (int i = 0; i < 4; ++i) { f[2 * i] = __uint_as_float(w[i] << 16); f[2 * i + 1] = __uint_as_float(w[i] & 0xffff0000u); }
}
__device__ __forceinline__ v4u pack8(const float (&f)[8]) { v4u w; w.x = pk2(f[0], f[1]); w.y = pk2(f[2], f[3]); w.z = pk2(f[4], f[5]); w.w = pk2(f[6], f[7]); return w; }
__device__ __forceinline__ float wave_sum(float v) {
#pragma unroll
    for (int o = 1; o < 64; o <<= 1) v += __shfl_xor(v, o);
    return v;
}
__device__ __forceinline__ float wave_max(float v) {
#pragma unroll
    for (int o = 1; o < 64; o <<= 1) v = fmaxf(v, __shfl_xor(v, o));
    return v;
}
__device__ __forceinline__ float silu_f(float x) { return x * __builtin_amdgcn_rcpf(1.f + __builtin_amdgcn_exp2f(-1.44269504f * x)); }
#define XB_TMO      128
#define XB_XCNT(j)  (256  + 64 * (j))
#define XB_XSUB(j)  (1280 + 64 * (j))
#define XB_XGEN(j)  (2304 + 64 * (j))
#define XB_TOP      3328
#define XB_TOPGEN   3392
#define XCD_BAR_WORDS 3456
#define XB_SPIN_CAP (1u << 18)

__device__ __forceinline__ unsigned xb_ld(unsigned* p)              { return __hip_atomic_load(p, __ATOMIC_RELAXED, __HIP_MEMORY_SCOPE_AGENT); }
__device__ __forceinline__ unsigned xb_add(unsigned* p, unsigned v) { return __hip_atomic_fetch_add(p, v, __ATOMIC_RELAXED, __HIP_MEMORY_SCOPE_AGENT); }
__device__ __forceinline__ unsigned xb_xcc_id() { return (unsigned)__builtin_amdgcn_s_getreg((3 << 11) | 20) & 0xFu; }
#define XB_SPIN(cond, bar) do { unsigned _sp = 0; while (cond) { __builtin_amdgcn_s_sleep(1); \
    if ((++_sp & 255u) == 0u) { if (xb_ld(&(bar)[XB_TMO])) break; if (_sp > XB_SPIN_CAP) { atomicAdd(&(bar)[XB_TMO], 1u); break; } } } } while (0)

struct XcdBarrier {
    unsigned* bar; unsigned x;
    volatile LAS unsigned* st;
};

__device__ __forceinline__ XcdBarrier xcd_barrier_post(unsigned* bar, volatile LAS unsigned* st) {
    XcdBarrier b; b.bar = bar; b.x = xb_xcc_id(); b.st = st;
    if (threadIdx.x == 0) (void)xb_add(&bar[XB_XCNT(b.x)], 1u);
    return b;
}
__device__ __forceinline__ void xcd_barrier_complete(unsigned* bar, unsigned x, unsigned& nloc, unsigned& nx) {
    const unsigned G = gridDim.x * gridDim.y * gridDim.z;
    unsigned sum, cnt, mine, sp = 0u;
    for (;;) {
        sum = 0u; cnt = 0u; mine = 0u;
#pragma unroll
        for (unsigned j = 0; j < 16; ++j) { const unsigned c = xb_ld(&bar[XB_XCNT(j)]); sum += c; cnt += (c > 0u) ? 1u : 0u; mine = (j == x) ? c : mine; }
        if (sum == G) break;
        __builtin_amdgcn_s_sleep(1);
        if ((++sp & 255u) == 0u) { if (xb_ld(&bar[XB_TMO])) break; if (sp > XB_SPIN_CAP) { atomicAdd(&bar[XB_TMO], 1u); break; } }
    }
    nloc = mine > 0u ? mine : 1u; nx = cnt > 0u ? cnt : 1u;
}

__device__ __forceinline__ void xcd_barrier(const XcdBarrier& b) {
    asm volatile("s_waitcnt vmcnt(0)" ::: "memory");
    __syncthreads();
    if (threadIdx.x == 0) {
        unsigned* bar = b.bar;
        __builtin_amdgcn_s_waitcnt(0);
        unsigned nloc = b.st[0], nx = b.st[1];
        if (nloc == 0u) { xcd_barrier_complete(bar, b.x, nloc, nx); b.st[0] = nloc; b.st[1] = nx; }
        const unsigned old = xb_add(&bar[XB_XSUB(b.x)], 1u);
        const unsigned gen = old / nloc;
        if (old + 1u == (gen + 1u) * nloc) {
            __builtin_amdgcn_fence(__ATOMIC_RELEASE, "agent");
            asm volatile("s_waitcnt vmcnt(0)" ::: "memory");
            const unsigned og = xb_add(&bar[XB_TOP], 1u);
            const unsigned tg = og / nx;
            if (og + 1u == (tg + 1u) * nx) xb_add(&bar[XB_TOPGEN], 1u);
            else XB_SPIN(xb_ld(&bar[XB_TOPGEN]) == tg, bar);
            __builtin_amdgcn_fence(__ATOMIC_ACQUIRE, "agent");
            xb_add(&bar[XB_XGEN(b.x)], 1u);
            asm volatile("s_waitcnt vmcnt(0)" ::: "memory");
        } else {
            XB_SPIN(xb_ld(&bar[XB_XGEN(b.x)]) == gen, bar);
            __builtin_amdgcn_fence(__ATOMIC_ACQUIRE, "agent");
            asm volatile("s_waitcnt vmcnt(0)" ::: "memory");
        }
    }
    __syncthreads();
}
struct Args { const float* in[22]; float* out; unsigned char* ws; int ph_lo, ph_hi; };
struct Frame {
    LAS unsigned char* lds;
    volatile LAS unsigned* MISC;
    gu32* ctl;
    int tid, lane, wave, vcu, G;
    unsigned long long pb;
};
#define IN_X(A)      ((A).in[0])
#define IN_LN1W(A)   ((A).in[1])
#define IN_WIN(A)    ((A).in[2])
#define IN_GATEB(A)  ((A).in[3])
#define IN_QNW(A)    ((A).in[4])
#define IN_KNW(A)    ((A).in[5])
#define IN_CONVW(A)  ((A).in[6])
#define IN_CONVB(A)  ((A).in[7])
#define IN_DTB(A)    ((A).in[8])
#define IN_ALOG(A)   ((A).in[9])
#define IN_DSKIP(A)  ((A).in[10])
#define IN_SSDNW(A)  ((A).in[11])
#define IN_WOA(A)    ((A).in[12])
#define IN_WOS(A)    ((A).in[13])
#define IN_WOUT(A)   ((A).in[14])
#define IN_LN2W(A)   ((A).in[15])
#define IN_WR(A)     ((A).in[16])
#define IN_BR(A)     ((A).in[17])
#define IN_WGU(A)    ((A).in[18])
#define IN_BGU(A)    ((A).in[19])
#define IN_WDN(A)    ((A).in[20])
#define IN_BDN(A)    ((A).in[21])
#define WSP(A, T, off) ((T*)((A).ws + (off)))

template <class Map>
__device__ __forceinline__ void transpose_item(const float* W, int K, int N, bf16* WT, LAS unsigned* scr, int kb, int nb, int lane, const Map& dest_row, int dk = 0, const float* kscale = nullptr) {
    const int k0 = 64 * kb, n0 = 64 * nb, cc = lane & 15, kpl = lane >> 4;
    int col = n0 + 4 * cc; if (col > N - 4) col = N - 4;
    f32x4 a[8], b[8];
#pragma unroll
    for (int it = 0; it < 8; ++it) { const int kp = 4 * it + kpl; a[it] = *(const f32x4*)(W + (size_t)(k0 + 2 * kp) * N + col); b[it] = *(const f32x4*)(W + (size_t)(k0 + 2 * kp + 1) * N + col); }
#pragma unroll
    for (int it = 0; it < 8; ++it) { const int kp = 4 * it + kpl; const float sa = kscale ? kscale[k0 + 2 * kp] : 1.0f, sb = kscale ? kscale[k0 + 2 * kp + 1] : 1.0f;
#pragma unroll
        for (int i = 0; i < 4; ++i) scr[(4 * cc + i) * 33 + kp] = pk2(a[it][i] * sa, b[it][i] * sb); }
    LDS_WAIT(); asm volatile("" ::: "memory");
    const int rr = lane >> 3, ch = lane & 7;
#pragma unroll
    for (int j = 0; j < 8; ++j) { const int n = 8 * j + rr; const LAS unsigned* s = scr + n * 33 + 4 * ch; v4u o; o.x = s[0]; o.y = s[1]; o.z = s[2]; o.w = s[3];
        const int dr = dest_row(n0 + n); if (dr >= 0) *(v4u*)(WT + (size_t)dr * K + dk + k0 + 8 * ch) = o; }
    LDS_WAIT(); asm volatile("" ::: "memory");
}
struct MapId { int N; __device__ __forceinline__ int operator()(int s) const { return s < N ? s : -1; } };
struct MapWin { __device__ __forceinline__ int operator()(int s) const { return s < COL_DT ? s : (s < COL_DT + SSD_H ? -1 : (s < N_IN ? s - SSD_H : -1)); } };
struct MapGu { __device__ __forceinline__ int operator()(int s) const { const int j = s >> 1, isu = s & 1; return (j >> 7) * 256 + (j & 127) + 128 * isu; } };


struct TrItem { const float* W; unsigned char* WT; int N, kb, nb, isgu; };
__device__ __forceinline__ TrItem moe_item(const Args& A, int it) {
    TrItem t;
    if (it < 32768) { const int e = it >> 10, q = it & 1023; t.W = IN_WGU(A) + (size_t)e * 1024 * 2048; t.WT = WSP(A,unsigned char,WS_WGU) + (size_t)e * 2048 * 1024; t.N = 2048; t.kb = q >> 6; t.nb = q & 63; t.isgu = 1; }
    else { const int r = it - 32768, e = r >> 9, q = r & 511; t.W = IN_WDN(A) + (size_t)e * 1024 * 1024; t.WT = WSP(A,unsigned char,WS_WDN) + (size_t)e * 1024 * 1024; t.N = 1024; t.kb = q >> 5; t.nb = q & 31; t.isgu = 0; }
    return t;
}
__device__ __forceinline__ void tr_issue(const TrItem& t, int lane, f32x4 (&a)[4], f32x4 (&b)[4]) {
    const int k0 = 64 * t.kb, cc = lane & 7, kpl = lane >> 3; const int col = 32 * t.nb + 4 * cc;
#pragma unroll
    for (int it = 0; it < 2; ++it) { const float* r0 = t.W + (size_t)(k0 + 4 * (8 * it + kpl)) * t.N + col;
        a[2 * it] = *(const f32x4*)r0; b[2 * it] = *(const f32x4*)(r0 + t.N); a[2 * it + 1] = *(const f32x4*)(r0 + 2 * (size_t)t.N); b[2 * it + 1] = *(const f32x4*)(r0 + 3 * (size_t)t.N); }
}
__device__ __forceinline__ void tr_finish(const TrItem& t, int lane, const f32x4 (&a)[4], const f32x4 (&b)[4], LAS unsigned* scr) {
    const int k0 = 64 * t.kb, n0 = 32 * t.nb, cc = lane & 7, kpl = lane >> 3;
#pragma unroll
    for (int it = 0; it < 2; ++it) { const int kq = 8 * it + kpl;
#pragma unroll
        for (int i = 0; i < 4; ++i) scr[(4 * cc + i) * 33 + kq] = pg8::cvt4_fp8(a[2 * it][i] * pg8::F8_SCALE_W, b[2 * it][i] * pg8::F8_SCALE_W, a[2 * it + 1][i] * pg8::F8_SCALE_W, b[2 * it + 1][i] * pg8::F8_SCALE_W); }
    LDS_WAIT(); asm volatile("" ::: "memory");
    const int rr = lane >> 2, ch = lane & 3;
#pragma unroll
    for (int j = 0; j < 2; ++j) { const int n = 16 * j + rr; const LAS unsigned* s = scr + n * 33 + 4 * ch; v4u o; o.x = s[0]; o.y = s[1]; o.z = s[2]; o.w = s[3];
        const int sc = n0 + n; const int dr = t.isgu ? ((sc >> 8) * 256 + ((sc >> 1) & 127) + 128 * (sc & 1)) : sc;
        *(v4u*)(t.WT + (size_t)dr * 1024 + k0 + 16 * ch) = o; }
    LDS_WAIT(); asm volatile("" ::: "memory");
}

__device__ __forceinline__ void p0_prologue(Frame& F, const Args& A) {
    LAS unsigned* scr = (LAS unsigned*)(F.lds + RING_OFF + F.wave * 8704);
    const int gw = F.vcu * NWAVES + F.wave, NGW = F.G * NWAVES, lane = F.lane;
    constexpr int I_IN = 16 * 161, I_OA = 16 * 16, I_OS = 32 * 16, I_OUT = 16 * 16, I_GU1 = 16 * 32, I_GU = NEXP * I_GU1, I_DN1 = 16 * 16, I_DN = NEXP * I_DN1;
    constexpr int NITEMS = (BG_MOE_CONVERT ? 0 : I_GU + I_DN) + I_IN + I_OA + I_OS + I_OUT;
    for (int it = gw; it < NITEMS; it += NGW) {
        int r = it;
        if (r < I_IN) { transpose_item(IN_WIN(A), 1024, N_IN, WSP(A,bf16,WS_WIN), scr, r / 161, r % 161, lane, MapWin{}); continue; } r -= I_IN;
        if (r < I_OA) { transpose_item(IN_WOA(A), 1024, 1024, WSP(A,bf16,WS_WOA), scr, r / 16, r % 16, lane, MapId{1024}); continue; } r -= I_OA;
        if (r < I_OS) { transpose_item(IN_WOS(A), 2048, 1024, WSP(A,bf16,WS_WOS), scr, r / 16, r % 16, lane, MapId{1024}, 0, IN_SSDNW(A)); continue; } r -= I_OS;
        if (r < I_OUT) { transpose_item(IN_WOUT(A), 1024, 1024, WSP(A,bf16,WS_WOUT), scr, r / 16, r % 16, lane, MapId{1024}); continue; } r -= I_OUT;
        if (BG_MOE_CONVERT) continue;
        if (r < I_GU) { const int e = r / I_GU1, q = r % I_GU1; transpose_item(IN_WGU(A) + (size_t)e * 1024 * 2048, 1024, 2048, WSP(A,bf16,WS_WGU) + (size_t)e * 2048 * 1024, scr, q / 32, q % 32, lane, MapGu{}); continue; } r -= I_GU;
        { const int e = r / I_DN1, q = r % I_DN1; transpose_item(IN_WDN(A) + (size_t)e * 1024 * 1024, 1024, 1024, WSP(A,bf16,WS_WDN) + (size_t)e * 1024 * 1024, scr, q / 16, q % 16, lane, MapId{1024}); }
    }
}

__device__ __forceinline__ float rowdot32(const float (&h)[16], const LAS float* WT, int lane) {
    float mine = 0.f;
#pragma unroll 2
    for (int e = 0; e < 32; ++e) { float s = 0.f;
#pragma unroll
        for (int j = 0; j < 4; ++j) { const f32x4 w = *(const LAS f32x4*)(WT + e * 1024 + 256 * j + 4 * lane); s += (h[4 * j] * w.x + h[4 * j + 1] * w.y) + (h[4 * j + 2] * w.z + h[4 * j + 3] * w.w); }
        s = wave_sum(s); mine = (lane == e) ? s : mine; }
    return mine;
}
__device__ __forceinline__ void stage_wt(Frame& F, const float* src) {
    LAS f32x4* dst = (LAS f32x4*)(F.lds + RING_OFF); const f32x4* s4 = (const f32x4*)src;
    for (int i = F.tid; i < 8192; i += NWAVES * 64) dst[i] = s4[i];
    __syncthreads();
}

__device__ __forceinline__ void p2_prep(Frame& F, const Args& A) {
    stage_wt(F, WSP(A,float,WS_WDT));
    const LAS float* WT = (const LAS float*)(F.lds + RING_OFF);
    const int lane = F.lane, wave = F.wave;
    float qw[16], kw[16];
#pragma unroll
    for (int q = 0; q < 4; ++q) { const f32x4 a = *(const f32x4*)(IN_QNW(A) + 16 * (lane & 3) + 4 * q), b = *(const f32x4*)(IN_KNW(A) + 16 * (lane & 3) + 4 * q);
#pragma unroll
        for (int i = 0; i < 4; ++i) { qw[4 * q + i] = a[i] * QSCALE; kw[4 * q + i] = b[i]; } }
    for (int item = F.vcu; item < M / 32; item += F.G) {
        const int t0 = item * 32 + wave * 4, b = t0 / SEQ, blk = (t0 % SEQ) / MBLK;
        float km[16];
#pragma unroll
        for (int i = 0; i < 16; ++i) km[i] = 0.f;
        for (int tt = 0; tt < 4; ++tt) {
            const int t = t0 + tt, pos = t % SEQ;
            bf16* prow = WSP(A,bf16,WS_PROJ) + (size_t)t * NPROJ;
            {
                float v[16]; { float lo[8], hi[8]; unpk8(*(const v4u*)(prow + PQ + 16 * lane), lo); unpk8(*(const v4u*)(prow + PQ + 16 * lane + 8), hi);
#pragma unroll
                    for (int i = 0; i < 8; ++i) { v[i] = lo[i]; v[8 + i] = hi[i]; } }
                float ss = 0.f;
#pragma unroll
                for (int i = 0; i < 16; ++i) ss += v[i] * v[i];
                ss += __shfl_xor(ss, 1); ss += __shfl_xor(ss, 2);
                const float rs = 1.0f / sqrtf(ss * (1.f / 64.f) + NORM_EPS);
                float lo[8], hi[8];
#pragma unroll
                for (int i = 0; i < 8; ++i) { lo[i] = v[i] * rs * qw[i]; hi[i] = v[8 + i] * rs * qw[8 + i]; }
                *(v4u*)(prow + PQ + 16 * lane) = pack8(lo); *(v4u*)(prow + PQ + 16 * lane + 8) = pack8(hi);
            }
            {
                float v[16]; { float lo[8], hi[8]; unpk8(*(const v4u*)(prow + PK + 16 * lane), lo); unpk8(*(const v4u*)(prow + PK + 16 * lane + 8), hi);
#pragma unroll
                    for (int i = 0; i < 8; ++i) { v[i] = lo[i]; v[8 + i] = hi[i]; } }
                float ss = 0.f;
#pragma unroll
                for (int i = 0; i < 16; ++i) ss += v[i] * v[i];
                ss += __shfl_xor(ss, 1); ss += __shfl_xor(ss, 2);
                const float rs = 1.0f / sqrtf(ss * (1.f / 64.f) + NORM_EPS);
                float lo[8], hi[8];
#pragma unroll
                for (int i = 0; i < 8; ++i) { lo[i] = v[i] * rs * kw[i]; hi[i] = v[8 + i] * rs * kw[8 + i]; km[i] += lo[i]; km[8 + i] += hi[i]; }
                *(v4u*)(prow + PK + 16 * lane) = pack8(lo); *(v4u*)(prow + PK + 16 * lane + 8) = pack8(hi);
            }
#pragma unroll 1
            for (int g6 = 0; g6 < 6; ++g6) {
                const int c0 = g6 * 512 + 8 * lane; float acc[8];
                { const f32x4 b0 = *(const f32x4*)(IN_CONVB(A) + c0), b1 = *(const f32x4*)(IN_CONVB(A) + c0 + 4);
#pragma unroll
                  for (int i = 0; i < 4; ++i) { acc[i] = b0[i]; acc[4 + i] = b1[i]; } }
#pragma unroll
                for (int j = 0; j < CONVK; ++j) {
                    if (pos - (CONVK - 1) + j >= 0) {
                        float xv[8]; unpk8(*(const v4u*)(WSP(A,bf16,WS_PROJ) + (size_t)(t - (CONVK - 1) + j) * NPROJ + PXBC + c0), xv);
                        const f32x4 w0 = *(const f32x4*)(IN_CONVW(A) + j * D_XBC + c0), w1 = *(const f32x4*)(IN_CONVW(A) + j * D_XBC + c0 + 4);
#pragma unroll
                        for (int i = 0; i < 4; ++i) { acc[i] += w0[i] * xv[i]; acc[4 + i] += w1[i] * xv[4 + i]; }
                    }
                }
#pragma unroll
                for (int i = 0; i < 8; ++i) acc[i] = silu_f(acc[i]);
                *(v4u*)(WSP(A,bf16,WS_XC) + (size_t)t * D_XBC + c0) = pack8(acc);
            }
            {
                float h[16]; const v2u* xr = (const v2u*)(WSP(A,bf16,WS_XN) + (size_t)t * D) + lane;
#pragma unroll
                for (int j = 0; j < 4; ++j) { const v2u w = xr[64 * j]; h[4 * j] = __uint_as_float(w.x << 16); h[4 * j + 1] = __uint_as_float(w.x & 0xffff0000u); h[4 * j + 2] = __uint_as_float(w.y << 16); h[4 * j + 3] = __uint_as_float(w.y & 0xffff0000u); }
                const float mine = rowdot32(h, WT, lane);
                if (lane < 32) { const float z = mine + IN_DTB(A)[lane]; WSP(A,float,WS_DT)[(size_t)t * 32 + lane] = fmaxf(z, 0.f) + log1pf(__expf(-fabsf(z))); }
            }
        }
        float* kmp = WSP(A,float,WS_KM) + ((size_t)(b * NH + (lane >> 2)) * NBLK + blk) * HD + 16 * (lane & 3);
#pragma unroll
        for (int i = 0; i < 16; ++i) unsafeAtomicAdd(kmp + i, km[i] * (1.f / MBLK));
    }
    __syncthreads();
}

__device__ __forceinline__ void p3_ssd(Frame& F, const Args& A) {
    LAS float* xs = (LAS float*)(F.lds + RING_OFF);
    LAS float* Bc = (LAS float*)(F.lds + RING_OFF + 16384);
    LAS float* Cc = (LAS float*)(F.lds + RING_OFF + 49152);
    LAS float* dtv = (LAS float*)(F.lds + RING_OFF + 81920);
    LAS float* yb = (LAS float*)(F.lds + RING_OFF + 82944);
    const int tid = F.tid;
    for (int unit = F.vcu; unit < BATCH * SSD_H; unit += F.G) {
        const int b = unit / SSD_H, h = unit % SSD_H, g = h / (SSD_H / NGRP);
        const float Aneg = -__expf(IN_ALOG(A)[h]), Dh = IN_DSKIP(A)[h];
        const int p = tid >> 3, ng = tid & 7;
        float st[16];
#pragma unroll
        for (int i = 0; i < 16; ++i) st[i] = 0.f;
        for (int ch = 0; ch < SEQ / 64; ++ch) {
            const int tb = b * SEQ + ch * 64;
            {
                const int r = tid >> 3, c8 = tid & 7;
                float v[8]; unpk8(*(const v4u*)(WSP(A,bf16,WS_XC) + (size_t)(tb + r) * D_XBC + h * 64 + 8 * c8), v);
#pragma unroll
                for (int i = 0; i < 8; ++i) xs[r * 64 + 8 * c8 + i] = v[i];
#pragma unroll
                for (int q = 0; q < 2; ++q) { const int idx = tid + 512 * q, rr = idx >> 4, c16 = idx & 15;
                    float bv[8], cv[8]; unpk8(*(const v4u*)(WSP(A,bf16,WS_XC) + (size_t)(tb + rr) * D_XBC + D_INNER + g * DSTATE + 8 * c16), bv); unpk8(*(const v4u*)(WSP(A,bf16,WS_XC) + (size_t)(tb + rr) * D_XBC + D_INNER + NGRP * DSTATE + g * DSTATE + 8 * c16), cv);
#pragma unroll
                    for (int i = 0; i < 8; ++i) { Bc[rr * 128 + 8 * c16 + i] = bv[i]; Cc[rr * 128 + 8 * c16 + i] = cv[i]; } }
                if (tid < 64) dtv[tid] = WSP(A,float,WS_DT)[(size_t)(tb + tid) * 32 + h];
            }
            __syncthreads();
            for (int tok = 0; tok < 64; ++tok) {
                const float dt = dtv[tok], decay = __expf(dt * Aneg), xdt = xs[tok * 64 + p] * dt;
                float yp = 0.f;
#pragma unroll
                for (int q = 0; q < 4; ++q) { const f32x4 bb = *(const LAS f32x4*)(Bc + tok * 128 + 16 * ng + 4 * q), cc = *(const LAS f32x4*)(Cc + tok * 128 + 16 * ng + 4 * q);
#pragma unroll
                    for (int i = 0; i < 4; ++i) { st[4 * q + i] = st[4 * q + i] * decay + bb[i] * xdt; yp += cc[i] * st[4 * q + i]; } }
                yp += __shfl_xor(yp, 1); yp += __shfl_xor(yp, 2); yp += __shfl_xor(yp, 4);
                if (ng == 0) yb[tok * 64 + p] = yp;
            }
            __syncthreads();
            {
                const int r = tid >> 3, c8 = tid & 7; const size_t t = (size_t)(tb + r);
                float z[8]; unpk8(*(const v4u*)(WSP(A,bf16,WS_PROJ) + t * NPROJ + PZ + h * 64 + 8 * c8), z);
                float o[8]; float ss = 0.f;
#pragma unroll
                for (int i = 0; i < 8; ++i) { const float y = yb[r * 64 + 8 * c8 + i] + Dh * xs[r * 64 + 8 * c8 + i]; o[i] = y * silu_f(z[i]); ss += o[i] * o[i]; }
                *(v4u*)(WSP(A,bf16,WS_YG) + t * D_INNER + h * 64 + 8 * c8) = pack8(o);
                ss += __shfl_xor(ss, 1); ss += __shfl_xor(ss, 2); ss += __shfl_xor(ss, 4);
                if (c8 == 0) { WSP(A,float,WS_SSQ)[t * 64 + 2 * h] = ss; WSP(A,float,WS_SSQ)[t * 64 + 2 * h + 1] = 0.f; }
            }
            __syncthreads();
        }
    }
}

typedef short bf16x8v __attribute__((ext_vector_type(8)));
typedef float f32x16 __attribute__((ext_vector_type(16)));
__device__ __forceinline__ int crow(int r, int hi) { return (r & 3) + 8 * (r >> 2) + 4 * hi; }

__device__ __forceinline__ void p3_ssd_mfma(Frame& F, const Args& A) {
    constexpr int RP = 272, TP = 144;
    constexpr int O_B = 0, O_C = 17408, O_BT = 34816, O_XT = 53248, O_S = 62464, O_CS = 97280, O_DT = 97536;
    LAS unsigned char* L = F.lds + RING_OFF;
    LAS float* csL = (LAS float*)(L + O_CS); LAS float* dtL = (LAS float*)(L + O_DT);
    const int tid = F.tid, lane = F.lane, wave = F.wave, r32 = lane & 31, hi = lane >> 5;
    for (int unit = F.vcu; unit < BATCH * SSD_H; unit += F.G) {
        const int b = unit / SSD_H, hd = unit % SSD_H, g = hd / (SSD_H / NGRP);
        const float Aneg = -__expf(IN_ALOG(A)[hd]), Dh = IN_DSKIP(A)[hd];
        const int lp = tid & 31, cc = tid >> 5;
        const bf16* bg = WSP(A,bf16,WS_XC) + (size_t)(b * SEQ + 2 * lp) * D_XBC + D_INNER + g * DSTATE + 8 * cc;
        const bf16* cg = bg + NGRP * DSTATE;
        const bf16* xg = WSP(A,bf16,WS_XC) + (size_t)(b * SEQ + 2 * lp) * D_XBC + hd * 64 + 8 * (cc & 7);
        const float* dg = WSP(A,float,WS_DT) + (size_t)(b * SEQ + (tid & 63)) * 32 + hd;
        v4u xr0, xr1, br0, br1, cr0, cr1; float dtr = 0.f;
#define SS_LOAD(c) do { const size_t o_ = (size_t)(c) * 64 * D_XBC; br0 = *(const v4u*)(bg + o_); br1 = *(const v4u*)(bg + o_ + D_XBC); cr0 = *(const v4u*)(cg + o_); cr1 = *(const v4u*)(cg + o_ + D_XBC); \
            if (cc < 8) { xr0 = *(const v4u*)(xg + o_); xr1 = *(const v4u*)(xg + o_ + D_XBC); } \
            if (tid < 64) dtr = dg[(size_t)(c) * 64 * 32]; } while (0)
#define SS_STORE() do { \
            *(LAS v4u*)(L + O_B + (2 * lp) * RP + cc * 16) = br0; *(LAS v4u*)(L + O_B + (2 * lp + 1) * RP + cc * 16) = br1; \
            *(LAS v4u*)(L + O_C + (2 * lp) * RP + cc * 16) = cr0; *(LAS v4u*)(L + O_C + (2 * lp + 1) * RP + cc * 16) = cr1; \
            _Pragma("unroll") for (int i_ = 0; i_ < 4; ++i_) { \
                *(LAS unsigned*)(L + O_BT + (8 * cc + 2 * i_) * TP + lp * 4) = (br0[i_] & 0xffffu) | (br1[i_] << 16); *(LAS unsigned*)(L + O_BT + (8 * cc + 2 * i_ + 1) * TP + lp * 4) = (br0[i_] >> 16) | (br1[i_] & 0xffff0000u); } \
            if (cc < 8) { _Pragma("unroll") for (int i_ = 0; i_ < 4; ++i_) { \
                *(LAS unsigned*)(L + O_XT + (8 * cc + 2 * i_) * TP + lp * 4) = (xr0[i_] & 0xffffu) | (xr1[i_] << 16); *(LAS unsigned*)(L + O_XT + (8 * cc + 2 * i_ + 1) * TP + lp * 4) = (xr0[i_] >> 16) | (xr1[i_] & 0xffff0000u); } } \
            if (tid < 64) { float a_ = dtr * Aneg; \
                _Pragma("unroll") for (int o_ = 1; o_ < 64; o_ <<= 1) { const float v_ = __shfl_up(a_, o_); if (lane >= o_) a_ += v_; } \
                csL[tid] = a_; dtL[tid] = dtr; } } while (0)
#define SS_BAR() do { asm volatile("s_waitcnt lgkmcnt(0)" ::: "memory"); __builtin_amdgcn_s_barrier(); asm volatile("" ::: "memory"); } while (0)
        SS_LOAD(0); SS_STORE();
        f32x16 s0 = {}, s1 = {};
        __syncthreads();
        for (int c = 0; c < SEQ / 64; ++c) {
            const unsigned long long ts0 = SEC_T();
            if (c + 1 < SEQ / 64) SS_LOAD(c + 1);
            __builtin_amdgcn_sched_barrier(0);
            const int tb = b * SEQ + c * 64;
            if (wave < 4) {
                const int pt = wave & 1, lt = wave >> 1;
                const size_t t = (size_t)(tb + 32 * lt + r32); v2u zq[4], xq[4];
#pragma unroll
                for (int g4 = 0; g4 < 4; ++g4) { const int pc = hd * 64 + 32 * pt + 8 * g4 + 4 * hi; zq[g4] = *(const v2u*)(WSP(A,bf16,WS_PROJ) + t * NPROJ + PZ + pc); xq[g4] = *(const v2u*)(WSP(A,bf16,WS_XC) + t * D_XBC + pc); }
                __builtin_amdgcn_sched_barrier(0);
                const LAS unsigned char* Sb = L + O_S + (c & 1) * 17408;
                f32x16 acc = {};
                const float csl = csL[32 * lt + r32];
                if (c > 0) {
#pragma unroll
                    for (int ks = 0; ks < 8; ++ks) { const bf16x8v af = *(const LAS bf16x8v*)(Sb + (32 * pt + r32) * RP + ks * 32 + hi * 16), bf = *(const LAS bf16x8v*)(L + O_C + (32 * lt + r32) * RP + ks * 32 + hi * 16);
                        acc = __builtin_amdgcn_mfma_f32_32x32x16_bf16(af, bf, acc, 0, 0, 0); }
                    const float el = __expf(csl);
#pragma unroll
                    for (int r = 0; r < 16; ++r) acc[r] *= el;
                }
                for (int st = 0; st <= lt; ++st) {
                    f32x16 gt = {};
#pragma unroll
                    for (int ks = 0; ks < 8; ++ks) { const bf16x8v af = *(const LAS bf16x8v*)(L + O_B + (32 * st + r32) * RP + ks * 32 + hi * 16), bf = *(const LAS bf16x8v*)(L + O_C + (32 * lt + r32) * RP + ks * 32 + hi * 16);
                        gt = __builtin_amdgcn_mfma_f32_32x32x16_bf16(af, bf, gt, 0, 0, 0); }
                    const int lidx = 32 * lt + r32;
#pragma unroll
                    for (int g4 = 0; g4 < 4; ++g4) { const int sb = 32 * st + 8 * g4 + 4 * hi; const f32x4 cv = *(const LAS f32x4*)(csL + sb), dv = *(const LAS f32x4*)(dtL + sb);
#pragma unroll
                        for (int i = 0; i < 4; ++i) { const float e = __expf(fminf(csl - cv[i], 0.f)) * dv[i]; const float mk = (sb + i <= lidx) ? 1.0f : 0.0f; gt[4 * g4 + i] = gt[4 * g4 + i] * (e * mk); } }
                    v4u m0, m1;
#pragma unroll
                    for (int q = 0; q < 4; ++q) { m0[q] = pk2(gt[2 * q], gt[2 * q + 1]); m1[q] = pk2(gt[8 + 2 * q], gt[8 + 2 * q + 1]); }
                    const LAS unsigned char* xrow = L + O_XT + (32 * pt + r32) * TP + (32 * st + 4 * hi) * 2;
                    { const v2u a0 = *(const LAS v2u*)(xrow), a1 = *(const LAS v2u*)(xrow + 16); v4u av; av.x = a0.x; av.y = a0.y; av.z = a1.x; av.w = a1.y;
                      acc = __builtin_amdgcn_mfma_f32_32x32x16_bf16(__builtin_bit_cast(bf16x8v, av), __builtin_bit_cast(bf16x8v, m0), acc, 0, 0, 0); }
                    { const v2u a0 = *(const LAS v2u*)(xrow + 32), a1 = *(const LAS v2u*)(xrow + 48); v4u av; av.x = a0.x; av.y = a0.y; av.z = a1.x; av.w = a1.y;
                      acc = __builtin_amdgcn_mfma_f32_32x32x16_bf16(__builtin_bit_cast(bf16x8v, av), __builtin_bit_cast(bf16x8v, m1), acc, 0, 0, 0); }
                }
                SEC_ADD(1, ts0); const unsigned long long ts1 = SEC_T();
                float ss = 0.f;
#pragma unroll
                for (int g4 = 0; g4 < 4; ++g4) { const int pc = hd * 64 + 32 * pt + 8 * g4 + 4 * hi;
                    const v2u zz = zq[g4], xx = xq[g4];
                    const float z[4] = {__uint_as_float(zz.x << 16), __uint_as_float(zz.x & 0xffff0000u), __uint_as_float(zz.y << 16), __uint_as_float(zz.y & 0xffff0000u)};
                    const float x[4] = {__uint_as_float(xx.x << 16), __uint_as_float(xx.x & 0xffff0000u), __uint_as_float(xx.y << 16), __uint_as_float(xx.y & 0xffff0000u)};
                    float o[4];
#pragma unroll
                    for (int i = 0; i < 4; ++i) { const float y = acc[4 * g4 + i] + Dh * x[i]; o[i] = y * silu_f(z[i]); ss += o[i] * o[i]; }
                    v2u w; w.x = pk2(o[0], o[1]); w.y = pk2(o[2], o[3]); *(v2u*)(WSP(A,bf16,WS_YG) + t * D_INNER + pc) = w; }
                ss += __shfl_xor(ss, 32);
                if (hi == 0) WSP(A,float,WS_SSQ)[t * 64 + hd * 2 + pt] = ss;
                SEC_ADD(2, ts1);
            } else {
                const int w4 = wave - 4, pt = w4 & 1, nt0 = 2 * (w4 >> 1);
                const float cslast = csL[63]; const float dec = __expf(cslast);
#pragma unroll
                for (int r = 0; r < 16; ++r) { s0[r] *= dec; s1[r] *= dec; }
#pragma unroll
                for (int ks = 0; ks < 4; ++ks) {
                    float xv[8]; unpk8(*(const LAS v4u*)(L + O_XT + (32 * pt + r32) * TP + ks * 32 + hi * 16), xv);
                    const f32x4 c0 = *(const LAS f32x4*)(csL + 16 * ks + 8 * hi), c1 = *(const LAS f32x4*)(csL + 16 * ks + 8 * hi + 4), d0 = *(const LAS f32x4*)(dtL + 16 * ks + 8 * hi), d1 = *(const LAS f32x4*)(dtL + 16 * ks + 8 * hi + 4);
#pragma unroll
                    for (int i = 0; i < 4; ++i) { xv[i] *= d0[i] * __expf(cslast - c0[i]); xv[4 + i] *= d1[i] * __expf(cslast - c1[i]); }
                    const bf16x8v af = __builtin_bit_cast(bf16x8v, pack8(xv));
                    const bf16x8v b0 = *(const LAS bf16x8v*)(L + O_BT + (32 * nt0 + r32) * TP + ks * 32 + hi * 16), b1 = *(const LAS bf16x8v*)(L + O_BT + (32 * nt0 + 32 + r32) * TP + ks * 32 + hi * 16);
                    s0 = __builtin_amdgcn_mfma_f32_32x32x16_bf16(af, b0, s0, 0, 0, 0); s1 = __builtin_amdgcn_mfma_f32_32x32x16_bf16(af, b1, s1, 0, 0, 0);
                }
                LAS unsigned char* Sn = L + O_S + ((c + 1) & 1) * 17408;
#pragma unroll
                for (int r = 0; r < 16; ++r) { const int p = 32 * pt + crow(r, hi);
                    *(LAS unsigned short*)(Sn + p * RP + (32 * nt0 + r32) * 2) = (unsigned short)f2bf(s0[r]); *(LAS unsigned short*)(Sn + p * RP + (32 * nt0 + 32 + r32) * 2) = (unsigned short)f2bf(s1[r]); }
            }
            const unsigned long long ts2 = SEC_T();
            SS_BAR();
            SEC_ADD(3, ts2); const unsigned long long ts3 = SEC_T();
            if (c + 1 < SEQ / 64) SS_STORE();
            asm volatile("s_waitcnt lgkmcnt(0)" ::: "memory"); SEC_ADD(4, ts3); const unsigned long long ts4 = SEC_T();
            SS_BAR();
            SEC_ADD(5, ts4); SEC_ADD(6, ts0);
        }
#undef SS_LOAD
#undef SS_STORE
#undef SS_BAR
    }
}


typedef short v4i16_t __attribute__((ext_vector_type(4)));
__device__ __forceinline__ v2u ldtr(const LAS unsigned char* p) { return __builtin_bit_cast(v2u, __builtin_amdgcn_ds_read_tr16_b64_v4i16((LAS v4i16_t*)p)); }
__device__ __forceinline__ int tr_off(int lane, int row0, int col0, int pitch) { return (row0 + ((lane & 15) >> 2)) * pitch + (col0 + 16 * ((lane >> 4) & 1) + 4 * (lane & 3)) * 2; }
__device__ __forceinline__ void p3_ssd_mfma2(Frame& F, const Args& A) {
    constexpr int RP = 272, XP = 144;
    constexpr int O_B = 0, O_C = 17408, O_X = 34816, O_Z = 44032, O_Y = 53248, O_S = 62464, O_CS = 97280, O_CS1 = 128768;
    LAS unsigned char* L = F.lds + RING_OFF;
#define S2_ARR(p) ((LAS float*)(L + ((p) ? O_CS1 : O_CS)))
    const int tid = F.tid, lane = F.lane, wave = F.wave, r32 = lane & 31, hi = lane >> 5;
    for (int unit = F.vcu; unit < BATCH * SSD_H; unit += F.G) {
        const int b = unit / SSD_H, hd = unit % SSD_H, g = hd / (SSD_H / NGRP);
        const float Aneg = -__expf(IN_ALOG(A)[hd]) * 1.44269504f, Dh = IN_DSKIP(A)[hd];
        const int xrow = tid >> 3, xch = tid & 7, brow = tid >> 4, bch = tid & 15;
        const bf16* xg = WSP(A,bf16,WS_XC) + (size_t)(b * SEQ + xrow) * D_XBC + hd * 64 + 8 * xch;
        const bf16* zg = WSP(A,bf16,WS_PROJ) + (size_t)(b * SEQ + xrow) * NPROJ + PZ + hd * 64 + 8 * xch;
        const bf16* bg = WSP(A,bf16,WS_XC) + (size_t)(b * SEQ + brow) * D_XBC + D_INNER + g * DSTATE + 8 * bch;
        const bf16* cg = bg + NGRP * DSTATE;
        const float* dg = WSP(A,float,WS_DT) + (size_t)(b * SEQ + (tid & 63)) * 32 + hd;
        bf16* yg = WSP(A,bf16,WS_YG) + (size_t)(b * SEQ + xrow) * D_INNER + hd * 64 + 8 * xch;
        float* sqg = WSP(A,float,WS_SSQ) + (size_t)(b * SEQ + xrow) * 32 + hd;
        v4u xr, zr, zc, br0, br1, cr0, cr1; float dtr = 0.f;
#define S2_LOAD(c) do { const size_t o_ = (size_t)(c) * 64 * D_XBC; xr = *(const v4u*)(xg + o_); zr = *(const v4u*)(zg + (size_t)(c) * 64 * NPROJ); \
            br0 = *(const v4u*)(bg + o_); br1 = *(const v4u*)(bg + o_ + 32 * D_XBC); cr0 = *(const v4u*)(cg + o_); cr1 = *(const v4u*)(cg + o_ + 32 * D_XBC); \
            if (tid < 64) dtr = dg[(size_t)(c) * 64 * 32]; } while (0)
#define S2_SCAN(p) do { LAS float* q_ = S2_ARR(p); float a_ = dtr * Aneg; \
            _Pragma("unroll") for (int o_ = 1; o_ < 64; o_ <<= 1) { const float v_ = __shfl_up(a_, o_); if (lane >= o_) a_ += v_; } \
            q_[lane] = a_; q_[64 + lane] = dtr; q_[128 + lane] = dtr * __builtin_amdgcn_exp2f(__shfl(a_, 63) - a_); q_[192 + lane] = dtr * __builtin_amdgcn_exp2f(fminf(__shfl(a_, 31) - a_, 0.f)); } while (0)
#define S2_STORE(p) do { \
            *(LAS v4u*)(L + O_X + xrow * XP + xch * 16) = xr; zc = zr; \
            { const float wr_ = S2_ARR(p)[128 + xrow]; float xf_[8]; unpk8(xr, xf_); _Pragma("unroll") for (int i_ = 0; i_ < 8; ++i_) xf_[i_] *= wr_; *(LAS v4u*)(L + O_Z + xrow * XP + xch * 16) = pack8(xf_); } \
            *(LAS v4u*)(L + O_B + brow * RP + bch * 16) = br0; *(LAS v4u*)(L + O_B + (brow + 32) * RP + bch * 16) = br1; \
            *(LAS v4u*)(L + O_C + brow * RP + bch * 16) = cr0; *(LAS v4u*)(L + O_C + (brow + 32) * RP + bch * 16) = cr1; } while (0)
#define S2_BAR() do { asm volatile("s_waitcnt lgkmcnt(0)" ::: "memory"); __builtin_amdgcn_s_barrier(); asm volatile("" ::: "memory"); } while (0)
        S2_LOAD(0); if (wave == 0) S2_SCAN(0);
        S2_BAR(); S2_STORE(0);
        f32x16 s0 = {}, s1 = {};
        f32x4 ta[4], tb[4];
#pragma unroll
        for (int i = 0; i < 4; ++i) { ta[i] = (f32x4){0.f, 0.f, 0.f, 0.f}; tb[i] = ta[i]; }
        S2_BAR();
        if (wave < 4) {
        for (int c = 0; c < SEQ / 64; ++c) {
            const unsigned long long ts0 = SEC_T();
            const LAS float* csL = S2_ARR(c & 1); const LAS float* dtL = csL + 64; const LAS float* w31L = csL + 192;
            if (c + 1 < SEQ / 64) S2_LOAD(c + 1);
            __builtin_amdgcn_sched_barrier(0);
            if (BG_MOE_CONVERT && unit < 256 && !(c & 1)) {
                LAS unsigned* tscr = (LAS unsigned*)(wave < 7 ? (L + 98304 + wave * 4352) : (F.lds + UTOK_OFF)); const int ibase = (unit * 8 + wave) * BG_SSD, jc = c >> 1;
                if (jc > 0 && jc <= BG_SSD) tr_finish(moe_item(A, ibase + jc - 1), lane, ta, tb, tscr);
                if (jc < BG_SSD) tr_issue(moe_item(A, ibase + jc), lane, ta, tb);
                __builtin_amdgcn_sched_barrier(0); }
            {
                const int pt = wave & 1, lt = wave >> 1;
                const LAS unsigned char* Sb = L + O_S + (c & 1) * 17408;
                f32x16 acc = {};
                const float csl = csL[32 * lt + r32];
                bf16x8v cfr[8];
#pragma unroll
                for (int ks = 0; ks < 8; ++ks) cfr[ks] = *(const LAS bf16x8v*)(L + O_C + (32 * lt + r32) * RP + ks * 32 + hi * 16);
                if (c > 0) {
#pragma unroll
                    for (int ks = 0; ks < 8; ++ks) { const bf16x8v af = *(const LAS bf16x8v*)(Sb + (32 * pt + r32) * RP + ks * 32 + hi * 16);
                        acc = __builtin_amdgcn_mfma_f32_32x32x16_bf16(af, cfr[ks], acc, 0, 0, 0); }
                    const float el = __builtin_amdgcn_exp2f(csl);
#pragma unroll
                    for (int r = 0; r < 16; ++r) acc[r] *= el;
                }
                for (int st = 0; st <= lt; ++st) {
                    f32x16 gt = {};
#pragma unroll
                    for (int ks = 0; ks < 8; ++ks) { const bf16x8v af = *(const LAS bf16x8v*)(L + O_B + (32 * st + r32) * RP + ks * 32 + hi * 16);
                        gt = __builtin_amdgcn_mfma_f32_32x32x16_bf16(af, cfr[ks], gt, 0, 0, 0); }
                    const int lidx = 32 * lt + r32;
                    if (st < lt) {
                        const float u = __builtin_amdgcn_exp2f(csl - csL[31]);
#pragma unroll
                        for (int g4 = 0; g4 < 4; ++g4) { const f32x4 wv = *(const LAS f32x4*)(w31L + 8 * g4 + 4 * hi);
#pragma unroll
                            for (int i = 0; i < 4; ++i) gt[4 * g4 + i] = gt[4 * g4 + i] * (wv[i] * u); }
                    } else {
#pragma unroll
                    for (int g4 = 0; g4 < 4; ++g4) { const int sb = 32 * st + 8 * g4 + 4 * hi; const f32x4 cv = *(const LAS f32x4*)(csL + sb), dv = *(const LAS f32x4*)(dtL + sb);
#pragma unroll
                        for (int i = 0; i < 4; ++i) { const float e = __builtin_amdgcn_exp2f((sb + i <= lidx) ? csl - cv[i] : -256.f) * dv[i]; gt[4 * g4 + i] = gt[4 * g4 + i] * e; } }
                    }
                    v4u m0, m1;
#pragma unroll
                    for (int q = 0; q < 4; ++q) { m0[q] = pk2(gt[2 * q], gt[2 * q + 1]); m1[q] = pk2(gt[8 + 2 * q], gt[8 + 2 * q + 1]); }
                    { const v2u a0 = ldtr(L + O_X + tr_off(lane, 32 * st + 4 * hi, 32 * pt, XP)), a1 = ldtr(L + O_X + tr_off(lane, 32 * st + 8 + 4 * hi, 32 * pt, XP)); v4u av; av.x = a0.x; av.y = a0.y; av.z = a1.x; av.w = a1.y;
                      acc = __builtin_amdgcn_mfma_f32_32x32x16_bf16(__builtin_bit_cast(bf16x8v, av), __builtin_bit_cast(bf16x8v, m0), acc, 0, 0, 0); }
                    { const v2u a0 = ldtr(L + O_X + tr_off(lane, 32 * st + 16 + 4 * hi, 32 * pt, XP)), a1 = ldtr(L + O_X + tr_off(lane, 32 * st + 24 + 4 * hi, 32 * pt, XP)); v4u av; av.x = a0.x; av.y = a0.y; av.z = a1.x; av.w = a1.y;
                      acc = __builtin_amdgcn_mfma_f32_32x32x16_bf16(__builtin_bit_cast(bf16x8v, av), __builtin_bit_cast(bf16x8v, m1), acc, 0, 0, 0); }
                }
                const int lrow = 32 * lt + r32;
#pragma unroll
                for (int g4 = 0; g4 < 4; ++g4) { const int pc = 32 * pt + 8 * g4 + 4 * hi; v2u w; w.x = pk2(acc[4 * g4], acc[4 * g4 + 1]); w.y = pk2(acc[4 * g4 + 2], acc[4 * g4 + 3]); *(LAS v2u*)(L + O_Y + lrow * XP + pc * 2) = w; }
            }
            if (wave == 0 && c + 1 < SEQ / 64) S2_SCAN((c + 1) & 1);
            SEC_ADD(1, ts0); const unsigned long long ts2 = SEC_T();
            S2_BAR();
            SEC_ADD(3, ts2); const unsigned long long ts3 = SEC_T();
            {
                float f[8], xv[8], zv[8]; unpk8(*(const LAS v4u*)(L + O_Y + xrow * XP + xch * 16), f); unpk8(*(const LAS v4u*)(L + O_X + xrow * XP + xch * 16), xv); unpk8(zc, zv);
                float ss = 0.f;
#pragma unroll
                for (int i = 0; i < 8; ++i) { f[i] = (f[i] + Dh * xv[i]) * silu_f(zv[i]); ss += f[i] * f[i]; }
                *(v4u*)(yg + (size_t)c * 64 * D_INNER) = pack8(f);
                ss += __shfl_xor(ss, 1); ss += __shfl_xor(ss, 2); ss += __shfl_xor(ss, 4);
                if (xch == 0) sqg[(size_t)c * 64 * 32] = ss;
            }
            if (c + 1 < SEQ / 64) S2_STORE((c + 1) & 1);
            asm volatile("s_waitcnt lgkmcnt(0)" ::: "memory"); SEC_ADD(4, ts3); const unsigned long long ts4 = SEC_T();
            S2_BAR();
            SEC_ADD(5, ts4); SEC_ADD(6, ts0);
        }
        } else {
        for (int c = 0; c < SEQ / 64; ++c) {
            const unsigned long long ts0 = SEC_T();
            const LAS float* csL = S2_ARR(c & 1); const LAS float* dtL = csL + 64; const LAS float* w31L = csL + 192;
            if (c + 1 < SEQ / 64) S2_LOAD(c + 1);
            __builtin_amdgcn_sched_barrier(0);
            if (BG_MOE_CONVERT && unit < 256 && !(c & 1)) {
                LAS unsigned* tscr = (LAS unsigned*)(wave < 7 ? (L + 98304 + wave * 4352) : (F.lds + UTOK_OFF)); const int ibase = (unit * 8 + wave) * BG_SSD, jc = c >> 1;
                if (jc > 0 && jc <= BG_SSD) tr_finish(moe_item(A, ibase + jc - 1), lane, ta, tb, tscr);
                if (jc < BG_SSD) tr_issue(moe_item(A, ibase + jc), lane, ta, tb);
                __builtin_amdgcn_sched_barrier(0); }
            {
                const int w4 = wave - 4, pt = w4 & 1, nt0 = 2 * (w4 >> 1);
                __builtin_amdgcn_sched_barrier(0);
                const float cslast = csL[63]; const float dec = __builtin_amdgcn_exp2f(cslast);
#pragma unroll
                for (int r = 0; r < 16; ++r) { s0[r] *= dec; s1[r] *= dec; }
#pragma unroll
                for (int ks = 0; ks < 4; ++ks) {
                    const v2u xa = ldtr(L + O_Z + tr_off(lane, 16 * ks + 8 * hi, 32 * pt, XP)), xb = ldtr(L + O_Z + tr_off(lane, 16 * ks + 8 * hi + 4, 32 * pt, XP));
                    v4u xw; xw.x = xa.x; xw.y = xa.y; xw.z = xb.x; xw.w = xb.y;
                    const bf16x8v af = __builtin_bit_cast(bf16x8v, xw);
                    v4u bw0, bw1;
                    { const v2u t0 = ldtr(L + O_B + tr_off(lane, 16 * ks + 8 * hi, 32 * nt0, RP)), t1 = ldtr(L + O_B + tr_off(lane, 16 * ks + 8 * hi + 4, 32 * nt0, RP)); bw0.x = t0.x; bw0.y = t0.y; bw0.z = t1.x; bw0.w = t1.y; }
                    { const v2u t0 = ldtr(L + O_B + tr_off(lane, 16 * ks + 8 * hi, 32 * nt0 + 32, RP)), t1 = ldtr(L + O_B + tr_off(lane, 16 * ks + 8 * hi + 4, 32 * nt0 + 32, RP)); bw1.x = t0.x; bw1.y = t0.y; bw1.z = t1.x; bw1.w = t1.y; }
                    s0 = __builtin_amdgcn_mfma_f32_32x32x16_bf16(af, __builtin_bit_cast(bf16x8v, bw0), s0, 0, 0, 0); s1 = __builtin_amdgcn_mfma_f32_32x32x16_bf16(af, __builtin_bit_cast(bf16x8v, bw1), s1, 0, 0, 0);
                }
                LAS unsigned char* Sn = L + O_S + ((c + 1) & 1) * 17408;
#pragma unroll
                for (int r = 0; r < 16; ++r) { const int p = 32 * pt + crow(r, hi);
                    const unsigned pw = pk2(s0[r], s1[r]);
                    *(LAS unsigned short*)(Sn + p * RP + (32 * nt0 + r32) * 2) = (unsigned short)(pw & 0xffffu); *(LAS unsigned short*)(Sn + p * RP + (32 * nt0 + 32 + r32) * 2) = (unsigned short)(pw >> 16); }
            }
            SEC_ADD(1, ts0); const unsigned long long ts2 = SEC_T();
            S2_BAR();
            SEC_ADD(3, ts2); const unsigned long long ts3 = SEC_T();
            {
                float f[8], xv[8], zv[8]; unpk8(*(const LAS v4u*)(L + O_Y + xrow * XP + xch * 16), f); unpk8(*(const LAS v4u*)(L + O_X + xrow * XP + xch * 16), xv); unpk8(zc, zv);
                float ss = 0.f;
#pragma unroll
                for (int i = 0; i < 8; ++i) { f[i] = (f[i] + Dh * xv[i]) * silu_f(zv[i]); ss += f[i] * f[i]; }
                *(v4u*)(yg + (size_t)c * 64 * D_INNER) = pack8(f);
                ss += __shfl_xor(ss, 1); ss += __shfl_xor(ss, 2); ss += __shfl_xor(ss, 4);
                if (xch == 0) sqg[(size_t)c * 64 * 32] = ss;
            }
            if (c + 1 < SEQ / 64) S2_STORE((c + 1) & 1);
            asm volatile("s_waitcnt lgkmcnt(0)" ::: "memory"); SEC_ADD(4, ts3); const unsigned long long ts4 = SEC_T();
            S2_BAR();
            SEC_ADD(5, ts4); SEC_ADD(6, ts0);
        }
        }
#undef S2_LOAD
#undef S2_STORE
#undef S2_SCAN
#undef S2_ARR
#undef S2_BAR
    }
}

__device__ __forceinline__ void p4_norm(Frame& F, const Args& A) {
    const int lane = F.lane, gw = F.vcu * NWAVES + F.wave, NGW = F.G * NWAVES;
    for (int t = gw; t < M; t += NGW) {
        bf16* row = WSP(A,bf16,WS_YG) + (size_t)t * D_INNER + 32 * lane; const int g = lane >> 4;
        float ss = 0.f;
#pragma unroll
        for (int hh = 0; hh < 16; ++hh) ss += WSP(A,float,WS_SSQ)[(size_t)t * 64 + 16 * g + hh];
        const float rs = 1.0f / sqrtf(ss * (1.f / 512.f) + NORM_EPS);
#pragma unroll
        for (int q = 0; q < 4; ++q) { float v[8]; unpk8(*(const v4u*)(row + 8 * q), v); const f32x4 w0 = *(const f32x4*)(IN_SSDNW(A) + 32 * lane + 8 * q), w1 = *(const f32x4*)(IN_SSDNW(A) + 32 * lane + 8 * q + 4);
#pragma unroll
            for (int i = 0; i < 4; ++i) { v[i] = v[i] * rs * w0[i]; v[4 + i] = v[4 + i] * rs * w1[i]; }
            *(v4u*)(row + 8 * q) = pack8(v); }
    }
}
__device__ __forceinline__ void attn_simple(Frame& F, const Args& A) {
    const int lane = F.lane, gw = F.vcu * NWAVES + F.wave, NGW = F.G * NWAVES;
    const float qwm = wave_max(fabsf(IN_QNW(A)[lane])), kwm = wave_max(fabsf(IN_KNW(A)[lane]));
    const float REF = 8.0f * qwm * kwm * 1.4426950408889634f + 0.25f;
    const bf16* QN = WSP(A,bf16,WS_PROJ) + PQ; const bf16* KN = WSP(A,bf16,WS_PROJ) + PK; const bf16* VV = WSP(A,bf16,WS_PROJ) + PV;
    for (int rep = 0; rep < REP(PH_ATTN); ++rep)
    for (long a = gw; a < (long)M * NH; a += NGW) {
        const int grp = (int)(a >> 7), within = (int)(a & 127), h = within >> 3, t = grp * 8 + (within & 7);
        const int b = t / SEQ, pos = t % SEQ, qb = pos >> 8;
        const bf16* qp = QN + (size_t)t * NPROJ + h * 64;
        float q[64];
#pragma unroll
        for (int c = 0; c < 8; ++c) { float v[8]; unpk8(*(const v4u*)(qp + 8 * c), v);
#pragma unroll
            for (int i = 0; i < 8; ++i) q[8 * c + i] = v[i]; }
        const float qd = bf2f(qp[lane]);
        float sc[7];
#pragma unroll
        for (int j = 0; j < 7; ++j) { sc[j] = -3.0e38f; if (j < qb) sc[j] = wave_sum(qd * WSP(A,float,WS_KM)[((size_t)(b * NH + h) * NBLK + j) * HD + lane]); }
        unsigned sel = 0u; const int nsel = qb < MOBA_TOPK ? qb : MOBA_TOPK;
#pragma unroll
        for (int k = 0; k < MOBA_TOPK; ++k) if (k < nsel) { float best = -3.0e38f; int bi = 0;
#pragma unroll
            for (int j = 0; j < 7; ++j) if (j < qb && !((sel >> j) & 1u) && sc[j] > best) { best = sc[j]; bi = j; }
            sel |= 1u << bi; }
        sel |= 1u << qb;
        float o = 0.f, lsum = 0.f;
        for (int j = 0; j <= qb; ++j) {
            if (!((sel >> j) & 1u)) continue;
            for (int tile = 0; tile < 4; ++tile) {
                const int kbase = j * MBLK + tile * 64; if (j == qb && kbase > pos) break;
                const int kk = kbase + lane; const bf16* kp = KN + (size_t)(b * SEQ + kk) * NPROJ + h * 64;
                float dot = 0.f;
#pragma unroll
                for (int c = 0; c < 8; ++c) { float v[8]; unpk8(*(const v4u*)(kp + 8 * c), v);
#pragma unroll
                    for (int i = 0; i < 8; ++i) dot += v[i] * q[8 * c + i]; }
                const bool valid = (j < qb) || (kk <= pos);
                const float pr = valid ? __builtin_amdgcn_exp2f(dot - REF) : 0.f; lsum += pr;
                const bf16* vp = VV + (size_t)(b * SEQ + kbase) * NPROJ + h * 64 + lane;
#pragma unroll 16
                for (int jj = 0; jj < 64; ++jj) { const float pj = __shfl(pr, jj); o += pj * bf2f(vp[(size_t)jj * NPROJ]); }
            }
        }
        const float l = wave_sum(lsum);
        WSP(A,bf16,WS_AO)[(size_t)t * D + h * 64 + lane] = (bf16)f2bf(o / l);
    }
}


__device__ __forceinline__ void attn_mfma(Frame& F, const Args& A) {
    const int tid = F.tid, lane = F.lane, wave = F.wave, r32 = lane & 31, hi = lane >> 5;
    constexpr int KP = 144, VP = 136, KBS = 9216, VB0 = 18432, VBS = 8704, KMOFF = 36864;
    LAS unsigned char* L = F.lds + RING_OFF;
    LAS float* KMs = (LAS float*)(L + KMOFF);
    const float qwm = wave_max(fabsf(IN_QNW(A)[lane])), kwm = wave_max(fabsf(IN_KNW(A)[lane]));
    const float REF = 8.0f * qwm * kwm * 1.4426950408889634f + 0.25f;
    const bf16* QN = WSP(A,bf16,WS_PROJ) + PQ; const bf16* KN = WSP(A,bf16,WS_PROJ) + PK; const bf16* VV = WSP(A,bf16,WS_PROJ) + PV;
    for (int slot = F.vcu; slot < 256; slot += F.G)
    for (int ui = 0; ui < 4; ++ui) {
        const int bh = slot >> 1, sp = slot & 1, b = bh >> 4, h = bh & 15;
        const int qb = (sp == 0) ? (ui == 0 ? 0 : ui == 1 ? 7 : ui == 2 ? 1 : 6) : (ui == 0 ? 2 : ui == 1 ? 5 : ui == 2 ? 3 : 4);
        const int tq0 = b * SEQ + qb * MBLK, NT = 4 * (qb + 1);
        const bf16* kg = KN + (size_t)(b * SEQ + (tid >> 3)) * NPROJ + h * 64 + 8 * (tid & 7);
        const bf16* vg = VV + (size_t)(b * SEQ + 2 * (tid >> 4)) * NPROJ + h * 64 + 4 * (tid & 15);
        v4u kreg; v2u vr0, vr1;
#define AT_LOAD(tt) do { kreg = *(const v4u*)(kg + (size_t)(tt) * 64 * NPROJ); vr0 = *(const v2u*)(vg + (size_t)(tt) * 64 * NPROJ); vr1 = *(const v2u*)(vg + (size_t)(tt) * 64 * NPROJ + NPROJ); } while (0)
#define AT_STORE(bufi) do { *(LAS v4u*)(L + (bufi) * KBS + (tid >> 3) * KP + (tid & 7) * 16) = kreg; \
            LAS unsigned char* vb_ = L + VB0 + (bufi) * VBS + (4 * (tid & 15)) * VP + (tid >> 4) * 4; \
            *(LAS unsigned*)(vb_) = (vr0.x & 0xffffu) | (vr1.x << 16); *(LAS unsigned*)(vb_ + VP) = (vr0.x >> 16) | (vr1.x & 0xffff0000u); \
            *(LAS unsigned*)(vb_ + 2 * VP) = (vr0.y & 0xffffu) | (vr1.y << 16); *(LAS unsigned*)(vb_ + 3 * VP) = (vr0.y >> 16) | (vr1.y & 0xffff0000u); } while (0)
        if (tid < 448) { const int j = tid >> 6; if (j < qb) KMs[tid] = WSP(A,float,WS_KM)[((size_t)(b * NH + h) * NBLK + j) * HD + (tid & 63)]; }
        AT_LOAD(0); AT_STORE(0);
        const bf16* qp = QN + (size_t)(tq0 + wave * 32 + r32) * NPROJ + h * 64;
        bf16x8v qr[4];
#pragma unroll
        for (int ds = 0; ds < 4; ++ds) qr[ds] = *(const bf16x8v*)(qp + 16 * ds + 8 * hi);
        __syncthreads();
        float sc[7];
#pragma unroll
        for (int j = 0; j < 7; ++j) { sc[j] = -3.0e38f;
            if (j < qb) { float s = 0.f;
#pragma unroll
                for (int ds = 0; ds < 4; ++ds) { float qv[8]; unpk8(__builtin_bit_cast(v4u, qr[ds]), qv);
                    const f32x4 k0 = *(const LAS f32x4*)(KMs + j * 64 + 16 * ds + 8 * hi), k1 = *(const LAS f32x4*)(KMs + j * 64 + 16 * ds + 8 * hi + 4);
                    s += (qv[0] * k0.x + qv[1] * k0.y) + (qv[2] * k0.z + qv[3] * k0.w) + (qv[4] * k1.x + qv[5] * k1.y) + (qv[6] * k1.z + qv[7] * k1.w); }
                s += __shfl_xor(s, 32); sc[j] = s; } }
        unsigned sel = 0u; const int nsel = qb < MOBA_TOPK ? qb : MOBA_TOPK;
#pragma unroll
        for (int k = 0; k < MOBA_TOPK; ++k) if (k < nsel) { float best = -3.0e38f; int bi = 0;
#pragma unroll
            for (int j = 0; j < 7; ++j) if (j < qb && !((sel >> j) & 1u) && sc[j] > best) { best = sc[j]; bi = j; }
            sel |= 1u << bi; }
        f32x16 o0 = {}, o1 = {}; float lsum = 0.f;
        const int qi = wave * 32 + r32;
        for (int tt = 0; tt < NT; ++tt) {
            const int cur = tt & 1;
            const unsigned long long ta0 = SEC_T();
            if (tt + 1 < NT) AT_LOAD(tt + 1);
            __builtin_amdgcn_sched_barrier(0);
            const int j = tt >> 2, tile = tt & 3; const bool own = (j == qb);
            if (!(own && tile * 64 > wave * 32 + 31)) {
                const LAS unsigned char* Kb = L + cur * KBS; const LAS unsigned char* Vb = L + VB0 + cur * VBS;
                f32x16 p0 = {}, p1 = {};
#pragma unroll
                for (int ds = 0; ds < 4; ++ds) {
                    const bf16x8v k0 = *(const LAS bf16x8v*)(Kb + r32 * KP + ds * 32 + hi * 16), k1 = *(const LAS bf16x8v*)(Kb + (32 + r32) * KP + ds * 32 + hi * 16);
                    p0 = __builtin_amdgcn_mfma_f32_32x32x16_bf16(k0, qr[ds], p0, 0, 0, 0); p1 = __builtin_amdgcn_mfma_f32_32x32x16_bf16(k1, qr[ds], p1, 0, 0, 0); }
                const bool selbit = ((sel >> j) & 1u) != 0u;
#pragma unroll
                for (int r = 0; r < 16; ++r) { const int kv0 = tile * 64 + crow(r, hi);
                    const bool v0 = own ? (kv0 <= qi) : selbit, v1 = own ? (kv0 + 32 <= qi) : selbit;
                    p0[r] = v0 ? __builtin_amdgcn_exp2f(p0[r] - REF) : 0.f; p1[r] = v1 ? __builtin_amdgcn_exp2f(p1[r] - REF) : 0.f; lsum += p0[r] + p1[r]; }
                v4u pf[4];
#pragma unroll
                for (int q = 0; q < 4; ++q) { pf[0][q] = pk2(p0[2 * q], p0[2 * q + 1]); pf[1][q] = pk2(p0[8 + 2 * q], p0[8 + 2 * q + 1]); pf[2][q] = pk2(p1[2 * q], p1[2 * q + 1]); pf[3][q] = pk2(p1[8 + 2 * q], p1[8 + 2 * q + 1]); }
#pragma unroll
                for (int ks = 0; ks < 4; ++ks) {
                    const bf16x8v pb = __builtin_bit_cast(bf16x8v, pf[ks]);
                    { const v2u a0 = *(const LAS v2u*)(Vb + r32 * VP + (16 * ks + 4 * hi) * 2), a1 = *(const LAS v2u*)(Vb + r32 * VP + (16 * ks + 8 + 4 * hi) * 2);
                      v4u av; av.x = a0.x; av.y = a0.y; av.z = a1.x; av.w = a1.y; o0 = __builtin_amdgcn_mfma_f32_32x32x16_bf16(__builtin_bit_cast(bf16x8v, av), pb, o0, 0, 0, 0); }
                    { const v2u a0 = *(const LAS v2u*)(Vb + (32 + r32) * VP + (16 * ks + 4 * hi) * 2), a1 = *(const LAS v2u*)(Vb + (32 + r32) * VP + (16 * ks + 8 + 4 * hi) * 2);
                      v4u av; av.x = a0.x; av.y = a0.y; av.z = a1.x; av.w = a1.y; o1 = __builtin_amdgcn_mfma_f32_32x32x16_bf16(__builtin_bit_cast(bf16x8v, av), pb, o1, 0, 0, 0); }
                }
            }
            SEC_ADD(11, ta0); const unsigned long long ta1 = SEC_T();
            if (tt + 1 < NT) AT_STORE(cur ^ 1);
            asm volatile("s_waitcnt lgkmcnt(0)" ::: "memory"); SEC_ADD(12, ta1); const unsigned long long ta2 = SEC_T();
            __syncthreads();
            SEC_ADD(13, ta2); SEC_ADD(15, ta0);
        }
#undef AT_LOAD
#undef AT_STORE
        const float l = lsum + __shfl_xor(lsum, 32), inv = 1.0f / l;
        bf16* op = WSP(A,bf16,WS_AO) + (size_t)(tq0 + qi) * D + h * 64 + 4 * hi;
#pragma unroll
        for (int g4 = 0; g4 < 4; ++g4) { v2u w0, w1; w0.x = pk2(o0[4 * g4] * inv, o0[4 * g4 + 1] * inv); w0.y = pk2(o0[4 * g4 + 2] * inv, o0[4 * g4 + 3] * inv);
            w1.x = pk2(o1[4 * g4] * inv, o1[4 * g4 + 1] * inv); w1.y = pk2(o1[4 * g4 + 2] * inv, o1[4 * g4 + 3] * inv);
            *(v2u*)(op + 8 * g4) = w0; *(v2u*)(op + 32 + 8 * g4) = w1; }
    }
    __syncthreads();
}

__device__ __forceinline__ void attn_mfma2(Frame& F, const Args& A) {
    const int tid = F.tid, lane = F.lane, wave = F.wave, r32 = lane & 31, hi = lane >> 5;
    constexpr int KP = 144, KBS = 9216, VB0 = 18432, VBS = 9216, KMOFF = 36864;
    LAS unsigned char* L = F.lds + RING_OFF;
    LAS float* KMs = (LAS float*)(L + KMOFF);
    const float qwm = wave_max(fabsf(IN_QNW(A)[lane])), kwm = wave_max(fabsf(IN_KNW(A)[lane]));
    const float REF = 8.0f * qwm * kwm * 1.4426950408889634f + 0.25f;
    const bf16* QN = WSP(A,bf16,WS_PROJ) + PQ; const bf16* KN = WSP(A,bf16,WS_PROJ) + PK; const bf16* VV = WSP(A,bf16,WS_PROJ) + PV;
    const int srow = tid >> 3, sch = tid & 7;
    const int wq = (wave < 4) ? wave : (wave ^ 2);
    f32x4 ta[4], tb[4];
#pragma unroll
    for (int i = 0; i < 4; ++i) { ta[i] = (f32x4){0.f, 0.f, 0.f, 0.f}; tb[i] = ta[i]; }
    LAS unsigned* tscr = (LAS unsigned*)(L + 40960 + wave * 4352);
    for (int slot = F.vcu; slot < 256; slot += F.G) {
    int gstep = 0; const int ibase = 2048 * BG_SSD + (slot * 8 + wave) * BG_ATT;
    const int bh = slot >> 1, sp = slot & 1, b = bh >> 4, h = bh & 15;
#define A2_QB(u_) ((sp == 0) ? ((u_) == 0 ? 0 : (u_) == 1 ? 7 : (u_) == 2 ? 1 : 6) : ((u_) == 0 ? 2 : (u_) == 1 ? 5 : (u_) == 2 ? 3 : 4))
    const bf16* kg = KN + (size_t)(b * SEQ + srow) * NPROJ + h * 64 + 8 * sch;
    const bf16* vg = VV + (size_t)(b * SEQ + srow) * NPROJ + h * 64 + 8 * sch;
    v4u kreg, vreg; bf16x8v qn[4]; float kmn[4] = {0.f, 0.f, 0.f, 0.f};
#define A2_LOAD(tt) do { kreg = *(const v4u*)(kg + (size_t)(tt) * 64 * NPROJ); vreg = *(const v4u*)(vg + (size_t)(tt) * 64 * NPROJ); } while (0)
#define A2_STORE(bufi) do { *(LAS v4u*)(L + (bufi) * KBS + srow * KP + sch * 16) = kreg; *(LAS v4u*)(L + VB0 + (bufi) * VBS + srow * KP + sch * 16) = vreg; } while (0)
#define A2_PRE(u_) do { const int qbn_ = A2_QB(u_); \
        if (tid < 448 && (tid >> 6) < qbn_) { const float* kq_ = WSP(A,float,WS_KM) + (((size_t)(b * NH + h) * NBLK + (tid >> 6)) * 4) * HD + (tid & 63); kmn[0] = kq_[0]; kmn[1] = kq_[HD]; kmn[2] = kq_[2 * HD]; kmn[3] = kq_[3 * HD]; } \
        A2_LOAD(0); \
        const bf16* qp_ = QN + (size_t)(b * SEQ + qbn_ * MBLK + wq * 32 + r32) * NPROJ + h * 64; \
        _Pragma("unroll") for (int ds_ = 0; ds_ < 4; ++ds_) qn[ds_] = *(const bf16x8v*)(qp_ + 16 * ds_ + 8 * hi); } while (0)
    A2_PRE(0);
    for (int ui = 0; ui < 4; ++ui) {
        const int qb = A2_QB(ui);
        const int tq0 = b * SEQ + qb * MBLK, NT = 4 * (qb + 1);
        if (tid < 448 && (tid >> 6) < qb) KMs[tid] = (kmn[0] + kmn[1]) + (kmn[2] + kmn[3]);
        A2_STORE(0); A2_LOAD(1);
        bf16x8v qr[4];
#pragma unroll
        for (int ds = 0; ds < 4; ++ds) qr[ds] = qn[ds];
        {
            float qf[4][8]; float ss = 0.f;
#pragma unroll
            for (int ds = 0; ds < 4; ++ds) { unpk8(__builtin_bit_cast(v4u, qr[ds]), qf[ds]);
#pragma unroll
                for (int i = 0; i < 8; ++i) ss += qf[ds][i] * qf[ds][i]; }
            ss += __shfl_xor(ss, 32);
            const float rs = QSCALE / sqrtf(ss * (1.f / 64.f) + NORM_EPS);
#pragma unroll
            for (int ds = 0; ds < 4; ++ds) { const f32x4 w0 = *(const f32x4*)(IN_QNW(A) + 16 * ds + 8 * hi), w1 = *(const f32x4*)(IN_QNW(A) + 16 * ds + 8 * hi + 4);
#pragma unroll
                for (int i = 0; i < 4; ++i) { qf[ds][i] *= rs * w0[i]; qf[ds][4 + i] *= rs * w1[i]; }
                qr[ds] = __builtin_bit_cast(bf16x8v, pack8(qf[ds])); }
        }
        __syncthreads();
        float sc[7];
#pragma unroll
        for (int j = 0; j < 7; ++j) { sc[j] = -3.0e38f;
            if (j < qb) { float s = 0.f;
#pragma unroll
                for (int ds = 0; ds < 4; ++ds) { float qv[8]; unpk8(__builtin_bit_cast(v4u, qr[ds]), qv);
                    const f32x4 k0 = *(const LAS f32x4*)(KMs + j * 64 + 16 * ds + 8 * hi), k1 = *(const LAS f32x4*)(KMs + j * 64 + 16 * ds + 8 * hi + 4);
                    s += (qv[0] * k0.x + qv[1] * k0.y) + (qv[2] * k0.z + qv[3] * k0.w) + (qv[4] * k1.x + qv[5] * k1.y) + (qv[6] * k1.z + qv[7] * k1.w); }
                s += __shfl_xor(s, 32); sc[j] = s; } }
        unsigned sel = 0u; const int nsel = qb < MOBA_TOPK ? qb : MOBA_TOPK;
#pragma unroll
        for (int k = 0; k < MOBA_TOPK; ++k) if (k < nsel) { float best = -3.0e38f; int bi = 0;
#pragma unroll
            for (int j = 0; j < 7; ++j) if (j < qb && !((sel >> j) & 1u) && sc[j] > best) { best = sc[j]; bi = j; }
            sel |= 1u << bi; }
        sel |= 1u << qb;
        f32x16 o0 = {}, o1 = {}; float lsum = 0.f;
        const int qi = wq * 32 + r32;
        const int trk = ((lane & 15) >> 2) * KP + (16 * ((lane >> 4) & 1) + 4 * (lane & 3)) * 2 + (4 * hi) * KP;
        for (int tt = 0; tt < NT; ++tt) {
            const int cur = tt & 1;
            const unsigned long long ta0 = SEC_T();
            __builtin_amdgcn_sched_barrier(0);
            const int j = tt >> 2, tile = tt & 3; const bool own = (j == qb);
            if (!(own && tile * 64 > wq * 32 + 31)) {
                const LAS unsigned char* Kb = L + cur * KBS; const LAS unsigned char* Vb = L + VB0 + cur * VBS;
                const float ci = ((sel >> j) & 1u) ? -REF : -3.0e38f;
                f32x16 p0, p1;
#pragma unroll
                for (int r = 0; r < 16; ++r) { p0[r] = ci; p1[r] = ci; }
#pragma unroll
                for (int ds = 0; ds < 4; ++ds) {
                    const bf16x8v k0 = *(const LAS bf16x8v*)(Kb + r32 * KP + ds * 32 + hi * 16), k1 = *(const LAS bf16x8v*)(Kb + (32 + r32) * KP + ds * 32 + hi * 16);
                    p0 = __builtin_amdgcn_mfma_f32_32x32x16_bf16(k0, qr[ds], p0, 0, 0, 0); p1 = __builtin_amdgcn_mfma_f32_32x32x16_bf16(k1, qr[ds], p1, 0, 0, 0); }
#pragma unroll
                for (int r = 0; r < 16; ++r) { p0[r] = __builtin_amdgcn_exp2f(p0[r]); p1[r] = __builtin_amdgcn_exp2f(p1[r]); }
                if (own && tile * 64 + 63 > wq * 32) {
#pragma unroll
                    for (int r = 0; r < 16; ++r) { const int kv0 = tile * 64 + crow(r, hi); p0[r] = (kv0 <= qi) ? p0[r] : 0.f; p1[r] = (kv0 + 32 <= qi) ? p1[r] : 0.f; }
                }
#pragma unroll
                for (int r = 0; r < 16; ++r) lsum += p0[r] + p1[r];
                v4u pf[4];
#pragma unroll
                for (int q = 0; q < 4; ++q) { pf[0][q] = pk2(p0[2 * q], p0[2 * q + 1]); pf[1][q] = pk2(p0[8 + 2 * q], p0[8 + 2 * q + 1]); pf[2][q] = pk2(p1[2 * q], p1[2 * q + 1]); pf[3][q] = pk2(p1[8 + 2 * q], p1[8 + 2 * q + 1]); }
#pragma unroll
                for (int ks = 0; ks < 4; ++ks) {
                    const bf16x8v pb = __builtin_bit_cast(bf16x8v, pf[ks]);
                    const LAS unsigned char* vp = Vb + trk + (16 * ks) * KP;
                    { const v2u a0 = ldtr(vp), a1 = ldtr(vp + 8 * KP); v4u av; av.x = a0.x; av.y = a0.y; av.z = a1.x; av.w = a1.y; o0 = __builtin_amdgcn_mfma_f32_32x32x16_bf16(__builtin_bit_cast(bf16x8v, av), pb, o0, 0, 0, 0); }
                    { const v2u a0 = ldtr(vp + 64), a1 = ldtr(vp + 8 * KP + 64); v4u av; av.x = a0.x; av.y = a0.y; av.z = a1.x; av.w = a1.y; o1 = __builtin_amdgcn_mfma_f32_32x32x16_bf16(__builtin_bit_cast(bf16x8v, av), pb, o1, 0, 0, 0); }
                }
            }
            SEC_ADD(41, ta0); const unsigned long long ta1 = SEC_T();
            if (tt + 1 < NT) A2_STORE(cur ^ 1);
            if (tt + 2 < NT) A2_LOAD(tt + 2);
            else if (tt + 2 == NT && ui < 3) A2_PRE(ui + 1);
            if (BG_MOE_CONVERT) { const int jq = gstep / BG_APER, jr = gstep - BG_APER * jq;
                if (jr == BG_APER - 2 && jq < BG_ATT) tr_finish(moe_item(A, ibase + jq), lane, ta, tb, tscr);
                if (jr == 0 && jq < BG_ATT) tr_issue(moe_item(A, ibase + jq), lane, ta, tb);
                ++gstep; }
            asm volatile("s_waitcnt lgkmcnt(0)" ::: "memory"); SEC_ADD(42, ta1); const unsigned long long ta2 = SEC_T();
            __syncthreads();
            SEC_ADD(43, ta2); SEC_ADD(45, ta0);
        }
        const float l = lsum + __shfl_xor(lsum, 32), inv = 1.0f / l;
        bf16* op = WSP(A,bf16,WS_AO) + (size_t)(tq0 + qi) * D + h * 64 + 4 * hi;
#pragma unroll
        for (int g4 = 0; g4 < 4; ++g4) { v2u w0, w1; w0.x = pk2(o0[4 * g4] * inv, o0[4 * g4 + 1] * inv); w0.y = pk2(o0[4 * g4 + 2] * inv, o0[4 * g4 + 3] * inv);
            w1.x = pk2(o1[4 * g4] * inv, o1[4 * g4 + 1] * inv); w1.y = pk2(o1[4 * g4 + 2] * inv, o1[4 * g4 + 3] * inv);
            *(v2u*)(op + 8 * g4) = w0; *(v2u*)(op + 32 + 8 * g4) = w1; }
    }
#undef A2_LOAD
#undef A2_STORE
#undef A2_PRE
#undef A2_QB
    }
    __syncthreads();
}

__device__ __forceinline__ void p7_route(Frame& F, const Args& A) {
    stage_wt(F, WSP(A,float,WS_WRT));
    const LAS float* WT = (const LAS float*)(F.lds + RING_OFF);
    const int lane = F.lane, gw = F.vcu * NWAVES + F.wave, NGW = F.G * NWAVES;
    for (int t = gw; t < M; t += NGW) {
        const f32x4* xr = (const f32x4*)((A).out + (size_t)t * D) + lane; const f32x4* wr = (const f32x4*)IN_LN2W(A) + lane;
        f32x4 v[4]; float s = 0.f;
#pragma unroll
        for (int j = 0; j < 4; ++j) { v[j] = xr[64 * j]; s += (v[j].x * v[j].x + v[j].y * v[j].y) + (v[j].z * v[j].z + v[j].w * v[j].w); }
        const float rs = 1.0f / sqrtf(wave_sum(s) * (1.f / D) + NORM_EPS);
        float h[16]; v2u* o8 = (v2u*)(WSP(A,bf16,WS_H2) + (size_t)t * D) + lane;
#pragma unroll
        for (int j = 0; j < 4; ++j) { const f32x4 w = wr[64 * j]; h[4 * j] = v[j].x * rs * w.x; h[4 * j + 1] = v[j].y * rs * w.y; h[4 * j + 2] = v[j].z * rs * w.z; h[4 * j + 3] = v[j].w * rs * w.w;
            v2u o; o.x = pk2(h[4 * j], h[4 * j + 1]); o.y = pk2(h[4 * j + 2], h[4 * j + 3]); o8[64 * j] = o; }
        float val = rowdot32(h, WT, lane); val = (lane < 32) ? val + IN_BR(A)[lane & 31] : -3.0e38f;
        float tv[4]; int ti[4];
#pragma unroll
        for (int k = 0; k < 4; ++k) { const float mx = wave_max(val); const unsigned long long bm = __ballot(val == mx); const int idx = __builtin_ctzll(bm);
            tv[k] = mx; ti[k] = idx; if (lane == idx) val = -3.0e38f; }
        float ex[4], es = 0.f;
#pragma unroll
        for (int k = 0; k < 4; ++k) { ex[k] = __expf(tv[k] - tv[0]); es += ex[k]; }
        if (lane == 0) {
#pragma unroll
            for (int k = 0; k < 4; ++k) { const unsigned j = __hip_atomic_fetch_add((WSP(A,unsigned,WS_CTL) + CW_CNT) + ti[k], 1u, RLX_AGENT); WSP(A,int,WS_TOKL)[ti[k] * EXPCAP + (int)j] = t * 4 + k; WSP(A,float,WS_GATEW)[t * 4 + k] = ex[k] / es; }
        }
    }
    __syncthreads();
}

__device__ __forceinline__ int moe_tables(Frame& F, const Args& A, bool reuse = false) {
    LAS int* tile_e = (LAS int*)(F.lds + TILEE_OFF); LAS int* rowb = (LAS int*)(F.lds + ROWB_OFF); LAS int* cntl = (LAS int*)(F.lds + CNTL_OFF);
    if (reuse) return rowb[NEXP] >> 8;
    if (F.tid < NEXP) { int c = (int)__hip_atomic_load((WSP(A,unsigned,WS_CTL) + CW_CNT) + F.tid, RLX_AGENT); cntl[F.tid] = c > EXPCAP ? EXPCAP : c; }
    __syncthreads();
    if (F.tid == 0) { int acc = 0; for (int x = 0; x < NEXP; ++x) { rowb[x] = acc; acc += ((cntl[x] + 255) >> 8) * 256; } rowb[NEXP] = acc; }
    __syncthreads();
    const int NT = rowb[NEXP] >> 8;
    if (F.tid < NT) { int x = 0;
#pragma unroll
        for (int q = 1; q < NEXP; ++q) x += (rowb[q] <= F.tid * 256) ? 1 : 0;
        tile_e[F.tid] = x; }
    __syncthreads();
    return NT;
}
__device__ __forceinline__ void p8_gather(Frame& F, const Args& A) {
    const int NT = moe_tables(F, A);
    const LAS int* rowb = (const LAS int*)(F.lds + ROWB_OFF); const LAS int* cntl = (const LAS int*)(F.lds + CNTL_OFF);
    const int lane = F.lane, gw = F.vcu * NWAVES + F.wave, NGW = F.G * NWAVES, total = NT * 256;
    for (int r = gw; r < total; r += NGW) {
        int e = 0;
#pragma unroll
        for (int q = 1; q < NEXP; ++q) e += (rowb[q] <= r) ? 1 : 0;
        const int j = r - rowb[e];
        if (j < cntl[e]) { const int a = WSP(A,int,WS_TOKL)[e * EXPCAP + j], t = a >> 2;
            const v4u x0 = *(const v4u*)(WSP(A,bf16,WS_H2) + (size_t)t * D + 16 * lane), x1 = *(const v4u*)(WSP(A,bf16,WS_H2) + (size_t)t * D + 16 * lane + 8);
            *(v4u*)(WSP(A,bf16,WS_XG) + (size_t)r * D + 16 * lane) = x0; *(v4u*)(WSP(A,bf16,WS_XG) + (size_t)r * D + 16 * lane + 8) = x1;
            if (lane == 0) { WSP(A,float,WS_ROWW)[r] = WSP(A,float,WS_GATEW)[a]; WSP(A,int,WS_POS)[a] = r; } }
        else if (lane == 0) WSP(A,float,WS_ROWW)[r] = 0.f;
    }
    __syncthreads();
}
__device__ __forceinline__ void p11_combine(Frame& F, const Args& A) {
    const int lane = F.lane, gw = F.vcu * NWAVES + F.wave, NGW = F.G * NWAVES;
    for (int t = gw; t < M; t += NGW) {
        f32x4* xr = (f32x4*)((A).out + (size_t)t * D) + lane; f32x4 v[4];
#pragma unroll
        for (int j = 0; j < 4; ++j) v[j] = xr[64 * j];
#pragma unroll
        for (int k = 0; k < 4; ++k) { const int r = WSP(A,int,WS_POS)[t * 4 + k]; const v2u* yr = (const v2u*)(WSP(A,bf16,WS_Y) + (size_t)r * D) + lane;
#pragma unroll
            for (int j = 0; j < 4; ++j) { const v2u w = yr[64 * j]; v[j].x += __uint_as_float(w.x << 16); v[j].y += __uint_as_float(w.x & 0xffff0000u); v[j].z += __uint_as_float(w.y << 16); v[j].w += __uint_as_float(w.y & 0xffff0000u); } }
#pragma unroll
        for (int j = 0; j < 4; ++j) xr[64 * j] = v[j];
    }
}

template <bool XLO, bool WLO>
__device__ __forceinline__ void tile_dot32(Frame& F, const bf16* Xhi, const bf16* Xlo, int ldx, const bf16* Whi, const bf16* Wlo, LAS float* PART, LAS float* LOG) {
    constexpr int CP = 528, O_XH = 0, O_XL = O_XH + 64 * CP, O_WH = O_XL + 64 * CP, O_WL = O_WH + 32 * CP;
    static_assert(O_WL + 32 * CP <= 131072, "tile_dot32 images");
    LAS unsigned char* L = F.lds + RING_OFF;
    const int tid = F.tid, lane = F.lane, wave = F.wave, r32 = lane & 31, hi = lane >> 5, tile = wave >> 2, kq = wave & 3;
    const int xr0 = tid >> 5, xc = tid & 31;
    v4u xha[4], xla[4], wha[2], wla[2], xhb[4], xlb[4], whb[2], wlb[2];
#define TD_LOAD(S, c) do { _Pragma("unroll") for (int i_ = 0; i_ < 4; ++i_) { const size_t o_ = (size_t)(xr0 + 16 * i_) * ldx + (c) * 256 + 8 * xc; xh##S[i_] = *(const v4u*)(Xhi + o_); if (XLO) xl##S[i_] = *(const v4u*)(Xlo + o_); } \
        _Pragma("unroll") for (int i_ = 0; i_ < 2; ++i_) { const int ow_ = (xr0 + 16 * i_) * 1024 + (c) * 256 + 8 * xc; wh##S[i_] = *(const v4u*)(Whi + ow_); if (WLO) wl##S[i_] = *(const v4u*)(Wlo + ow_); } } while (0)
#define TD_STORE(S) do { _Pragma("unroll") for (int i_ = 0; i_ < 4; ++i_) { *(LAS v4u*)(L + O_XH + (xr0 + 16 * i_) * CP + xc * 16) = xh##S[i_]; if (XLO) *(LAS v4u*)(L + O_XL + (xr0 + 16 * i_) * CP + xc * 16) = xl##S[i_]; } \
        _Pragma("unroll") for (int i_ = 0; i_ < 2; ++i_) { *(LAS v4u*)(L + O_WH + (xr0 + 16 * i_) * CP + xc * 16) = wh##S[i_]; if (WLO) *(LAS v4u*)(L + O_WL + (xr0 + 16 * i_) * CP + xc * 16) = wl##S[i_]; } } while (0)
#define TD_MMA() do { _Pragma("unroll") for (int ks = 0; ks < 4; ++ks) { const int ko = (kq * 64 + ks * 16 + 8 * hi) * 2; \
            const bf16x8v a = *(const LAS bf16x8v*)(L + O_XH + (tile * 32 + r32) * CP + ko), b = *(const LAS bf16x8v*)(L + O_WH + r32 * CP + ko); \
            acc = __builtin_amdgcn_mfma_f32_32x32x16_bf16(a, b, acc, 0, 0, 0); \
            if (WLO) { const bf16x8v bl = *(const LAS bf16x8v*)(L + O_WL + r32 * CP + ko); acc = __builtin_amdgcn_mfma_f32_32x32x16_bf16(a, bl, acc, 0, 0, 0); } \
            if (XLO) { const bf16x8v al = *(const LAS bf16x8v*)(L + O_XL + (tile * 32 + r32) * CP + ko); acc = __builtin_amdgcn_mfma_f32_32x32x16_bf16(al, b, acc, 0, 0, 0); } } } while (0)
    f32x16 acc = {};
    TD_LOAD(a, 0); TD_LOAD(b, 1);
    TD_STORE(a); __syncthreads();
    TD_LOAD(a, 2); __builtin_amdgcn_sched_barrier(0); TD_MMA(); __syncthreads(); TD_STORE(b); __syncthreads();
    TD_LOAD(b, 3); __builtin_amdgcn_sched_barrier(0); TD_MMA(); __syncthreads(); TD_STORE(a); __syncthreads();
    TD_MMA(); __syncthreads(); TD_STORE(b); __syncthreads();
    TD_MMA(); __syncthreads();
#undef TD_LOAD
#undef TD_STORE
#undef TD_MMA
#pragma unroll
    for (int r = 0; r < 16; ++r) PART[(wave * 32 + crow(r, hi)) * 33 + r32] = acc[r];
    __syncthreads();
#pragma unroll
    for (int q = 0; q < 4; ++q) { const int idx = F.tid + 512 * q, tok = idx >> 5, e = idx & 31; const LAS float* pp = PART + ((tok >> 5) * 4 * 32 + (tok & 31)) * 33 + e;
        LOG[tok * 33 + e] = (pp[0] + pp[32 * 33]) + (pp[2 * 32 * 33] + pp[3 * 32 * 33]); }
    __syncthreads();
}

__device__ __forceinline__ void p0_tail(Frame& F, const Args& A) {
    const int lane = F.lane, gw = F.vcu * NWAVES + F.wave, NGW = F.G * NWAVES;
    { const int gt = F.vcu * 512 + F.tid, NGT = F.G * 512;
      for (int i = gt; i < 32 * 1024; i += NGT) { const int e = i >> 10, k = i & 1023; const float wd = IN_WIN(A)[(size_t)k * N_IN + COL_DT + e], wr = IN_WR(A)[k * 32 + e];
          const unsigned dh = f2bf(wd), rh = f2bf(wr);
          WSP(A,bf16,WS_WDH)[i] = (bf16)dh; WSP(A,bf16,WS_WDL)[i] = (bf16)f2bf(wd - __uint_as_float(dh << 16)); WSP(A,bf16,WS_WRH)[i] = (bf16)rh; WSP(A,bf16,WS_WRL)[i] = (bf16)f2bf(wr - __uint_as_float(rh << 16)); } }
    f32x4 w[4];
#pragma unroll
    for (int j = 0; j < 4; ++j) w[j] = ((const f32x4*)IN_LN1W(A))[lane + 64 * j];
    for (int m0 = gw * 4; m0 < M; m0 += NGW * 4) {
        f32x4 v[4][4];
#pragma unroll
        for (int i = 0; i < 4; ++i)
#pragma unroll
            for (int j = 0; j < 4; ++j) v[i][j] = ((const f32x4*)(IN_X(A) + (size_t)(m0 + i) * D))[lane + 64 * j];
#pragma unroll
        for (int i = 0; i < 4; ++i) { float s = 0.f;
#pragma unroll
            for (int j = 0; j < 4; ++j) s += (v[i][j].x * v[i][j].x + v[i][j].y * v[i][j].y) + (v[i][j].z * v[i][j].z + v[i][j].w * v[i][j].w);
            const float rs = 1.0f / sqrtf(wave_sum(s) * (1.f / D) + NORM_EPS);
            v2u* o8 = (v2u*)(WSP(A,bf16,WS_XN) + (size_t)(m0 + i) * D) + lane;
#pragma unroll
            for (int j = 0; j < 4; ++j) { v2u o; o.x = pk2(v[i][j].x * rs * w[j].x, v[i][j].y * rs * w[j].y); o.y = pk2(v[i][j].z * rs * w[j].z, v[i][j].w * rs * w[j].w); o8[64 * j] = o; } }
    }
}

__device__ __forceinline__ void p2_prep2(Frame& F, const Args& A) {
    LAS float* PART = (LAS float*)(F.lds + RING_OFF); LAS float* LOG = (LAS float*)(F.lds + RING_OFF + 33792);
    const int lane = F.lane, wave = F.wave, tid = F.tid;
    float qw[16], kw[16];
#pragma unroll
    for (int q = 0; q < 4; ++q) { const f32x4 a = *(const f32x4*)(IN_QNW(A) + 16 * (lane & 3) + 4 * q), b = *(const f32x4*)(IN_KNW(A) + 16 * (lane & 3) + 4 * q);
#pragma unroll
        for (int i = 0; i < 4; ++i) { qw[4 * q + i] = a[i] * QSCALE; kw[4 * q + i] = b[i]; } }
    for (int blk = F.vcu; blk < M / 64; blk += F.G) {
        const unsigned long long tp0 = SEC_T();
        tile_dot32<false, true>(F, WSP(A,bf16,WS_XN) + (size_t)blk * 64 * D, nullptr, D, WSP(A,bf16,WS_WDH), WSP(A,bf16,WS_WDL), PART, LOG);
#pragma unroll
        for (int q = 0; q < 4; ++q) { const int idx = tid + 512 * q, tok = idx >> 5, e = idx & 31; const float z = LOG[tok * 33 + e] + IN_DTB(A)[e];
            WSP(A,float,WS_DT)[(size_t)(blk * 64 + tok) * 32 + e] = fmaxf(z, 0.f) + log1pf(__expf(-fabsf(z))); }
        SEC_ADD(21, tp0); const unsigned long long tp1 = SEC_T();
        const int t0 = blk * 64 + wave * 8, b = t0 / SEQ, mb = (t0 % SEQ) / MBLK, pos0 = t0 % SEQ;
        float km[16];
#pragma unroll
        for (int i = 0; i < 16; ++i) km[i] = 0.f;
#pragma unroll 1
        for (int bt = 0; bt < 2; ++bt) {
            v4u ka[4][2];
#pragma unroll
            for (int i = 0; i < 4; ++i) { bf16* prow = WSP(A,bf16,WS_PROJ) + (size_t)(t0 + 4 * bt + i) * NPROJ + 16 * lane;
                ka[i][0] = *(const v4u*)(prow + PK); ka[i][1] = *(const v4u*)(prow + PK + 8); }
#pragma unroll
            for (int i = 0; i < 4; ++i) { bf16* prow = WSP(A,bf16,WS_PROJ) + (size_t)(t0 + 4 * bt + i) * NPROJ + 16 * lane;
                { float lo[8], hi[8]; unpk8(ka[i][0], lo); unpk8(ka[i][1], hi); float ss = 0.f;
#pragma unroll
                  for (int c = 0; c < 8; ++c) ss += lo[c] * lo[c] + hi[c] * hi[c];
                  ss += __shfl_xor(ss, 1); ss += __shfl_xor(ss, 2); const float rs = 1.0f / sqrtf(ss * (1.f / 64.f) + NORM_EPS);
#pragma unroll
                  for (int c = 0; c < 8; ++c) { lo[c] = lo[c] * rs * kw[c]; hi[c] = hi[c] * rs * kw[8 + c]; km[c] += lo[c]; km[8 + c] += hi[c]; }
                  *(v4u*)(prow + PK) = pack8(lo); *(v4u*)(prow + PK + 8) = pack8(hi); } }
        }
        SEC_ADD(22, tp1); const unsigned long long tp2 = SEC_T();
        {
#pragma unroll
            for (int q = 0; q < 4; ++q) *(LAS f32x4*)(PART + wave * 1024 + 16 * lane + 4 * q) = (f32x4){km[4 * q], km[4 * q + 1], km[4 * q + 2], km[4 * q + 3]};
            __syncthreads();
#pragma unroll
            for (int q = 0; q < 2; ++q) { const int idx = tid + 512 * q; float s = 0.f;
#pragma unroll
                for (int w = 0; w < 8; ++w) s += PART[w * 1024 + idx];
                WSP(A,float,WS_KM)[(((size_t)(b * NH + (idx >> 6)) * NBLK + mb) * 4 + ((blk & 3))) * HD + (idx & 63)] = s * (1.f / MBLK); }
        }
        SEC_ADD(23, tp2); const unsigned long long tp3 = SEC_T();
#pragma unroll 1
        for (int g6 = 0; g6 < 6; ++g6) {
            const int c0 = g6 * 512 + 8 * lane;
            v4u rw[11];
#pragma unroll
            for (int i = 0; i < 11; ++i) { rw[i] = (v4u){0u, 0u, 0u, 0u}; if (pos0 - 3 + i >= 0) rw[i] = *(const v4u*)(WSP(A,bf16,WS_PROJ) + (size_t)(t0 - 3 + i) * NPROJ + PXBC + c0); }
            float wv[4][8], bv[8];
#pragma unroll
            for (int j = 0; j < 4; ++j) { const f32x4 w0 = *(const f32x4*)(IN_CONVW(A) + j * D_XBC + c0), w1 = *(const f32x4*)(IN_CONVW(A) + j * D_XBC + c0 + 4);
#pragma unroll
                for (int c = 0; c < 4; ++c) { wv[j][c] = w0[c]; wv[j][4 + c] = w1[c]; } }
            { const f32x4 b0 = *(const f32x4*)(IN_CONVB(A) + c0), b1 = *(const f32x4*)(IN_CONVB(A) + c0 + 4);
#pragma unroll
              for (int c = 0; c < 4; ++c) { bv[c] = b0[c]; bv[4 + c] = b1[c]; } }
            float acc[8][8];
#pragma unroll
            for (int o = 0; o < 8; ++o)
#pragma unroll
                for (int c = 0; c < 8; ++c) acc[o][c] = bv[c];
#pragma unroll
            for (int i = 0; i < 11; ++i) { float xv[8]; unpk8(rw[i], xv);
#pragma unroll
                for (int j = 0; j < 4; ++j) { const int o = i - j; if (o >= 0 && o < 8) {
#pragma unroll
                    for (int c = 0; c < 8; ++c) acc[o][c] += wv[j][c] * xv[c]; } } }
#pragma unroll
            for (int o = 0; o < 8; ++o) {
#pragma unroll
                for (int c = 0; c < 8; ++c) acc[o][c] = silu_f(acc[o][c]);
                *(v4u*)(WSP(A,bf16,WS_XC) + (size_t)(t0 + o) * D_XBC + c0) = pack8(acc[o]); }
        }
        SEC_ADD(24, tp3);
        __syncthreads();
        SEC_ADD(25, tp0);
    }
}

__device__ __forceinline__ void p4_norm2(Frame& F, const Args& A) {
    const unsigned long long tn0 = SEC_T();
    const int lane = F.lane, gw = F.vcu * NWAVES + F.wave, NGW = F.G * NWAVES;
    f32x4 nw[8];
#pragma unroll
    for (int q = 0; q < 8; ++q) nw[q] = *(const f32x4*)(IN_SSDNW(A) + 32 * lane + 4 * q);
    for (int t0 = gw * 4; t0 < M; t0 += NGW * 4) {
        float sq[4]; v4u rv[4][4];
#pragma unroll
        for (int i = 0; i < 4; ++i) { sq[i] = WSP(A,float,WS_SSQ)[(size_t)(t0 + i) * 32 + 8 * (lane >> 4) + (lane & 7)];
#pragma unroll
            for (int q = 0; q < 4; ++q) rv[i][q] = *(const v4u*)(WSP(A,bf16,WS_YG) + (size_t)(t0 + i) * D_INNER + 32 * lane + 8 * q); }
#pragma unroll
        for (int i = 0; i < 4; ++i) { float ss = sq[i]; ss += __shfl_xor(ss, 1); ss += __shfl_xor(ss, 2); ss += __shfl_xor(ss, 4);
            const float rs = 1.0f / sqrtf(ss * (1.f / 512.f) + NORM_EPS);
#pragma unroll
            for (int q = 0; q < 4; ++q) { float v[8]; unpk8(rv[i][q], v);
#pragma unroll
                for (int c = 0; c < 4; ++c) { v[c] = v[c] * rs * nw[2 * q][c]; v[4 + c] = v[4 + c] * rs * nw[2 * q + 1][c]; }
                *(v4u*)(WSP(A,bf16,WS_YG) + (size_t)(t0 + i) * D_INNER + 32 * lane + 8 * q) = pack8(v); } }
    }
}

__device__ __forceinline__ void p7_route2(Frame& F, const Args& A) {
    LAS float* PART = (LAS float*)(F.lds + RING_OFF); LAS float* LOG = (LAS float*)(F.lds + RING_OFF + 33792);
    const int lane = F.lane, wave = F.wave;
    f32x4 w[4];
#pragma unroll
    for (int j = 0; j < 4; ++j) w[j] = ((const f32x4*)IN_LN2W(A))[lane + 64 * j];
    const float brl = IN_BR(A)[lane & 31];
    LAS unsigned* lcnt = (LAS unsigned*)(F.lds + LCNT_OFF); LAS unsigned* lbase = (LAS unsigned*)(F.lds + LBASE_OFF);
    for (int blk = F.vcu; blk < M / 64; blk += F.G) {
        const int t0 = blk * 64 + wave * 8;
        if (F.tid < 32) lcnt[F.tid] = 0u;
        const unsigned long long tr0 = SEC_T();
        {
            constexpr int CP = 528, O_XH = 0, O_XL = O_XH + 64 * CP, O_WH = O_XL + 64 * CP, O_WL = O_WH + 32 * CP;
            LAS unsigned char* L = F.lds + RING_OFF;
            const int r32 = lane & 31, hi = lane >> 5, tile = wave >> 2, kq = wave & 3, xr0 = F.tid >> 4, xc = F.tid & 15;
            const bf16* wph = WSP(A,bf16,WS_WRH) + xr0 * 1024 + 8 * xc; const bf16* wpl = WSP(A,bf16,WS_WRL) + xr0 * 1024 + 8 * xc;
            v4u wha[2], wla[2];
#define RT_WLOAD(S, c) do { _Pragma("unroll") for (int i_ = 0; i_ < 2; ++i_) { wh##S[i_] = *(const v4u*)(wph + (c) * 256 + 128 * i_); wl##S[i_] = *(const v4u*)(wpl + (c) * 256 + 128 * i_); } } while (0)
#define RT_WSTORE(S) do { _Pragma("unroll") for (int i_ = 0; i_ < 2; ++i_) { *(LAS v4u*)(L + O_WH + xr0 * CP + (xc + 16 * i_) * 16) = wh##S[i_]; *(LAS v4u*)(L + O_WL + xr0 * CP + (xc + 16 * i_) * 16) = wl##S[i_]; } } while (0)
#define RT_XSTORE(c) do { _Pragma("unroll") for (int i_ = 0; i_ < 8; ++i_) { const f32x4 x_ = v[i_][c]; const float q_ = rsv[i_]; \
                float h_[4] = {x_.x * q_ * w[c].x, x_.y * q_ * w[c].y, x_.z * q_ * w[c].z, x_.w * q_ * w[c].w}; unsigned hb_[4], lb_[4]; \
                _Pragma("unroll") for (int e_ = 0; e_ < 4; ++e_) { hb_[e_] = f2bf(h_[e_]); lb_[e_] = f2bf(h_[e_] - __uint_as_float(hb_[e_] << 16)); } \
                v2u o_; o_.x = hb_[0] | (hb_[1] << 16); o_.y = hb_[2] | (hb_[3] << 16); *(LAS v2u*)(L + O_XH + (8 * wave + i_) * CP + lane * 8) = o_; \
                o_.x = lb_[0] | (lb_[1] << 16); o_.y = lb_[2] | (lb_[3] << 16); *(LAS v2u*)(L + O_XL + (8 * wave + i_) * CP + lane * 8) = o_; \
                ((unsigned*)(WSP(A,unsigned char,WS_H2F8) + (size_t)(t0 + i_) * D))[lane + 64 * (c)] = pg8::cvt4_fp8(pg8::f8_sat(h_[0] * pg8::F8_SCALE_H), pg8::f8_sat(h_[1] * pg8::F8_SCALE_H), pg8::f8_sat(h_[2] * pg8::F8_SCALE_H), pg8::f8_sat(h_[3] * pg8::F8_SCALE_H)); } } while (0)
#define RT_MMA() do { _Pragma("unroll") for (int ks = 0; ks < 4; ++ks) { const int ko = (kq * 64 + ks * 16 + 8 * hi) * 2; \
                const bf16x8v a_ = *(const LAS bf16x8v*)(L + O_XH + (tile * 32 + r32) * CP + ko), b_ = *(const LAS bf16x8v*)(L + O_WH + r32 * CP + ko); \
                const bf16x8v bl_ = *(const LAS bf16x8v*)(L + O_WL + r32 * CP + ko), al_ = *(const LAS bf16x8v*)(L + O_XL + (tile * 32 + r32) * CP + ko); \
                acc = __builtin_amdgcn_mfma_f32_32x32x16_bf16(a_, b_, acc, 0, 0, 0); acc = __builtin_amdgcn_mfma_f32_32x32x16_bf16(a_, bl_, acc, 0, 0, 0); acc = __builtin_amdgcn_mfma_f32_32x32x16_bf16(al_, b_, acc, 0, 0, 0); } } while (0)
            RT_WLOAD(a, 0);
            f32x4 v[8][4];
#pragma unroll
            for (int i = 0; i < 8; ++i)
#pragma unroll
                for (int j = 0; j < 4; ++j) v[i][j] = ((const f32x4*)((A).out + (size_t)(t0 + i) * D))[lane + 64 * j];
            float rsv[8];
#pragma unroll
            for (int i = 0; i < 8; ++i) { float s = 0.f;
#pragma unroll
                for (int j = 0; j < 4; ++j) s += (v[i][j].x * v[i][j].x + v[i][j].y * v[i][j].y) + (v[i][j].z * v[i][j].z + v[i][j].w * v[i][j].w);
                rsv[i] = 1.0f / sqrtf(wave_sum(s) * (1.f / D) + NORM_EPS); }
            f32x16 acc = {};
            RT_XSTORE(0); RT_WSTORE(a); RT_WLOAD(a, 1); __syncthreads(); RT_MMA(); __syncthreads();
            RT_XSTORE(1); RT_WSTORE(a); RT_WLOAD(a, 2); __syncthreads(); RT_MMA(); __syncthreads();
            RT_XSTORE(2); RT_WSTORE(a); RT_WLOAD(a, 3); __syncthreads(); RT_MMA(); __syncthreads();
            RT_XSTORE(3); RT_WSTORE(a); __syncthreads(); RT_MMA(); __syncthreads();
#undef RT_WLOAD
#undef RT_WSTORE
#undef RT_XSTORE
#undef RT_MMA
#pragma unroll
            for (int r = 0; r < 16; ++r) PART[(wave * 32 + crow(r, hi)) * 33 + r32] = acc[r];
            __syncthreads();
#pragma unroll
            for (int q = 0; q < 4; ++q) { const int idx = F.tid + 512 * q, tok = idx >> 5, e = idx & 31; const LAS float* pp = PART + ((tok >> 5) * 4 * 32 + (tok & 31)) * 33 + e;
                LOG[tok * 33 + e] = (pp[0] + pp[32 * 33]) + (pp[2 * 32 * 33] + pp[3 * 32 * 33]); }
            __syncthreads();
        }
        SEC_ADD(31, tr0); const unsigned long long tr1 = SEC_T();
        SEC_ADD(32, tr1); const unsigned long long tr2 = SEC_T();
        int my_e = 0, my_a = 0; float my_g = 0.f;
#pragma unroll
        for (int i = 0; i < 8; ++i) { const int tok = 8 * wave + i;
            float val = (lane < 32) ? LOG[tok * 33 + (lane & 31)] + brl : -3.0e38f;
            float tv[4]; int ti[4];
#pragma unroll
            for (int k = 0; k < 4; ++k) { const float mx = wave_max(val); const unsigned long long bm = __ballot(val == mx); const int idx = __builtin_ctzll(bm);
                tv[k] = mx; ti[k] = idx; if (lane == idx) val = -3.0e38f; }
            float ex[4], es = 0.f;
#pragma unroll
            for (int k = 0; k < 4; ++k) { ex[k] = __expf(tv[k] - tv[0]); es += ex[k]; }
            const float ies = 1.0f / es;
#pragma unroll
            for (int k = 0; k < 4; ++k) if (lane == 4 * i + k) { my_e = ti[k]; my_g = ex[k] * ies; my_a = (blk * 64 + tok) * 4 + k; } }
        SEC_ADD(33, tr2); const unsigned long long tr3 = SEC_T();
        unsigned lrank = 0u;
        if (lane < 32) lrank = __hip_atomic_fetch_add(lcnt + my_e, 1u, __ATOMIC_RELAXED, __HIP_MEMORY_SCOPE_WORKGROUP);
        __syncthreads();
        if (F.tid < 32) lbase[F.tid] = __hip_atomic_fetch_add((WSP(A,unsigned,WS_CTL) + CW_CNT) + F.tid, lcnt[F.tid], RLX_AGENT);
        __syncthreads();
        if (lane < 32) { const int j = (int)(lbase[my_e] + lrank); WSP(A,int,WS_TOKL)[my_e * EXPCAP + j] = my_a; WSP(A,float,WS_GATEW)[my_e * EXPCAP + j] = my_g; WSP(A,int,WS_POS)[my_a] = my_e * EXPCAP + j; }
        __syncthreads();
        SEC_ADD(34, tr3); SEC_ADD(35, tr0);
    }
}

__device__ __forceinline__ void p8_gather2(Frame& F, const Args& A) {
    const int NT = moe_tables(F, A);
    const LAS int* rowb = (const LAS int*)(F.lds + ROWB_OFF); const LAS int* cntl = (const LAS int*)(F.lds + CNTL_OFF);
    const int lane = F.lane, gw = F.vcu * NWAVES + F.wave, NGW = F.G * NWAVES, total = NT * 256;
    for (int r0 = gw * 4; r0 < total; r0 += NGW * 4) {
        int aa[4]; bool ok[4];
#pragma unroll
        for (int i = 0; i < 4; ++i) { const int r = r0 + i; int e = 0;
#pragma unroll
            for (int q = 1; q < NEXP; ++q) e += (rowb[q] <= r) ? 1 : 0;
            const int j = r - rowb[e]; ok[i] = j < cntl[e]; aa[i] = ok[i] ? WSP(A,int,WS_TOKL)[e * EXPCAP + j] : 0; }
        v4u x0[4], x1[4]; float gv[4];
#pragma unroll
        for (int i = 0; i < 4; ++i) { const bf16* src = WSP(A,bf16,WS_H2) + (size_t)(aa[i] >> 2) * D + 16 * lane; x0[i] = *(const v4u*)src; x1[i] = *(const v4u*)(src + 8); gv[i] = WSP(A,float,WS_GATEW)[aa[i]]; }
#pragma unroll
        for (int i = 0; i < 4; ++i) { const int r = r0 + i;
            if (ok[i]) { *(v4u*)(WSP(A,bf16,WS_XG) + (size_t)r * D + 16 * lane) = x0[i]; *(v4u*)(WSP(A,bf16,WS_XG) + (size_t)r * D + 16 * lane + 8) = x1[i];
                if (lane == 0) { WSP(A,float,WS_ROWW)[r] = gv[i]; WSP(A,int,WS_POS)[aa[i]] = r; } }
            else if (lane == 0) WSP(A,float,WS_ROWW)[r] = 0.f; }
    }
    __syncthreads();
}

__device__ __forceinline__ void p11_combine2(Frame& F, const Args& A) {
    (void)moe_tables(F, A, !MK_PER_PHASE); const LAS int* rowb = (const LAS int*)(F.lds + ROWB_OFF);
    const int lane = F.lane, gw = F.vcu * NWAVES + F.wave, NGW = F.G * NWAVES;
    for (int t0 = gw * 2; t0 < M; t0 += NGW * 2) {
        int rr[2][4]; f32x4 v[2][4]; unsigned y[2][4][4];
#pragma unroll
        for (int i = 0; i < 2; ++i)
#pragma unroll
            for (int k = 0; k < 4; ++k) { const int ps = WSP(A,int,WS_POS)[(t0 + i) * 4 + k]; rr[i][k] = rowb[ps >> 14] + (ps & (EXPCAP - 1)); }
#pragma unroll
        for (int i = 0; i < 2; ++i) {
#pragma unroll
            for (int j = 0; j < 4; ++j) v[i][j] = ((const f32x4*)((A).out + (size_t)(t0 + i) * D))[lane + 64 * j];
#pragma unroll
            for (int k = 0; k < 4; ++k)
#pragma unroll
                for (int j = 0; j < 4; ++j) y[i][k][j] = ((const unsigned*)(WSP(A,unsigned char,WS_Y) + (size_t)rr[i][k] * D))[lane + 64 * j]; }
#pragma unroll
        for (int i = 0; i < 2; ++i) {
#pragma unroll
            for (int j = 0; j < 4; ++j) { f32x4 s = {0.f, 0.f, 0.f, 0.f};
#pragma unroll
                for (int k = 0; k < 4; ++k) { const int w = (int)y[i][k][j]; const f32x2_t lo = __builtin_amdgcn_cvt_pk_f32_fp8(w, false), hi = __builtin_amdgcn_cvt_pk_f32_fp8(w, true); s.x += lo.x; s.y += lo.y; s.z += hi.x; s.w += hi.y; }
                ((f32x4*)((A).out + (size_t)(t0 + i) * D))[lane + 64 * j] = v[i][j] + s * (1.0f / pg8::F8_SCALE_Y); } }
    }
}

template <class Sched>
__device__ __forceinline__ void gu_setup(Frame& F, const Args& A, const Sched& S) {
    LAS unsigned* utok = (LAS unsigned*)(F.lds + UTOK_OFF);
    const LAS int* tile_e = (const LAS int*)(F.lds + TILEE_OFF); const LAS int* rowb = (const LAS int*)(F.lds + ROWB_OFF); const LAS int* cntl = (const LAS int*)(F.lds + CNTL_OFF);
    if (F.tid < 256) {
        int aa[UTOK_UNITS], rr[UTOK_UNITS]; bool ok[UTOK_UNITS], has[UTOK_UNITS], pz[UTOK_UNITS]; float gv[UTOK_UNITS];
#pragma unroll
        for (int i = 0; i < UTOK_UNITS; ++i) { pg8::Unit u; has[i] = S.next(i, u); aa[i] = 0; ok[i] = false; pz[i] = false; rr[i] = 0; gv[i] = 0.f;
            if (has[i]) { const int rt = u.pm, x = tile_e[rt], j = rt * 256 - rowb[x] + F.tid; ok[i] = j < cntl[x]; pz[i] = (u.pn & 7) == 0; rr[i] = rt * 256 + F.tid;
                if (ok[i]) { aa[i] = WSP(A,int,WS_TOKL)[x * EXPCAP + j]; if (pz[i]) gv[i] = WSP(A,float,WS_GATEW)[x * EXPCAP + j]; } } }
#pragma unroll
        for (int i = 0; i < UTOK_UNITS; ++i) if (has[i]) { utok[i * 256 + F.tid] = (unsigned)(aa[i] >> 2) * (unsigned)D; if (pz[i]) WSP(A,float,WS_ROWW)[rr[i]] = gv[i]; }
    }
    __syncthreads();
}

__device__ __forceinline__ void pretouch(const Frame& F, const unsigned char* p, size_t bytes) {
    const size_t per = (bytes / (size_t)F.G) & ~(size_t)127; const unsigned char* q = p + per * (size_t)F.vcu; unsigned acc = 0u;
    for (size_t o = (size_t)F.tid * 128; o < per; o += (size_t)NWAVES * 64 * 128) acc += *(const unsigned*)(q + o);
    asm volatile("" :: "v"(acc));
}

__device__ __forceinline__ void p4_rs(Frame& F, const Args& A, int pm) {
    if (F.tid < 256) { const int t = pm * 256 + F.tid; float rs[4];
#pragma unroll
        for (int g = 0; g < 4; ++g) { const f32x4 a = *(const f32x4*)(WSP(A,float,WS_SSQ) + (size_t)t * 32 + 8 * g), b = *(const f32x4*)(WSP(A,float,WS_SSQ) + (size_t)t * 32 + 8 * g + 4);
            rs[g] = 1.0f / sqrtf(((a.x + a.y) + (a.z + a.w) + (b.x + b.y) + (b.z + b.w)) * (1.f / 512.f) + NORM_EPS); }
        *(f32x4*)(WSP(A,float,WS_RS) + (size_t)t * 4) = (f32x4){rs[0] / rs[1], rs[1] / rs[2], rs[2] / rs[3], rs[3]}; }
}

__device__ __forceinline__ int moe_units(Frame& F, int nN, int base, int count, int v, bool pair) {
    LAS int* tab = (LAS int*)(F.lds + UTAB_OFF); const LAS int* tile_e = (const LAS int*)(F.lds + TILEE_OFF);
    const int n = (v >= 0 && v < count) ? (count - v + F.G - 1) / F.G : 0;
    if (F.tid < n && F.tid < UTOK_UNITS) { const int idx = base + F.tid * F.G + v; int rt, pl;
        if (pair && F.G == 256 && idx < 2048) { const int r = idx >> 8, w = idx & 255; rt = 64 * (r >> 1) + 8 * (w >> 5) + 4 * (r & 1) + ((w & 31) >> 3); pl = w & 7; }
        else { rt = idx / nN; pl = idx - rt * nN; }
        tab[2 * F.tid] = rt; tab[2 * F.tid + 1] = tile_e[rt] * nN + pl; }
    __syncthreads();
    return n < UTOK_UNITS ? n : UTOK_UNITS;
}
__global__ void __launch_bounds__(NWAVES * 64, 2) mk_fwd(Args args) {
    extern __shared__ __attribute__((aligned(16))) unsigned char lds[];
    Frame F;
    F.lds = (LAS unsigned char*)lds;
    F.MISC = (volatile LAS unsigned*)(F.lds + MISC_OFF);
    F.tid = threadIdx.x; F.lane = F.tid & 63; F.wave = __builtin_amdgcn_readfirstlane(F.tid >> 6);
    F.pb = 0ull;
    F.G = gridDim.x; { const int bx = blockIdx.x; F.vcu = (F.G % 8 == 0) ? (bx % 8) * (F.G / 8) + bx / 8 : bx; }
    const Args& A = args;
    F.ctl = (gu32*)(args.ws + WS_CTL);
    for (int u = F.tid; u < (LDS_BYTES - LDSCTL_OFF) / 4; u += NWAVES * 64) ((LAS unsigned*)(F.lds + LDSCTL_OFF))[u] = 0u;
    __syncthreads();
    XcdBarrier bar; bar.bar = (unsigned*)(F.ctl + CW_BAR); bar.x = 0; bar.st = nullptr;
    if (!MK_PER_PHASE) bar = xcd_barrier_post((unsigned*)(F.ctl + CW_BAR), F.MISC + 8);
    const int lo = args.ph_lo, hi = args.ph_hi;
#ifndef PH_MASK
#define PH_MASK 0xFFF
#endif
#define IN(k) ((((PH_MASK) >> (k)) & 1) && lo <= (k) && (k) < hi)
#ifndef PROBE_PHASE
#define PROBE_PHASE -1
#endif
#ifndef PROBE_BLOCK
#define PROBE_BLOCK 0
#endif
#ifndef PROBE_MULT
#define PROBE_MULT 4
#endif
    unsigned long long pb_mark = 0ull, pb_acc = 0ull;
#define PB_START(k) do { if ((k) == PROBE_PHASE) pb_mark = __builtin_amdgcn_s_memrealtime(); } while (0)
#define PB_END(k) do { if ((k) == PROBE_PHASE) pb_acc = __builtin_amdgcn_s_memrealtime() - pb_mark; } while (0)
#ifndef PRETOUCH
#define PRETOUCH 0
#endif
#ifndef KROT
#define KROT 0
#endif
    const int lpos = F.vcu & 31;
#define ROTN(nt) (KROT ? ((lpos & 7) * ((nt) >> 3) + (lpos >> 3) * (((nt) >> 2) + 1)) & ((nt) - 1) : 0)
#define ROTD(nt) (KROT ? ((lpos >> 2) * ((nt) >> 3) + (lpos & 3) * (((nt) >> 2) + 1)) & ((nt) - 1) : 0)
#define SEAM(k) do { if (!MK_PER_PHASE && IN(k) && IN((k) + 1)) xcd_barrier(bar); } while (0)

    PB_START(PH_PRO);
    if (IN(PH_PRO)) { for (int rep = 0; rep < (1 + (((REP_MASK) >> PH_PRO) & 1)); ++rep) { const unsigned long long tq0 = SEC_T(); p0_prologue(F, A); SEC_ADD(11, tq0); } { const unsigned long long tq1 = SEC_T(); p0_tail(F, A); SEC_ADD(12, tq1); } { const unsigned long long tq2 = SEC_T(); SEAM(PH_PRO); SEC_ADD(13, tq2); } PB_END(PH_PRO); }
    PB_START(PH_INPROJ);
    if (IN(PH_INPROJ)) for (int rep = 0; rep < REP(PH_INPROJ); ++rep) {
        pg8::Gemm g{WSP(A,bf16,WS_XN), WSP(A,bf16,WS_WIN), M, NPROJ, D}; pg8::StaticOrder S; S.init(M, NPROJ, F.G, (int)blockIdx.x);
        pg8::EpiPlain E{WSP(A,bf16,WS_PROJ), NPROJ};
        pg8::gemm_phase<pg8::EpiPlain, pg8::StaticOrder, true, true>(F.lds + RING_OFF, g, S, E, 0, F.pb);
        if (rep == REP(PH_INPROJ) - 1) SEAM(PH_INPROJ); PB_END(PH_INPROJ);
    }
    PB_START(PH_PREP);
    if (IN(PH_PREP)) { p2_prep2(F, A); SEAM(PH_PREP); PB_END(PH_PREP); }
    PB_START(PH_SSD);
    if (IN(PH_SSD)) {
#if SSD_SIMPLE
        p3_ssd(F, A);
#else
        for (int rep = 0; rep < REP(PH_SSD); ++rep) p3_ssd_mfma2(F, A);
#endif
        PB_END(PH_SSD);     }
    PB_START(PH_ATTN);
    if (IN(PH_ATTN)) {
#if ATTN_SIMPLE
        attn_simple(F, A);
#else
        for (int rep = 0; rep < REP(PH_ATTN); ++rep) attn_mfma2(F, A);
#endif
        if (PRETOUCH & 1) pretouch(F, (A).ws + WS_WOA, 8 * MiB);
        SEAM(PH_ATTN); PB_END(PH_ATTN); }
    PB_START(PH_OPROJ);
    if (IN(PH_OPROJ)) for (int rep = 0; rep < REP(PH_OPROJ); ++rep) {
        { pg8::StaticOrder S0; S0.init(M, D, F.G, (int)blockIdx.x); pg8::Unit u0; if (S0.next(0, u0)) p4_rs(F, A, u0.pm); VM_WAIT(); __syncthreads(); }
        { pg8::Gemm g{WSP(A,bf16,WS_AO), WSP(A,bf16,WS_WOA), M, D, D}; pg8::StaticOrder S; S.init(M, D, F.G, (int)blockIdx.x);
          pg8::EpiGate1 E{WSP(A,bf16,WS_PROJ) + PGATE, NPROJ, IN_GATEB(A), WSP(A,bf16,WS_MIXF)};
          pg8::gemm_phase<pg8::EpiGate1, pg8::StaticOrder, true, true>(F.lds + RING_OFF, g, S, E, 0, F.pb); }
        { pg8::Gemm g{WSP(A,bf16,WS_YG), WSP(A,bf16,WS_WOS), M, D, D_INNER}; pg8::StaticOrder S; S.init(M, D, F.G, (int)blockIdx.x);
          pg8::EpiGate2H E{WSP(A,bf16,WS_PROJ) + PGATE + D, NPROJ, IN_GATEB(A) + D, WSP(A,bf16,WS_MIXF), WSP(A,bf16,WS_MIX), WSP(A,float,WS_RS)};
          pg8::gemm_phase<pg8::EpiGate2H, pg8::StaticOrder, true, true>(F.lds + RING_OFF, g, S, E, 0, F.pb); }
        if (rep == REP(PH_OPROJ) - 1) SEAM(PH_OPROJ); PB_END(PH_OPROJ);
    }
    PB_START(PH_WOUT);
    if (IN(PH_WOUT)) for (int rep = 0; rep < REP(PH_WOUT); ++rep) {
        pg8::Gemm g{WSP(A,bf16,WS_MIX), WSP(A,bf16,WS_WOUT), M, D, D}; pg8::StaticOrder S; S.init(M, D, F.G, (int)blockIdx.x);
        pg8::EpiResid E{IN_X(A), (A).out};
        pg8::gemm_phase<pg8::EpiResid, pg8::StaticOrder, true, true>(F.lds + RING_OFF, g, S, E, 0, F.pb);
        if (rep == REP(PH_WOUT) - 1) SEAM(PH_WOUT); PB_END(PH_WOUT);
    }
    PB_START(PH_ROUTE);
    if (IN(PH_ROUTE)) { p7_route2(F, A); if (PRETOUCH & 4) pretouch(F, (A).ws + WS_WGU, 64 * MiB); SEAM(PH_ROUTE); PB_END(PH_ROUTE); }
    PB_START(PH_GATHER);
    if (IN(PH_GATHER)) { PB_END(PH_GATHER); }
    PB_START(PH_GU);
    if (IN(PH_GU)) {
        const int NT = moe_tables(F, A); const int cntA = ((8 * NT) / F.G) * F.G;
        pg8::Gemm g{WSP(A,bf16,WS_H2F8), WSP(A,bf16,WS_WGU), NT * 256, 2048, D / 2}; pg8::TableOrder S{moe_units(F, 8, 0, cntA, F.vcu, true), (const LAS int*)(F.lds + UTAB_OFF)};
        gu_setup(F, A, S);
        pg8::EpiSwiglu8 E{WSP(A,unsigned char,WS_ACT), IN_BGU(A)};
        pg8::gemm_phase_g<pg8::EpiSwiglu8, pg8::TableOrder, true, true>(F.lds + RING_OFF, g, S, E, (const LAS unsigned*)(F.lds + UTOK_OFF), ROTN(8), F.pb);
        if (PRETOUCH & 2) pretouch(F, (A).ws + WS_WDN, 32 * MiB);
        SEAM(PH_GU); PB_END(PH_GU);
    }
    PB_START(PH_DOWN);
    if (IN(PH_DOWN)) {
        const int NT = moe_tables(F, A, !MK_PER_PHASE && IN(PH_GU)); const int cntA = ((8 * NT) / F.G) * F.G, remGU = 8 * NT - cntA;
        const int nDB = (F.G - remGU) < 4 * NT ? (F.G - remGU) : 4 * NT;
        pg8::Gemm gd{WSP(A,bf16,WS_ACT), WSP(A,bf16,WS_WDN), NT * 256, 1024, D / 2}; pg8::EpiDown8 ED{WSP(A,unsigned char,WS_Y), IN_BDN(A), WSP(A,float,WS_ROWW)};
        if (F.vcu < remGU) {
            pg8::Gemm g{WSP(A,bf16,WS_H2F8), WSP(A,bf16,WS_WGU), NT * 256, 2048, D / 2}; pg8::TableOrder S{moe_units(F, 8, cntA, remGU, F.vcu, true), (const LAS int*)(F.lds + UTAB_OFF)};
            gu_setup(F, A, S);
            pg8::EpiSwiglu8 E{WSP(A,unsigned char,WS_ACT), IN_BGU(A)};
            pg8::gemm_phase_g<pg8::EpiSwiglu8, pg8::TableOrder, true, true>(F.lds + RING_OFF, g, S, E, (const LAS unsigned*)(F.lds + UTOK_OFF), ROTN(8), F.pb);
        } else {
            pg8::TableOrder S{moe_units(F, 4, 0, nDB, F.vcu - remGU, false), (const LAS int*)(F.lds + UTAB_OFF)};
            pg8::gemm_phase<pg8::EpiDown8, pg8::TableOrder, true, true, true>(F.lds + RING_OFF, gd, S, ED, ROTD(8), F.pb);
        }
        if (!MK_PER_PHASE) xcd_barrier(bar);
        { pg8::TableOrder S{moe_units(F, 4, nDB, 4 * NT - nDB, F.vcu, false), (const LAS int*)(F.lds + UTAB_OFF)};
          pg8::gemm_phase<pg8::EpiDown8, pg8::TableOrder, true, true, true>(F.lds + RING_OFF, gd, S, ED, ROTD(8), F.pb); }
        SEAM(PH_DOWN); PB_END(PH_DOWN);
    }
    PB_START(PH_COMB);
    if (IN(PH_COMB)) { p11_combine2(F, A); }
    PB_END(PH_COMB);
#ifdef PROBE_XBAR
    for (int q = 0; q < PROBE_XBAR; ++q) xcd_barrier(bar);
#endif
#ifndef PROBE_HOT
#define PROBE_HOT 0
#endif
    if (PROBE_HOT) {
        struct HotOrder { int l; __device__ __forceinline__ bool next(int i, pg8::Unit& u) const { if (i >= 10) return false; u.pm = l & 1; u.pn = (l >> 1) & 1; return true; }
            __device__ __forceinline__ void a_ready(const pg8::Unit&) const {} __device__ __forceinline__ void done(const pg8::Unit&) const {} };
        pg8::Gemm g{WSP(A,bf16,WS_XN), WSP(A,bf16,WS_WIN), M, NPROJ, D}; HotOrder S{F.vcu & 31}; pg8::EpiPlain E{WSP(A,bf16,WS_H2), D};
        pg8::gemm_phase<pg8::EpiPlain, HotOrder, true, true>(F.lds + RING_OFF, g, S, E, 0, F.pb);
    }
    if ((PROBE_PHASE >= 0 || PROBE_SEC > 0) && blockIdx.x == PROBE_BLOCK && F.tid == 64 * PROBE_WAVE) { const unsigned long long t1 = __builtin_amdgcn_s_memrealtime(); while (__builtin_amdgcn_s_memrealtime() - t1 < (unsigned long long)PROBE_MULT * (pb_acc + F.pb)) __builtin_amdgcn_s_sleep(8); }
#undef IN
#undef SEAM
}

extern "C" void kernel_launch(void* const* d_in, const int* in_sizes, int n_in, void* d_out, int out_size, void* d_ws, size_t ws_size, hipStream_t stream) {
    static int grid = 0;
    if (grid == 0) {
        if (n_in != 22 || in_sizes[0] != M * D || out_size != M * D || ws_size < WS_END) { fprintf(stderr, "kernel_launch: unexpected shapes / workspace (n_in %d, in0 %d, out %d, ws %zu, need %zu); nothing launched\n", n_in, n_in > 0 ? in_sizes[0] : -1, out_size, ws_size, (size_t)WS_END); grid = -1; return; }
        int dev = 0, cus = 0, per_cu = 0;
        if (hipGetDevice(&dev) != hipSuccess || hipDeviceGetAttribute(&cus, hipDeviceAttributeMultiprocessorCount, dev) != hipSuccess) { fprintf(stderr, "kernel_launch: device query failed\n"); grid = -1; return; }
        if (hipFuncSetAttribute((const void*)mk_fwd, hipFuncAttributeMaxDynamicSharedMemorySize, LDS_BYTES) != hipSuccess) { fprintf(stderr, "kernel_launch: hipFuncSetAttribute failed\n"); grid = -1; return; }
        if (hipOccupancyMaxActiveBlocksPerMultiprocessor(&per_cu, (const void*)mk_fwd, NWAVES * 64, LDS_BYTES) != hipSuccess || per_cu < 1) fprintf(stderr, "kernel_launch: note: occupancy query reports %d blocks per CU\n", per_cu);
        (void)hipGetLastError();
        grid = cus;
    }
    if (grid < 0) return;
    if (hipMemsetAsync((char*)d_ws + WS_CTL, 0, CTL_ZERO_BYTES, stream) != hipSuccess) { fprintf(stderr, "kernel_launch: memset failed\n"); return; }
    Args a{};
    for (int i = 0; i < 22; ++i) a.in[i] = (const float*)d_in[i];
    a.out = (float*)d_out; a.ws = (unsigned char*)d_ws;
#if MK_PER_PHASE
    for (int p = 0; p < N_PHASES; ++p) { a.ph_lo = p; a.ph_hi = p + 1; hipLaunchKernelGGL(mk_fwd, dim3(grid), dim3(NWAVES * 64), LDS_BYTES, stream, a); }
#else
    a.ph_lo = 0; a.ph_hi = N_PHASES;
    hipLaunchKernelGGL(mk_fwd, dim3(grid), dim3(NWAVES * 64), LDS_BYTES, stream, a);
#endif
    const hipError_t le = hipPeekAtLastError();
    if (le != hipSuccess) fprintf(stderr, "kernel_launch: launch failed: %s\n", hipGetErrorName(le));
}
```
